# Optimizing an MI355X kernel written in HIP

```python
import math
import jax
import jax.numpy as jnp
from jax import lax
import numpy as np

D_MODEL = 2048
BATCH = 4
SEQ = 2048
DEPTH = 2

HEAD_DIM = 64
SCALE = HEAD_DIM ** -0.5
Q_BLOCK = 128
NORM_EPS = 1e-6
NEG = -1e30
TINY = 1e-30

DIL_GROUPS = ((128, 1), (512, 4), (2048, 16))
N_DIL_GROUPS = 3
A_HEADS = 8
A_WIDTH = A_HEADS * HEAD_DIM

B_HEADS = 16
B_KV_GROUPS = 2
B_HEADS_PER_GROUP = B_HEADS // B_KV_GROUPS
CMP_LEN = 32
CMP_STRIDE = 16
CMP_HIDDEN = 256
SEL_LEN = 64
SEL_TOPK = 16
SEL_LOCAL = 2
FORCED_SCORE = 1e6
WIN = 512
B_WIDTH = B_HEADS * HEAD_DIM

C_HEADS = 8
C_VDIM = 2 * HEAD_DIM
C_WIDTH = C_HEADS * C_VDIM

N_BUCKETS = 32
BIAS_MAX_DIST = 2048
N_BIAS_A = N_DIL_GROUPS * A_HEADS
N_BIAS_HEADS = N_BIAS_A + B_HEADS + C_HEADS

D_FF = 4 * D_MODEL
N_BRANCHES = 3

IN_SPLITS = (
    3 * N_DIL_GROUPS * A_HEADS * HEAD_DIM,
    B_HEADS * HEAD_DIM,
    6 * B_KV_GROUPS * HEAD_DIM,
    3 * B_HEADS,
    C_HEADS * 2 * HEAD_DIM,
    C_HEADS * 2 * HEAD_DIM,
    C_HEADS * C_VDIM,
    N_BRANCHES * D_MODEL,
)
IN_COLS = sum(IN_SPLITS)
IN_OFFSETS = tuple(int(v) for v in np.cumsum(IN_SPLITS)[:-1])

kernel_name = "hybrid_gated_dilated_nsa_diff_block"


def rms_norm(x, gain):
    xf = x.astype(jnp.float32)
    y = xf * lax.rsqrt(jnp.mean(xf * xf, axis=-1, keepdims=True) + NORM_EPS)
    return (y * gain.astype(jnp.float32)).astype(x.dtype)


def masked_softmax(logits, mask):
    logits = jnp.where(mask, logits, NEG)
    m = jnp.max(logits, axis=-1, keepdims=True)
    e = jnp.where(mask, jnp.exp(logits - m), 0.0)
    s = jnp.maximum(jnp.sum(e, axis=-1, keepdims=True), TINY)
    return e / s, (m + jnp.log(s))[..., 0]


def t5_bucket(dist):
    exact = N_BUCKETS // 2
    d = jnp.maximum(dist, 0)
    logd = jnp.log(jnp.maximum(d, 1).astype(jnp.float32) / exact)
    far = exact + (logd / math.log(BIAS_MAX_DIST / exact) * (N_BUCKETS - exact)).astype(jnp.int32)
    return jnp.where(d < exact, d, jnp.minimum(far, N_BUCKETS - 1))


def sweep_query_blocks(block_fn, seq):
    out = lax.map(block_fn, jnp.arange(seq // Q_BLOCK))
    out = jnp.moveaxis(out, 0, 1)
    return out.reshape((out.shape[0], seq) + out.shape[3:])


def dilated_attention(q, k, v, rel_a):
    seq = q.shape[1]

    def block(bi):
        t = bi * Q_BLOCK + jnp.arange(Q_BLOCK)
        qb = lax.dynamic_slice_in_dim(q, bi * Q_BLOCK, Q_BLOCK, axis=1)
        outs, lses = [], []
        for g, (win, dil) in enumerate(DIL_GROUPS):
            offs = jnp.arange(win // dil + 1) * dil
            idx = t[:, None] - offs[None, :]
            valid = idx >= 0
            idx = jnp.maximum(idx, 0)
            kg = k[:, :, g][:, idx]
            vg = v[:, :, g][:, idx]
            logits = jnp.einsum("bqhd,bqjhd->bhqj", qb[:, :, g], kg).astype(jnp.float32) * SCALE
            bias = rel_a[t5_bucket(offs), g].T.astype(jnp.float32)
            p, lse = masked_softmax(logits + bias[None, :, None, :], valid[None, None])
            outs.append(jnp.einsum("bhqj,bqjhd->bqhd", p.astype(v.dtype), vg))
            lses.append(jnp.transpose(lse, (0, 2, 1)))
        wts = jax.nn.softmax(jnp.stack(lses, axis=0), axis=0).astype(v.dtype)
        return (wts[0][..., None] * outs[0] + wts[1][..., None] * outs[1]
                + wts[2][..., None] * outs[2])

    return sweep_query_blocks(block, seq)


def nsa_attention(q, kv, gates, cmp_k_pos, cmp_v_pos, cmp_k_w1, cmp_k_w2, cmp_v_w1, cmp_v_w2, rel_b):
    bsz, seq = q.shape[:2]
    G, Hg, hd = B_KV_GROUPS, B_HEADS_PER_GROUP, HEAD_DIM
    qg = q.reshape(bsz, seq, G, Hg, hd)
    k_cmp, v_cmp, k_sel, v_sel, k_win, v_win = [kv[:, :, i] for i in range(6)]
    t_all = jnp.arange(seq)

    n_cmp = (seq - CMP_LEN) // CMP_STRIDE + 1
    starts = jnp.arange(n_cmp) * CMP_STRIDE
    cidx = starts[:, None] + jnp.arange(CMP_LEN)[None, :]

    def compress(kx, pos, w1, w2):
        blocks = kx[:, cidx] + pos[None, None, :, None, :]
        blocks = jnp.transpose(blocks, (0, 1, 3, 2, 4)).reshape(bsz, n_cmp, G, CMP_LEN * hd)
        return jax.nn.gelu(blocks @ w1) @ w2

    kc = compress(k_cmp, cmp_k_pos, cmp_k_w1, cmp_k_w2)
    vc = compress(v_cmp, cmp_v_pos, cmp_v_w1, cmp_v_w2)
    cmask = (starts + CMP_LEN - 1)[None, :] <= t_all[:, None]
    logits_c = jnp.einsum("bsghd,bngd->bghsn", qg, kc).astype(jnp.float32) * SCALE
    p_cmp, _ = masked_softmax(logits_c, cmask)
    o_cmp = jnp.einsum("bghsn,bngd->bsghd", p_cmp.astype(v_cmp.dtype), vc)

    n_sel = seq // SEL_LEN
    top = min(SEL_TOPK, n_sel)
    bstart = jnp.arange(n_sel) * SEL_LEN
    overlap = ((starts[:, None] < bstart[None, :] + SEL_LEN)
               & (starts[:, None] + CMP_LEN > bstart[None, :])).astype(jnp.float32)
    score = jnp.einsum("bghsn,nj->bgsj", p_cmp, overlap)
    cur = t_all // SEL_LEN
    back = cur[:, None] - jnp.arange(n_sel)[None, :]
    forced = (jnp.arange(n_sel)[None, :] == 0) | ((back >= 0) & (back < SEL_LOCAL))
    score = jnp.where(forced, FORCED_SCORE, score)
    score = jnp.where(bstart[None, :] <= t_all[:, None], score, NEG)
    _, sel_idx = lax.top_k(score, top)

    k_blk = jnp.transpose(k_sel.reshape(bsz, n_sel, SEL_LEN, G, hd), (0, 3, 1, 2, 4))
    v_blk = jnp.transpose(v_sel.reshape(bsz, n_sel, SEL_LEN, G, hd), (0, 3, 1, 2, 4))
    bidx = jnp.arange(bsz)[:, None, None, None]
    gidx = jnp.arange(G)[None, :, None, None]
    rel_bg = jnp.transpose(rel_b, (1, 0, 2))

    def sel_block(bi):
        qs = bi * Q_BLOCK
        t = qs + jnp.arange(Q_BLOCK)
        qb = lax.dynamic_slice_in_dim(qg, qs, Q_BLOCK, axis=1)
        ib = lax.dynamic_slice_in_dim(sel_idx, qs, Q_BLOCK, axis=2)
        kb = k_blk[bidx, gidx, ib].reshape(bsz, G, Q_BLOCK, top * SEL_LEN, hd)
        vb = v_blk[bidx, gidx, ib].reshape(bsz, G, Q_BLOCK, top * SEL_LEN, hd)
        kpos = (ib[..., None] * SEL_LEN + jnp.arange(SEL_LEN)).reshape(bsz, G, Q_BLOCK, top * SEL_LEN)
        dist = t[None, None, :, None] - kpos
        bias = rel_bg[gidx, t5_bucket(dist)]
        logits = (jnp.einsum("bqghd,bgqkd->bghqk", qb, kb).astype(jnp.float32) * SCALE
                  + jnp.transpose(bias, (0, 1, 4, 2, 3)).astype(jnp.float32))
        p, _ = masked_softmax(logits, (dist >= 0)[:, :, None])
        return jnp.einsum("bghqk,bgqkd->bqghd", p.astype(vb.dtype), vb)

    o_sel = sweep_query_blocks(sel_block, seq)

    kw = jnp.pad(k_win, ((0, 0), (WIN, 0), (0, 0), (0, 0)))
    vw = jnp.pad(v_win, ((0, 0), (WIN, 0), (0, 0), (0, 0)))

    def win_block(bi):
        qs = bi * Q_BLOCK
        t = qs + jnp.arange(Q_BLOCK)
        qb = lax.dynamic_slice_in_dim(qg, qs, Q_BLOCK, axis=1)
        kb = lax.dynamic_slice_in_dim(kw, qs, Q_BLOCK + WIN, axis=1)
        vb = lax.dynamic_slice_in_dim(vw, qs, Q_BLOCK + WIN, axis=1)
        kpos = qs - WIN + jnp.arange(Q_BLOCK + WIN)
        dist = t[:, None] - kpos[None, :]
        valid = (dist >= 0) & (dist < WIN) & (kpos[None, :] >= 0)
        bias = jnp.transpose(rel_b[t5_bucket(dist)], (2, 3, 0, 1)).astype(jnp.float32)
        logits = jnp.einsum("bqghd,bkgd->bghqk", qb, kb).astype(jnp.float32) * SCALE + bias
        p, _ = masked_softmax(logits, valid)
        return jnp.einsum("bghqk,bkgd->bqghd", p.astype(vb.dtype), vb)

    o_win = sweep_query_blocks(win_block, seq)

    shp = (bsz, seq, B_HEADS, hd)
    out = (gates[..., 0:1] * o_cmp.reshape(shp) + gates[..., 1:2] * o_sel.reshape(shp)
           + gates[..., 2:3] * o_win.reshape(shp))
    return out.reshape(bsz, seq, B_WIDTH)


def diff_attention(q, k, v, lam_vecs, sub_gain, rel_c, lam_init):
    bsz, seq = q.shape[:2]
    lv = lam_vecs.astype(jnp.float32)
    lam = jnp.exp(jnp.sum(lv[0] * lv[1])) - jnp.exp(jnp.sum(lv[2] * lv[3])) + lam_init
    kpos = jnp.arange(seq)

    def block(bi):
        t = bi * Q_BLOCK + jnp.arange(Q_BLOCK)
        qb = lax.dynamic_slice_in_dim(q, bi * Q_BLOCK, Q_BLOCK, axis=1)
        dist = t[:, None] - kpos[None, :]
        bias = jnp.transpose(rel_c[t5_bucket(dist)], (2, 0, 1)).astype(jnp.float32)
        logits = jnp.einsum("bqhcd,bkhcd->bchqk", qb, k).astype(jnp.float32) * SCALE + bias
        p, _ = masked_softmax(logits, dist >= 0)
        attn = p[:, 0] - lam * p[:, 1]
        return jnp.einsum("bhqk,bkhd->bqhd", attn.astype(v.dtype), v)

    o = sweep_query_blocks(block, seq)
    o = rms_norm(o, sub_gain) * (1.0 - lam_init)
    return o.reshape(bsz, seq, C_WIDTH)


def setup_inputs(seed: int = 0) -> dict:
    key = jax.random.key(seed)
    ks = jax.random.split(key, 24)
    f32 = jnp.float32
    L = DEPTH

    def w(k, shape, fan_in):
        return jax.random.normal(k, shape, f32) * fan_in ** -0.5

    def gain(k, shape):
        return 1.0 + 0.02 * jax.random.normal(k, shape, f32)

    return {
        "x": jax.random.normal(ks[0], (BATCH, SEQ, D_MODEL), f32),
        "rel_bias": 0.2 * jax.random.normal(ks[1], (N_BUCKETS, N_BIAS_HEADS), f32),
        "w_in": w(ks[2], (L, D_MODEL, IN_COLS), D_MODEL),
        "cmp_k_pos": 0.2 * jax.random.normal(ks[3], (L, CMP_LEN, HEAD_DIM), f32),
        "cmp_v_pos": 0.2 * jax.random.normal(ks[4], (L, CMP_LEN, HEAD_DIM), f32),
        "cmp_k_w1": w(ks[5], (L, CMP_LEN * HEAD_DIM, CMP_HIDDEN), CMP_LEN * HEAD_DIM),
        "cmp_k_w2": w(ks[6], (L, CMP_HIDDEN, HEAD_DIM), CMP_HIDDEN),
        "cmp_v_w1": w(ks[7], (L, CMP_LEN * HEAD_DIM, CMP_HIDDEN), CMP_LEN * HEAD_DIM),
        "cmp_v_w2": w(ks[8], (L, CMP_HIDDEN, HEAD_DIM), CMP_HIDDEN),
        "diff_lambda": 0.1 * jax.random.normal(ks[9], (L, 4, HEAD_DIM), f32),
        "diff_norm": gain(ks[10], (L, C_VDIM)),
        "w_branch_a": w(ks[11], (L, A_WIDTH, D_MODEL), A_WIDTH),
        "w_branch_b": w(ks[12], (L, B_WIDTH, D_MODEL), B_WIDTH),
        "w_branch_c": w(ks[13], (L, C_WIDTH, D_MODEL), C_WIDTH),
        "w_out": w(ks[14], (L, D_MODEL, D_MODEL), D_MODEL),
        "norm_mix_pre": gain(ks[15], (L, D_MODEL)),
        "norm_mix_post": gain(ks[16], (L, D_MODEL)),
        "norm_mlp_pre": gain(ks[17], (L, D_MODEL)),
        "norm_mlp_post": gain(ks[18], (L, D_MODEL)),
        "w_up": w(ks[19], (L, D_MODEL, D_FF), D_MODEL),
        "w_down": w(ks[20], (L, D_FF, D_MODEL), D_FF),
    }


def reference(x, rel_bias, w_in, cmp_k_pos, cmp_v_pos, cmp_k_w1, cmp_k_w2, cmp_v_w1, cmp_v_w2,
              diff_lambda, diff_norm, w_branch_a, w_branch_b, w_branch_c, w_out,
              norm_mix_pre, norm_mix_post, norm_mlp_pre, norm_mlp_post, w_up, w_down):
    bsz, seq, _ = x.shape
    rel_a = rel_bias[:, :N_BIAS_A].reshape(N_BUCKETS, N_DIL_GROUPS, A_HEADS)
    rel_b = rel_bias[:, N_BIAS_A:N_BIAS_A + B_HEADS].reshape(N_BUCKETS, B_KV_GROUPS, B_HEADS_PER_GROUP)
    rel_c = rel_bias[:, N_BIAS_A + B_HEADS:]

    for l in range(DEPTH):
        lam_init = 0.8 - 0.6 * math.exp(-0.3 * l)
        h = rms_norm(x, norm_mix_pre[l])
        proj = h @ w_in[l]
        a_qkv, b_q, b_kv, b_gate, c_q, c_k, c_v, m_gate = jnp.split(proj, IN_OFFSETS, axis=-1)

        a = a_qkv.reshape(bsz, seq, 3, N_DIL_GROUPS, A_HEADS, HEAD_DIM)
        o_a = dilated_attention(a[:, :, 0], a[:, :, 1], a[:, :, 2], rel_a).reshape(bsz, seq, A_WIDTH)

        o_b = nsa_attention(b_q.reshape(bsz, seq, B_HEADS, HEAD_DIM),
                            b_kv.reshape(bsz, seq, 6, B_KV_GROUPS, HEAD_DIM),
                            jax.nn.sigmoid(b_gate.reshape(bsz, seq, B_HEADS, 3)),
                            cmp_k_pos[l], cmp_v_pos[l], cmp_k_w1[l], cmp_k_w2[l],
                            cmp_v_w1[l], cmp_v_w2[l], rel_b)

        o_c = diff_attention(c_q.reshape(bsz, seq, C_HEADS, 2, HEAD_DIM),
                             c_k.reshape(bsz, seq, C_HEADS, 2, HEAD_DIM),
                             c_v.reshape(bsz, seq, C_HEADS, C_VDIM),
                             diff_lambda[l], diff_norm[l], rel_c, lam_init)

        g = jax.nn.sigmoid(m_gate.reshape(bsz, seq, N_BRANCHES, D_MODEL))
        mixed = (g[:, :, 0] * (o_a @ w_branch_a[l]) + g[:, :, 1] * (o_b @ w_branch_b[l])
                 + g[:, :, 2] * (o_c @ w_branch_c[l]))
        x = x + rms_norm(mixed @ w_out[l], norm_mix_post[l])

        h = rms_norm(x, norm_mlp_pre[l])
        u = jnp.square(jax.nn.relu(h @ w_up[l]))
        x = x + rms_norm(u @ w_down[l], norm_mlp_post[l])
    return x
```

```cpp
#include <hip/hip_runtime.h>
#include <hip/hip_cooperative_groups.h>
#include <cstdio>
#include <cstdint>
namespace cg = cooperative_groups;
namespace pg8 {
#define PG8_LAS __attribute__((address_space(3)))
typedef unsigned short bf16_t;
typedef short bf16x8 __attribute__((ext_vector_type(8)));
typedef float f32x4 __attribute__((ext_vector_type(4)));
typedef unsigned u32x4 __attribute__((ext_vector_type(4)));
constexpr int BM = 256, BK = 64, HALF = 128, HTB = HALF * BK * 2  , STAGE_BYTES = 8 * HTB, NXCD = 8, WGM = 8;

__host__ __device__ __forceinline__ int lds_byte(int r, int c) { const int st = (r >> 4) * 2 + (c >> 5), rr = r & 15, cc = c & 31, ob = rr * 64 + cc * 2; return st * 1024 + (ob ^ (((ob >> 9) & 1) << 5)); }
__host__ __device__ __forceinline__ void stage_rc(int b, int& R, int& C) { const int st = b / 1024, sb = b % 1024, swz = sb ^ (((sb >> 9) & 1) << 5); R = (st >> 1) * 16 + swz / 64; C = (st & 1) * 32 + (swz % 64) / 2; }
__host__ __device__ __forceinline__ int perm32(int rho) { const int n = rho >> 4, i = rho & 15; return 8 * (i >> 2) + 4 * n + (i & 3); }

struct Unit { int pm, pn; };
struct Gemm { const bf16_t* A; const bf16_t* Bt; int M, N, K; };

struct StaticOrder {
    int nM, nN, nwg, G, c;
    __host__ __device__ void init(int M, int N, int G_, int c_) { nM = M / BM; nN = N / BM; nwg = nM * nN; G = G_; c = c_; }
    __host__ __device__ bool next(int i, Unit& u) const {
        const long L = (long)i * G + c; if (L >= nwg) return false;
        int wgid = (int)L; { const int q = nwg / NXCD, r = nwg % NXCD, xcd = wgid % NXCD, off = wgid / NXCD; wgid = (xcd < r ? xcd * (q + 1) : r * (q + 1) + (xcd - r) * q) + off; }
        const int nig = WGM * nN, gid = wgid / nig, fm = gid * WGM, gsz = (nM - fm) < WGM ? (nM - fm) : WGM;
        u.pm = fm + ((wgid % nig) % gsz); u.pn = (wgid % nig) / gsz; return true;
    }
    __device__ __forceinline__ void a_ready(const Unit&) const {}
    __device__ __forceinline__ void done(const Unit&) const {}
};

__device__ __forceinline__ unsigned cvt_pk_bf16(float lo, float hi) { unsigned r; asm volatile("v_cvt_pk_bf16_f32 %0, %1, %2" : "=v"(r) : "v"(lo), "v"(hi)); return r; }
typedef float f32x2 __attribute__((ext_vector_type(2)));
template <class Epi, class Sched, bool ALIGN_EPI = false, bool SP2 = false>
__device__ __forceinline__ void gemm_phase(PG8_LAS unsigned char* lds, const Gemm g, const Sched& S, const Epi& E) {
    const int tid = threadIdx.x, wid = __builtin_amdgcn_readfirstlane(tid >> 6), lane = tid & 63, wr = wid >> 2, wc = wid & 3, fr = lane & 15, fq = lane >> 4;
    const int K = g.K, nt = K / BK;
    unsigned voffA[2], voffB[2];
#pragma unroll
    for (int i = 0; i < 2; ++i) { int R, C; stage_rc(tid * 16 + i * 8192, R, C); const int Rb = Epi::PERM ? ((R & ~31) + perm32(R & 31)) : R;
        voffA[i] = (unsigned)(R * K + C) * 2u; voffB[i] = (unsigned)(Rb * K + C) * 2u; }
    const size_t kstep = (size_t)(BK * 2);
    const size_t hstep = (size_t)HALF * K * 2;
    const size_t tstep = 2 * hstep;
    const unsigned ldsw = (unsigned)wid * 1024u;
    const int aoff = lds_byte(wr * 64 + fr, fq * 8), boff = lds_byte(wc * 32 + fr, fq * 8);
#define PG8_SA(b, h) (((b) * 2 + (h)) * HTB)
#define PG8_SB(b, h) ((4 + (b) * 2 + (h)) * HTB)
#define PG8_STAGE(bufoff, gbase, voff) do { _Pragma("unroll") for (int _i = 0; _i < 2; ++_i) \
        __builtin_amdgcn_global_load_lds((const unsigned*)((const char*)(gbase) + (voff)[_i]), (PG8_LAS unsigned*)(lds + (bufoff) + ldsw + _i * 8192), 16, 0, 0); } while (0)
#define PG8_LDA(dst, b, h) do { _Pragma("unroll") for (int m = 0; m < 4; ++m) _Pragma("unroll") for (int k = 0; k < 2; ++k) dst[m][k] = *(const PG8_LAS bf16x8*)(lds + PG8_SA(b, h) + aoff + m * 2048 + k * 1024); } while (0)
#define PG8_LDB(dst, b, h) do { _Pragma("unroll") for (int n = 0; n < 2; ++n) _Pragma("unroll") for (int k = 0; k < 2; ++k) dst[n][k] = *(const PG8_LAS bf16x8*)(lds + PG8_SB(b, h) + boff + n * 2048 + k * 1024); } while (0)
#define PG8_MMA(ai, bj, At, Bt) do { __builtin_amdgcn_s_setprio(1); _Pragma("unroll") for (int m = 0; m < 4; ++m) _Pragma("unroll") for (int n = 0; n < 2; ++n) _Pragma("unroll") for (int k = 0; k < 2; ++k) \
        acc[ai][bj][m][n] = __builtin_amdgcn_mfma_f32_16x16x32_bf16(Bt[n][k], At[m][k], acc[ai][bj][m][n], 0, 0, 0); __builtin_amdgcn_s_setprio(0); } while (0)
#define PG8_WAIT_V(n) asm volatile("s_waitcnt vmcnt(" #n ")" ::: "memory")
#define PG8_WAIT_L(n) asm volatile("s_waitcnt lgkmcnt(" #n ")" ::: "memory")
#define PG8_BAR __builtin_amdgcn_s_barrier()
#define PG8_SCHED __builtin_amdgcn_sched_barrier(0)
    Unit cur, nxt; int ui = 0;
    if (!S.next(0, cur)) return;
    f32x4 acc[2][2][4][2];
#pragma unroll
    for (int a = 0; a < 2; ++a)
#pragma unroll
        for (int b = 0; b < 2; ++b)
#pragma unroll
            for (int m = 0; m < 4; ++m)
#pragma unroll
                for (int n = 0; n < 2; ++n) acc[a][b][m][n] = (f32x4){0.f, 0.f, 0.f, 0.f};
    bf16x8 At[4][2], B0[2][2], B1[2][2];
    const char* cA = (const char*)g.A + (size_t)cur.pm * tstep; const char* cB = (const char*)g.Bt + (size_t)cur.pn * tstep;
    S.a_ready(cur);
    if constexpr (SP2) {
        PG8_STAGE(PG8_SB(0, 0), cB, voffB); PG8_STAGE(PG8_SB(0, 1), cB + hstep, voffB); PG8_STAGE(PG8_SA(0, 0), cA, voffA); PG8_STAGE(PG8_SA(0, 1), cA + hstep, voffA);
        if (wr == 1) PG8_BAR;
        PG8_WAIT_V(2); PG8_BAR;
        PG8_STAGE(PG8_SB(1, 0), cB + kstep, voffB); PG8_STAGE(PG8_SA(1, 0), cA + kstep, voffA); PG8_STAGE(PG8_SB(1, 1), cB + hstep + kstep, voffB);
        PG8_WAIT_V(6); PG8_BAR;
    } else {
        PG8_STAGE(PG8_SB(0, 0), cB, voffB); PG8_STAGE(PG8_SA(0, 0), cA, voffA); PG8_STAGE(PG8_SB(0, 1), cB + hstep, voffB); PG8_STAGE(PG8_SA(0, 1), cA + hstep, voffA);
        if (wr == 1) PG8_BAR;
        PG8_WAIT_V(4); PG8_BAR;
        PG8_STAGE(PG8_SB(1, 0), cB + kstep, voffB); PG8_STAGE(PG8_SA(1, 0), cA + kstep, voffA); PG8_STAGE(PG8_SB(1, 1), cB + hstep + kstep, voffB);
        PG8_WAIT_V(6); PG8_BAR;
    }
    for (;;) {
        const bool has_next = S.next(ui + 1, nxt);
        const char* nA = has_next ? (const char*)g.A + (size_t)nxt.pm * tstep : cA; const char* nB = has_next ? (const char*)g.Bt + (size_t)nxt.pn * tstep : cB;
        for (int t = 0; t < nt; t += 2) {
            if constexpr (Epi::KHOOK) { if (E.khook_at(t)) E.khook(acc, cur, t, wr, wc, fr, fq); }
            const bool last = (t == nt - 2);
            const char* a1 = cA + (size_t)(t + 1) * kstep;
            const char* a2 = last ? nA : cA + (size_t)(t + 2) * kstep; const char* b2 = last ? nB : cB + (size_t)(t + 2) * kstep;
            const char* a3 = a2 + kstep; const char* b3 = b2 + kstep;
            if (last && has_next) S.a_ready(nxt);
            if constexpr (SP2) {
            PG8_LDB(B0, 0, 0); PG8_LDB(B1, 0, 1); PG8_SCHED; PG8_LDA(At, 0, 0); PG8_STAGE(PG8_SA(1, 1), a1 + hstep, voffA);
            PG8_WAIT_V(8); PG8_WAIT_L(0); PG8_BAR; PG8_MMA(0, 0, At, B0); PG8_MMA(0, 1, At, B1); PG8_BAR; PG8_SCHED;
            PG8_LDA(At, 0, 1); PG8_STAGE(PG8_SB(0, 0), b2, voffB); PG8_STAGE(PG8_SB(0, 1), b2 + hstep, voffB); PG8_STAGE(PG8_SA(0, 0), a2, voffA);
            PG8_WAIT_V(8); PG8_WAIT_L(0); PG8_BAR; PG8_MMA(1, 0, At, B0); PG8_MMA(1, 1, At, B1); PG8_BAR; PG8_SCHED;
            PG8_LDB(B0, 1, 0); PG8_LDB(B1, 1, 1); PG8_SCHED; PG8_LDA(At, 1, 0); PG8_STAGE(PG8_SA(0, 1), a2 + hstep, voffA);
            PG8_WAIT_V(8); PG8_WAIT_L(0); PG8_BAR; PG8_MMA(0, 0, At, B0); PG8_MMA(0, 1, At, B1); PG8_BAR; PG8_SCHED;
            PG8_LDA(At, 1, 1); PG8_STAGE(PG8_SB(1, 0), b3, voffB); PG8_STAGE(PG8_SB(1, 1), b3 + hstep, voffB); PG8_STAGE(PG8_SA(1, 0), a3, voffA);
            PG8_WAIT_V(8); PG8_WAIT_L(0); PG8_BAR; PG8_MMA(1, 0, At, B0); PG8_MMA(1, 1, At, B1); PG8_BAR; PG8_SCHED;
            } else {
            PG8_LDB(B0, 0, 0); PG8_SCHED; PG8_LDA(At, 0, 0); PG8_STAGE(PG8_SA(1, 1), a1 + hstep, voffA);
            PG8_WAIT_L(8); PG8_BAR; PG8_WAIT_L(0); PG8_MMA(0, 0, At, B0); PG8_BAR; PG8_SCHED;
            PG8_LDB(B1, 0, 1); PG8_STAGE(PG8_SB(0, 0), b2, voffB);
            PG8_BAR; PG8_WAIT_L(0); PG8_MMA(0, 1, At, B1); PG8_BAR;
            PG8_LDA(At, 0, 1); PG8_STAGE(PG8_SA(0, 0), a2, voffA);
            PG8_BAR; PG8_WAIT_L(0); PG8_MMA(1, 0, At, B0); PG8_BAR; PG8_SCHED;
            PG8_STAGE(PG8_SB(0, 1), b2 + hstep, voffB);
            PG8_WAIT_V(6); PG8_BAR; PG8_MMA(1, 1, At, B1); PG8_BAR;
            PG8_LDB(B0, 1, 0); PG8_SCHED; PG8_LDA(At, 1, 0); PG8_STAGE(PG8_SA(0, 1), a2 + hstep, voffA);
            PG8_WAIT_L(8); PG8_BAR; PG8_WAIT_L(0); PG8_MMA(0, 0, At, B0); PG8_BAR; PG8_SCHED;
            PG8_LDB(B1, 1, 1); PG8_STAGE(PG8_SB(1, 0), b3, voffB);
            PG8_BAR; PG8_WAIT_L(0); PG8_MMA(0, 1, At, B1); PG8_BAR;
            PG8_LDA(At, 1, 1); PG8_STAGE(PG8_SA(1, 0), a3, voffA);
            PG8_BAR; PG8_WAIT_L(0); PG8_MMA(1, 0, At, B0); PG8_BAR; PG8_SCHED;
            PG8_STAGE(PG8_SB(1, 1), b3 + hstep, voffB);
            PG8_WAIT_V(6); PG8_BAR; PG8_MMA(1, 1, At, B1); PG8_BAR;
            }
        }
        if constexpr (ALIGN_EPI) { if (wr == 0) PG8_BAR; }
        if constexpr (!Epi::AFTER_DRAIN) { E(acc, cur, wr, wc, fr, fq); S.done(cur); }
        if (!has_next) break;
#pragma unroll
        for (int a = 0; a < 2; ++a)
#pragma unroll
            for (int b = 0; b < 2; ++b)
#pragma unroll
                for (int m = 0; m < 4; ++m)
#pragma unroll
                    for (int n = 0; n < 2; ++n) acc[a][b][m][n] = (f32x4){0.f, 0.f, 0.f, 0.f};
        cur = nxt; cA = nA; cB = nB; ++ui;
        if constexpr (ALIGN_EPI) { if (wr == 1) PG8_BAR; }
    }
    PG8_WAIT_V(0);
    if constexpr (!ALIGN_EPI) { if (wr == 0) PG8_BAR; }
    PG8_BAR;
    if constexpr (Epi::AFTER_DRAIN) { E.fused(acc, cur, wr, wc, fr, fq, lds, wid, lane); S.done(cur); }
#undef PG8_SA
#undef PG8_SB
#undef PG8_STAGE
#undef PG8_LDA
#undef PG8_LDB
#undef PG8_MMA
#undef PG8_WAIT_V
#undef PG8_WAIT_L
#undef PG8_BAR
#undef PG8_SCHED
}
}
#ifndef PROBE_SUB
#define PROBE_SUB 0
#endif
#ifndef PROBE_DUP
#define PROBE_DUP 0
#endif
#ifndef PROBE_DUPK
#define PROBE_DUPK -1
#endif
#ifndef PROBE_PRO
#define PROBE_PRO 0
#endif
#define LAS __attribute__((address_space(3)))
typedef unsigned short bf16;
typedef float f32x4 __attribute__((ext_vector_type(4)));
typedef unsigned u32x4 __attribute__((ext_vector_type(4)));
typedef unsigned u32x2 __attribute__((ext_vector_type(2)));

constexpr int BATCH = 4, SEQ = 2048, DM = 2048, M = BATCH * SEQ, DEPTH = 2;
constexpr int NIN = 15664, NP = 15872, DFF = 8192;
constexpr int OFF_BQ = 4608, OFF_BKV = 5632, OFF_BG = 6400, OFF_CQ = 6448, OFF_CK = 7472, OFF_CV = 8496, OFF_MG = 9520;
constexpr int BT = 2112;
constexpr int NCMP = 127;
constexpr size_t MiB = 1u << 20;
constexpr size_t WS_WT = 0, LAYER_W = 144 * MiB;
constexpr size_t WO_IN = 0, WO_A = 62 * MiB, WO_B = 64 * MiB, WO_C = 68 * MiB, WO_OUT = 72 * MiB, WO_UP = 80 * MiB, WO_DOWN = 112 * MiB;
constexpr size_t WS_H = 288 * MiB, WS_PROJ = 320 * MiB, WS_U = WS_PROJ;
constexpr size_t WS_OA = 568 * MiB, WS_OB = 576 * MiB, WS_OC = 592 * MiB, WS_OCMP = 608 * MiB;
constexpr size_t WS_MIXF = 640 * MiB, WS_MIXB = 704 * MiB, WS_Y = 736 * MiB;
constexpr size_t WS_KC = 800 * MiB, WS_VC = 801 * MiB, WS_SELM = 802 * MiB, WS_BIAST = 803 * MiB, WS_CW = 804 * MiB, WS_BAR = 812 * MiB, WS_END = 813 * MiB;
constexpr int LDS_BYTES = 147456;
constexpr int PH_PER_LAYER = 9;
constexpr int NPH = 1 + DEPTH * PH_PER_LAYER;

struct Args { const float* in[21]; float* out; unsigned char* ws; int ph_lo, ph_hi; };
constexpr int PTAB_OFF = 131072 + 1024;
struct PT { const unsigned long long* t;
    __device__ __forceinline__ unsigned long long get(int i) const { const unsigned long long v = t[i]; const unsigned lo = __builtin_amdgcn_readfirstlane((unsigned)v), hi = __builtin_amdgcn_readfirstlane((unsigned)(v >> 32)); return ((unsigned long long)hi << 32) | lo; }
    __device__ __forceinline__ const float* in(int i) const { return (const float*)(const __attribute__((address_space(1))) float*)get(i); }
    __device__ __forceinline__ float* out() const { return (float*)(__attribute__((address_space(1))) float*)get(21); }
    __device__ __forceinline__ unsigned char* ws() const { return (unsigned char*)(__attribute__((address_space(1))) unsigned char*)get(22); } };

#define LDS_FENCE() asm volatile("s_waitcnt lgkmcnt(0)" ::: "memory")

__device__ __forceinline__ unsigned f2bf(float f) { unsigned u = __builtin_bit_cast(unsigned, f); return (u + 0x7fffu + ((u >> 16) & 1u)) >> 16; }
__device__ __forceinline__ unsigned pk2(float lo, float hi) { return f2bf(lo) | (f2bf(hi) << 16); }
typedef __bf16 bf16v2_t __attribute__((ext_vector_type(2)));
typedef float f32v2_t __attribute__((ext_vector_type(2)));
__device__ __forceinline__ unsigned pkh(float lo, float hi) { f32v2_t v; v.x = lo; v.y = hi; return __builtin_bit_cast(unsigned, __builtin_convertvector(v, bf16v2_t)); }
__device__ __forceinline__ float bf_lo(unsigned w) { return __uint_as_float(w << 16); }
__device__ __forceinline__ float bf_hi(unsigned w) { return __uint_as_float(w & 0xffff0000u); }
__device__ __forceinline__ float bf2f(bf16 h) { return __uint_as_float(((unsigned)h) << 16); }
__device__ __forceinline__ float wave_sum(float v) {
#pragma unroll
    for (int o = 32; o >= 1; o >>= 1) v += __shfl_xor(v, o);
    return v;
}
__device__ __forceinline__ float wave_max(float v) {
#pragma unroll
    for (int o = 32; o >= 1; o >>= 1) v = fmaxf(v, __shfl_xor(v, o));
    return v;
}
__device__ __forceinline__ float sigmoidf_(float x) { return 1.0f / (1.0f + __expf(-x)); }

__device__ __forceinline__ void load64(const bf16* p, float (&q)[64]) {
    const u32x4* p4 = (const u32x4*)p;
#pragma unroll
    for (int i = 0; i < 8; ++i) { const u32x4 w = p4[i];
        q[8 * i + 0] = bf_lo(w.x); q[8 * i + 1] = bf_hi(w.x); q[8 * i + 2] = bf_lo(w.y); q[8 * i + 3] = bf_hi(w.y);
        q[8 * i + 4] = bf_lo(w.z); q[8 * i + 5] = bf_hi(w.z); q[8 * i + 6] = bf_lo(w.w); q[8 * i + 7] = bf_hi(w.w); }
}
__device__ __forceinline__ float dot64(const float (&q)[64], const bf16* k) {
    const u32x4* k4 = (const u32x4*)k; float a0 = 0.f, a1 = 0.f;
#pragma unroll
    for (int i = 0; i < 8; ++i) { const u32x4 w = k4[i];
        a0 += q[8 * i + 0] * bf_lo(w.x); a1 += q[8 * i + 1] * bf_hi(w.x); a0 += q[8 * i + 2] * bf_lo(w.y); a1 += q[8 * i + 3] * bf_hi(w.y);
        a0 += q[8 * i + 4] * bf_lo(w.z); a1 += q[8 * i + 5] * bf_hi(w.z); a0 += q[8 * i + 6] * bf_lo(w.w); a1 += q[8 * i + 7] * bf_hi(w.w); }
    return a0 + a1;
}
__device__ __forceinline__ float wave_softmax(float* S, int n, int lane, float& mout) {
    float m = -3.0e38f;
    for (int i = lane; i < n; i += 64) m = fmaxf(m, S[i]);
    m = wave_max(m);
    float s = 0.f;
    for (int i = lane; i < n; i += 64) { const float e = __expf(S[i] - m); S[i] = e; s += e; }
    s = wave_sum(s); mout = m; return s;
}

struct TItem { const float* W; bf16* WT; int K, N, item, pitch; };
struct TRegs { f32x4 v0[8], v1[8]; };
__device__ __forceinline__ void titem_load(const TItem& t, TRegs& R, int lane) {
    const int nblk = (t.N + 63) / 64, kb = t.item / nblk, nb = t.item % nblk, k0 = 64 * kb, n0 = 64 * nb;
    const int rg = lane >> 4, c4 = lane & 15, nn = n0 + 4 * c4; const bool ok = nn < t.N;
#pragma unroll
    for (int i = 0; i < 8; ++i) { const float* p = t.W + (size_t)(k0 + 8 * i + 2 * rg) * t.N + nn;
        R.v0[i] = ok ? *(const f32x4*)p : (f32x4){0.f, 0.f, 0.f, 0.f}; R.v1[i] = ok ? *(const f32x4*)(p + t.N) : (f32x4){0.f, 0.f, 0.f, 0.f}; }
}
__device__ __forceinline__ void titem_store(const TItem& t, const TRegs& R, float* scrf, int lane) {
    unsigned* scr = (unsigned*)scrf;
    const int nblk = (t.N + 63) / 64, kb = t.item / nblk, nb = t.item % nblk, k0 = 64 * kb, n0 = 64 * nb;
    const int rg = lane >> 4, c4 = lane & 15;
#pragma unroll
    for (int i = 0; i < 8; ++i) { unsigned* q = scr + (4 * i + rg) * 66 + 4 * c4;
        q[0] = pkh(R.v0[i].x, R.v1[i].x); q[1] = pkh(R.v0[i].y, R.v1[i].y); q[2] = pkh(R.v0[i].z, R.v1[i].z); q[3] = pkh(R.v0[i].w, R.v1[i].w); }
    LDS_FENCE();
    const int c = lane & 7;
#pragma unroll
    for (int j = 0; j < 8; ++j) { const int n = (lane >> 3) + 8 * j; const unsigned* s = scr + (4 * c) * 66 + n;
        u32x4 o; o.x = s[0]; o.y = s[66]; o.z = s[132]; o.w = s[198];
        *(u32x4*)(t.WT + (size_t)(n0 + n) * t.pitch + k0 + 8 * c) = o; }
    LDS_FENCE();
}
__device__ __forceinline__ int t5_bucket(int d) {
    if (d < 16) return d;
    const float logd = logf((float)d / 16.0f);
    int far = 16 + (int)(logd / 4.852030263919617f * 16.0f);
    return far < 31 ? far : 31;
}
__device__ __forceinline__ void rms_row_to_bf16(const float* xrow, const float* gain, bf16* orow, int lane) {
    const f32x4* xr = (const f32x4*)xrow + lane; const f32x4* gr = (const f32x4*)gain + lane;
    f32x4 v[8]; float s = 0.f;
#pragma unroll
    for (int j = 0; j < 8; ++j) { v[j] = xr[64 * j]; s += (v[j].x * v[j].x + v[j].y * v[j].y) + (v[j].z * v[j].z + v[j].w * v[j].w); }
    const float r = 1.0f / sqrtf(wave_sum(s) * (1.0f / DM) + 1e-6f);
    u32x2* o8 = (u32x2*)orow + lane;
#pragma unroll
    for (int j = 0; j < 8; ++j) { const f32x4 g = gr[64 * j]; u32x2 w; w.x = pk2(v[j].x * r * g.x, v[j].y * r * g.y); w.y = pk2(v[j].z * r * g.z, v[j].w * r * g.w); o8[64 * j] = w; }
}
__device__ __forceinline__ void rowpass_row(const float* xi, const bf16* y, const float* gp, const float* gn, float* xo, bf16* h, int lane) {
    const u32x2* yr = (const u32x2*)y + lane; const f32x4* xr = (const f32x4*)xi + lane; const f32x4* gpr = (const f32x4*)gp + lane;
    f32x4 v[8]; float s = 0.f;
#pragma unroll
    for (int j = 0; j < 8; ++j) { const u32x2 w = yr[64 * j]; v[j].x = bf_lo(w.x); v[j].y = bf_hi(w.x); v[j].z = bf_lo(w.y); v[j].w = bf_hi(w.y); s += (v[j].x * v[j].x + v[j].y * v[j].y) + (v[j].z * v[j].z + v[j].w * v[j].w); }
    const float r = 1.0f / sqrtf(wave_sum(s) * (1.0f / DM) + 1e-6f);
    float s2 = 0.f;
#pragma unroll
    for (int j = 0; j < 8; ++j) { const f32x4 g = gpr[64 * j]; const f32x4 x = xr[64 * j]; v[j] = x + v[j] * r * g; s2 += (v[j].x * v[j].x + v[j].y * v[j].y) + (v[j].z * v[j].z + v[j].w * v[j].w); }
    f32x4* xw = (f32x4*)xo + lane;
#pragma unroll
    for (int j = 0; j < 8; ++j) xw[64 * j] = v[j];
    if (gn) {
        const float r2 = 1.0f / sqrtf(wave_sum(s2) * (1.0f / DM) + 1e-6f);
        const f32x4* gnr = (const f32x4*)gn + lane; u32x2* o8 = (u32x2*)h + lane;
#pragma unroll
        for (int j = 0; j < 8; ++j) { const f32x4 g = gnr[64 * j]; u32x2 w; w.x = pk2(v[j].x * r2 * g.x, v[j].y * r2 * g.y); w.y = pk2(v[j].z * r2 * g.z, v[j].w * r2 * g.w); o8[64 * j] = w; }
    }
}

constexpr int IT_IN = 32 * 245, IT_A = 8 * 32, IT_B = 16 * 32, IT_C = 16 * 32, IT_OUT = 32 * 32, IT_UP = 32 * 128, IT_DOWN = 128 * 32;
constexpr int IT_W1 = 32 * 4, IT_W2 = 4 * 1;
constexpr int IT_LAYER = IT_IN + IT_A + IT_B + IT_C + IT_OUT + IT_UP + IT_DOWN + 2 * IT_W1 + 2 * IT_W2;

__device__ __forceinline__ TItem decode_item(const PT a, unsigned char* ws, int it) {
    const int l = it / IT_LAYER; int r = it % IT_LAYER;
    unsigned char* wl = ws + WS_WT + (size_t)l * LAYER_W; unsigned char* cw = ws + WS_CW + (size_t)l * 4 * MiB;
    TItem t;
    if (r < IT_IN) { t.W = a.in(2) + (size_t)l * DM * NIN; t.K = DM; t.N = NIN; t.WT = (bf16*)(wl + WO_IN); t.item = r; t.pitch = t.K; return t; } r -= IT_IN;
    if (r < IT_A) { t.W = a.in(11) + (size_t)l * 512 * DM; t.K = 512; t.N = DM; t.WT = (bf16*)(wl + WO_A); t.item = r; t.pitch = 2560; return t; } r -= IT_A;
    if (r < IT_B) { t.W = a.in(12) + (size_t)l * 1024 * DM; t.K = 1024; t.N = DM; t.WT = (bf16*)(wl + WO_A) + 512; t.item = r; t.pitch = 2560; return t; } r -= IT_B;
    if (r < IT_C) { t.W = a.in(13) + (size_t)l * 1024 * DM; t.K = 1024; t.N = DM; t.WT = (bf16*)(wl + WO_A) + 1536; t.item = r; t.pitch = 2560; return t; } r -= IT_C;
    if (r < IT_OUT) { t.W = a.in(14) + (size_t)l * DM * DM; t.K = DM; t.N = DM; t.WT = (bf16*)(wl + WO_OUT); t.item = r; t.pitch = t.K; return t; } r -= IT_OUT;
    if (r < IT_UP) { t.W = a.in(19) + (size_t)l * DM * DFF; t.K = DM; t.N = DFF; t.WT = (bf16*)(wl + WO_UP); t.item = r; t.pitch = t.K; return t; } r -= IT_UP;
    if (r < IT_DOWN) { t.W = a.in(20) + (size_t)l * DFF * DM; t.K = DFF; t.N = DM; t.WT = (bf16*)(wl + WO_DOWN); t.item = r; t.pitch = t.K; return t; } r -= IT_DOWN;
    if (r < IT_W1) { t.W = a.in(5) + (size_t)l * 2048 * 256; t.K = 2048; t.N = 256; t.WT = (bf16*)cw; t.item = r; t.pitch = t.K; return t; } r -= IT_W1;
    if (r < IT_W1) { t.W = a.in(7) + (size_t)l * 2048 * 256; t.K = 2048; t.N = 256; t.WT = (bf16*)(cw + MiB); t.item = r; t.pitch = t.K; return t; } r -= IT_W1;
    if (r < IT_W2) { t.W = a.in(6) + (size_t)l * 256 * 64; t.K = 256; t.N = 64; t.WT = (bf16*)(cw + 2 * MiB); t.item = r; t.pitch = t.K; return t; } r -= IT_W2;
    t.W = a.in(8) + (size_t)l * 256 * 64; t.K = 256; t.N = 64; t.WT = (bf16*)(cw + 2 * MiB + 65536); t.item = r; t.pitch = t.K; return t;
}
__device__ __forceinline__ void phase_prologue(const PT a, float* ldsf, int lane, int wave, int gw, int ngw) {
    float* scr = ldsf + wave * 4096;
    unsigned char* ws = a.ws();
    constexpr int NIT = DEPTH * IT_LAYER;
    if (gw < NIT) {
        int it = gw; TItem cur = decode_item(a, ws, it); TRegs R; titem_load(cur, R, lane);
        for (;;) {
            const int nx = it + ngw; const bool more = nx < NIT;
            TItem nxt = cur; TRegs R2 = R;
            if (more) { nxt = decode_item(a, ws, nx); titem_load(nxt, R2, lane); }
            titem_store(cur, R, scr, lane);
            if (!more) break;
            cur = nxt; R = R2; it = nx;
        }
    }
    float* biasT = (float*)(ws + WS_BIAST);
    for (int i = gw * 64 + lane; i < 48 * BT; i += ngw * 64) { const int col = i / BT, d = i % BT; biasT[i] = a.in(1)[t5_bucket(d) * 48 + col]; }
    for (int m = gw; m < M; m += ngw) rms_row_to_bf16(a.in(0) + (size_t)m * DM, a.in(15), (bf16*)(ws + WS_H) + (size_t)m * DM, lane);
}

struct EpiAny { static constexpr bool PERM = true, AFTER_DRAIN = false, KHOOK = true;
    int mode; bf16* ob; float* of; const bf16* proj;
    __device__ __forceinline__ bool khook_at(int t) const { return mode == 6 && (t == 8 || t == 24); }
    __device__ __forceinline__ void khook(pg8::f32x4 (&acc)[2][2][4][2], const pg8::Unit& u, int t, int wr, int wc, int fr, int fq) const {
        const int step = (t == 8) ? 0 : 1;
        { int tl = (int)threadIdx.x; asm volatile("" : "+v"(tl)); fr = tl & 15; fq = (tl >> 4) & 3; }
#pragma unroll
        for (int ai = 0; ai < 2; ++ai) {
                u32x2 zc[16], zn[16];
#pragma unroll
                for (int q = 0; q < 16; ++q) { const int m = q >> 2, bj = (q >> 1) & 1, n = q & 1;
                    const int row = u.pm * 256 + ai * 128 + wr * 64 + m * 16 + fr, col = u.pn * 256 + bj * 128 + wc * 32 + 8 * fq + 4 * n;
                    const bf16* gp = proj + (size_t)row * NP + OFF_MG + step * DM + col; zc[q] = *(const u32x2*)gp; zn[q] = *(const u32x2*)(gp + DM); }
#pragma unroll
                for (int q = 0; q < 16; ++q) { const int m = q >> 2, bj = (q >> 1) & 1, n = q & 1;
                    pg8::f32x4 t0 = acc[ai][bj][m][n];
                    t0[0] *= (1.f + __expf(-bf_lo(zn[q].x))) * __builtin_amdgcn_rcpf(1.f + __expf(-bf_lo(zc[q].x))); t0[1] *= (1.f + __expf(-bf_hi(zn[q].x))) * __builtin_amdgcn_rcpf(1.f + __expf(-bf_hi(zc[q].x)));
                    t0[2] *= (1.f + __expf(-bf_lo(zn[q].y))) * __builtin_amdgcn_rcpf(1.f + __expf(-bf_lo(zc[q].y))); t0[3] *= (1.f + __expf(-bf_hi(zn[q].y))) * __builtin_amdgcn_rcpf(1.f + __expf(-bf_hi(zc[q].y)));
                    acc[ai][bj][m][n] = t0; }
                asm volatile("" ::: "memory"); }
    }
    __device__ __forceinline__ void store8(int row, int col, f32x4 v0, f32x4 v1, u32x4 gpre) const {
        u32x4 w;
        if (mode == 0) { w.x = pkh(v0.x, v0.y); w.y = pkh(v0.z, v0.w); w.z = pkh(v1.x, v1.y); w.w = pkh(v1.z, v1.w); *(u32x4*)(ob + (size_t)row * NP + col) = w; }
        else if (mode == 4) { w.x = pkh(v0.x, v0.y); w.y = pkh(v0.z, v0.w); w.z = pkh(v1.x, v1.y); w.w = pkh(v1.z, v1.w); *(u32x4*)(ob + (size_t)row * DM + col) = w; }
        else if (mode == 5) {
            v0.x = fmaxf(v0.x, 0.f); v0.y = fmaxf(v0.y, 0.f); v0.z = fmaxf(v0.z, 0.f); v0.w = fmaxf(v0.w, 0.f); v1.x = fmaxf(v1.x, 0.f); v1.y = fmaxf(v1.y, 0.f); v1.z = fmaxf(v1.z, 0.f); v1.w = fmaxf(v1.w, 0.f);
            w.x = pkh(v0.x * v0.x, v0.y * v0.y); w.y = pkh(v0.z * v0.z, v0.w * v0.w); w.z = pkh(v1.x * v1.x, v1.y * v1.y); w.w = pkh(v1.z * v1.z, v1.w * v1.w); *(u32x4*)(ob + (size_t)row * DFF + col) = w; }
        else if (mode == 6) {
            const u32x4 gw_ = gpre;
            w.x = pkh(sigmoidf_(bf_lo(gw_.x)) * v0.x, sigmoidf_(bf_hi(gw_.x)) * v0.y); w.y = pkh(sigmoidf_(bf_lo(gw_.y)) * v0.z, sigmoidf_(bf_hi(gw_.y)) * v0.w);
            w.z = pkh(sigmoidf_(bf_lo(gw_.z)) * v1.x, sigmoidf_(bf_hi(gw_.z)) * v1.y); w.w = pkh(sigmoidf_(bf_lo(gw_.w)) * v1.z, sigmoidf_(bf_hi(gw_.w)) * v1.w);
            *(u32x4*)(ob + (size_t)row * DM + col) = w; }
        else {
            const u32x4 gw_ = *(const u32x4*)(proj + (size_t)row * NP + OFF_MG + (mode - 1) * DM + col);
            f32x4 r0, r1;
            r0.x = sigmoidf_(bf_lo(gw_.x)) * v0.x; r0.y = sigmoidf_(bf_hi(gw_.x)) * v0.y; r0.z = sigmoidf_(bf_lo(gw_.y)) * v0.z; r0.w = sigmoidf_(bf_hi(gw_.y)) * v0.w;
            r1.x = sigmoidf_(bf_lo(gw_.z)) * v1.x; r1.y = sigmoidf_(bf_hi(gw_.z)) * v1.y; r1.z = sigmoidf_(bf_lo(gw_.w)) * v1.z; r1.w = sigmoidf_(bf_hi(gw_.w)) * v1.w;
            u32x4* mp = (u32x4*)(ob + (size_t)row * DM + col);
            if (mode != 1) { const u32x4 o = *mp; r0.x += bf_lo(o.x); r0.y += bf_hi(o.x); r0.z += bf_lo(o.y); r0.w += bf_hi(o.y); r1.x += bf_lo(o.z); r1.y += bf_hi(o.z); r1.z += bf_lo(o.w); r1.w += bf_hi(o.w); }
            w.x = pkh(r0.x, r0.y); w.y = pkh(r0.z, r0.w); w.z = pkh(r1.x, r1.y); w.w = pkh(r1.z, r1.w); *mp = w;
        }
    }
    __device__ __forceinline__ void operator()(const pg8::f32x4 (&acc)[2][2][4][2], const pg8::Unit& u, int wr, int wc, int fr, int fq) const {
#pragma unroll
        for (int ai = 0; ai < 2; ++ai)
#pragma unroll
            for (int mp = 0; mp < 2; ++mp) {
                u32x4 gpre[4];
#pragma unroll
                for (int q = 0; q < 4; ++q) { const int m = 2 * mp + (q >> 1), bj = q & 1; const int row = u.pm * 256 + ai * 128 + wr * 64 + m * 16 + fr, col = u.pn * 256 + bj * 128 + wc * 32 + 8 * fq;
                    gpre[q] = (mode == 6) ? *(const u32x4*)(proj + (size_t)row * NP + OFF_MG + 2 * DM + col) : (u32x4){0u, 0u, 0u, 0u}; }
#pragma unroll
                for (int q = 0; q < 4; ++q) { const int m = 2 * mp + (q >> 1), bj = q & 1; const int row = u.pm * 256 + ai * 128 + wr * 64 + m * 16 + fr, col = u.pn * 256 + bj * 128 + wc * 32 + 8 * fq;
                    const pg8::f32x4 t0 = acc[ai][bj][m][0], t1 = acc[ai][bj][m][1];
                    f32x4 v0, v1; v0.x = t0[0]; v0.y = t0[1]; v0.z = t0[2]; v0.w = t0[3]; v1.x = t1[0]; v1.y = t1[1]; v1.z = t1[2]; v1.w = t1[3]; store8(row, col, v0, v1, gpre[q]); }
                asm volatile("" ::: "memory"); }
    } };


constexpr int KCAT = 2560;
typedef short bf16x8 __attribute__((ext_vector_type(8)));
typedef short bf16x4 __attribute__((ext_vector_type(4)));
typedef float f32x16 __attribute__((ext_vector_type(16)));
#define MFMA32(a, b, c) __builtin_amdgcn_mfma_f32_32x32x16_bf16(a, b, c, 0, 0, 0)

template <int KW, int NDS> struct KVRegs { u32x4 k[KW / 64]; u32x4 v[NDS / 2]; };

template <int KW, int NDS> __device__ __forceinline__ void load_tile(KVRegs<KW, NDS>& R, const bf16* base_b, int tok0, int tstride, int kcol, int vcol, int tid) {
#pragma unroll
    for (int r = 0; r < KW / 64; ++r) { const int idx = tid + 512 * r, key = idx / (KW / 8), ch = idx % (KW / 8);
        R.k[r] = *(const u32x4*)(base_b + (size_t)(tok0 + key * tstride) * NP + kcol + ch * 8); }
#pragma unroll
    for (int r = 0; r < NDS / 2; ++r) { const int idx = tid + 512 * r, key = idx & 63, ch = idx >> 6;
        R.v[r] = *(const u32x4*)(base_b + (size_t)(tok0 + key * tstride) * NP + vcol + ch * 8); }
}
template <int KW, int NDS> __device__ __forceinline__ void store_tile(const KVRegs<KW, NDS>& R, bf16* Ks, bf16* Vt, int tid) {
#pragma unroll
    for (int r = 0; r < KW / 64; ++r) { const int idx = tid + 512 * r, key = idx / (KW / 8), ch = idx % (KW / 8);
        *(u32x4*)(Ks + key * (KW + 8) + ch * 8) = R.k[r]; }
#pragma unroll
    for (int r = 0; r < NDS / 2; ++r) { const int idx = tid + 512 * r, key = idx & 63, ch = idx >> 6; const u32x4 w = R.v[r]; bf16* p = Vt + (ch * 8) * 68 + key;
        p[0 * 68] = (bf16)(w.x & 0xffffu); p[1 * 68] = (bf16)(w.x >> 16); p[2 * 68] = (bf16)(w.y & 0xffffu); p[3 * 68] = (bf16)(w.y >> 16);
        p[4 * 68] = (bf16)(w.z & 0xffffu); p[5 * 68] = (bf16)(w.z >> 16); p[6 * 68] = (bf16)(w.w & 0xffffu); p[7 * 68] = (bf16)(w.w >> 16); }
}
constexpr float LOG2E = 1.4426950408889634f;
constexpr float QSCALE2 = 0.125f * LOG2E;
__device__ __forceinline__ void load_qfrag(const bf16* qrow, int hi, bf16x8 (&qf)[4], float sc) {
#pragma unroll
    for (int c = 0; c < 4; ++c) { const u32x4 w = *(const u32x4*)(qrow + c * 16 + hi * 8); u32x4 o;
        o.x = pkh(bf_lo(w.x) * sc, bf_hi(w.x) * sc); o.y = pkh(bf_lo(w.y) * sc, bf_hi(w.y) * sc);
        o.z = pkh(bf_lo(w.z) * sc, bf_hi(w.z) * sc); o.w = pkh(bf_lo(w.w) * sc, bf_hi(w.w) * sc);
        qf[c] = __builtin_bit_cast(bf16x8, o); }
}
template <int KP, int NDS> __device__ __forceinline__ void attn_tile(const bf16x8 (&qf)[4], const bf16* Ks, const bf16* Vt, float& m, float& l, f32x16 (&O)[NDS],
                                                                       const float* tab, int dq, int maxd, bool tile_ok, int pmode, float cb, int l32, int hi) {
    f32x16 s0, s1;
#pragma unroll
    for (int i = 0; i < 16; ++i) { s0[i] = 0.f; s1[i] = 0.f; }
#pragma unroll
    for (int c = 0; c < 4; ++c) { const bf16x8 a0 = *(const bf16x8*)(Ks + l32 * KP + c * 16 + hi * 8); const bf16x8 a1 = *(const bf16x8*)(Ks + (32 + l32) * KP + c * 16 + hi * 8);
        s0 = MFMA32(a0, qf[c], s0); s1 = MFMA32(a1, qf[c], s1); }
    float mx = -1e30f, sub;
    if (pmode == 2) {
#pragma unroll
        for (int i = 0; i < 16; ++i) mx = fmaxf(mx, fmaxf(s0[i], s1[i]));
        mx = fmaxf(mx, __shfl_xor(mx, 32)) + cb;
    } else if (pmode == 1) {
        const float* tp = tab + (dq - 4 * hi);
#pragma unroll
        for (int h4 = 0; h4 < 4; ++h4) { float bb[4];
#pragma unroll
            for (int j = 0; j < 4; ++j) bb[j] = tp[-(h4 * 8 + j)];
#pragma unroll
            for (int j = 0; j < 4; ++j) { const int i = 4 * h4 + j; s0[i] = tile_ok ? s0[i] + bb[j] : -INFINITY; mx = fmaxf(mx, s0[i]); } }
#pragma unroll
        for (int h4 = 0; h4 < 4; ++h4) { float bb[4];
#pragma unroll
            for (int j = 0; j < 4; ++j) bb[j] = tp[-(32 + h4 * 8 + j)];
#pragma unroll
            for (int j = 0; j < 4; ++j) { const int i = 4 * h4 + j; s1[i] = tile_ok ? s1[i] + bb[j] : -INFINITY; mx = fmaxf(mx, s1[i]); } }
        mx = fmaxf(mx, __shfl_xor(mx, 32));
    } else {
        const int dq4 = dq - 4 * hi, cl = maxd < 2047 ? maxd : 2047;
#pragma unroll
        for (int h4 = 0; h4 < 4; ++h4) { float bb[4];
#pragma unroll
            for (int j = 0; j < 4; ++j) { const int d0 = dq4 - (h4 * 8 + j); bb[j] = tab[d0 < 0 ? 0 : (d0 > cl ? cl : d0)]; }
#pragma unroll
            for (int j = 0; j < 4; ++j) { const int i = 4 * h4 + j; const int d0 = dq4 - (h4 * 8 + j); const bool v0 = tile_ok && (unsigned)d0 <= (unsigned)maxd;
                s0[i] = v0 ? s0[i] + bb[j] : -INFINITY; mx = fmaxf(mx, s0[i]); } }
#pragma unroll
        for (int h4 = 0; h4 < 4; ++h4) { float bb[4];
#pragma unroll
            for (int j = 0; j < 4; ++j) { const int d1 = dq4 - 32 - (h4 * 8 + j); bb[j] = tab[d1 < 0 ? 0 : (d1 > cl ? cl : d1)]; }
#pragma unroll
            for (int j = 0; j < 4; ++j) { const int i = 4 * h4 + j; const int d1 = dq4 - 32 - (h4 * 8 + j); const bool v1 = tile_ok && (unsigned)d1 <= (unsigned)maxd;
                s1[i] = v1 ? s1[i] + bb[j] : -INFINITY; mx = fmaxf(mx, s1[i]); } }
        mx = fmaxf(mx, __shfl_xor(mx, 32));
    }
    const float mn = fmaxf(m, mx), alpha = __builtin_amdgcn_exp2f(m - mn);
    const bool resc = __any(mn != m);
    m = mn; sub = (pmode == 2) ? mn - cb : mn;
    s0 = s0 - sub; s1 = s1 - sub;
#pragma unroll
    for (int i = 0; i < 16; ++i) { s0[i] = __builtin_amdgcn_exp2f(s0[i]); s1[i] = __builtin_amdgcn_exp2f(s1[i]); }
    const f32x16 ss = s0 + s1;
    const float rs = ((ss[0] + ss[1]) + (ss[2] + ss[3])) + ((ss[4] + ss[5]) + (ss[6] + ss[7])) + (((ss[8] + ss[9]) + (ss[10] + ss[11])) + ((ss[12] + ss[13]) + (ss[14] + ss[15])));
    l = l * alpha + rs;
    if (resc) {
#pragma unroll
        for (int ds = 0; ds < NDS; ++ds)
#pragma unroll
            for (int i = 0; i < 16; ++i) O[ds][i] *= alpha;
    }
#pragma unroll
    for (int c = 0; c < 4; ++c) {
        u32x4 pw;
        if (c == 0) { pw.x = pkh(s0[0], s0[1]); pw.y = pkh(s0[2], s0[3]); pw.z = pkh(s0[4], s0[5]); pw.w = pkh(s0[6], s0[7]); }
        else if (c == 1) { pw.x = pkh(s0[8], s0[9]); pw.y = pkh(s0[10], s0[11]); pw.z = pkh(s0[12], s0[13]); pw.w = pkh(s0[14], s0[15]); }
        else if (c == 2) { pw.x = pkh(s1[0], s1[1]); pw.y = pkh(s1[2], s1[3]); pw.z = pkh(s1[4], s1[5]); pw.w = pkh(s1[6], s1[7]); }
        else { pw.x = pkh(s1[8], s1[9]); pw.y = pkh(s1[10], s1[11]); pw.z = pkh(s1[12], s1[13]); pw.w = pkh(s1[14], s1[15]); }
        const bf16x8 pb = __builtin_bit_cast(bf16x8, pw);
#pragma unroll
        for (int ds = 0; ds < NDS; ++ds) { const bf16* vp = Vt + (ds * 32 + l32) * 68 + 16 * c + 4 * hi;
            const u32x2 lo = *(const u32x2*)vp, hi2 = *(const u32x2*)(vp + 8); u32x4 vw; vw.x = lo.x; vw.y = lo.y; vw.z = hi2.x; vw.w = hi2.y;
            O[ds] = MFMA32(__builtin_bit_cast(bf16x8, vw), pb, O[ds]); }
    }
}
template <int KW, int NDS, int SLOT, bool TWO> __device__ __forceinline__ void attn_pass(unsigned tmask, const bf16* base_b, int tok_base, int tstride, int kcol, int vcol, bf16* Ks, bf16* Vt, int kofs,
        const bf16x8 (&qf)[4], float& m, float& l, f32x16 (&O)[NDS], const float* tab, const unsigned char* bk, int iq, int maxd, unsigned okbits, int wave_maxq, int wave_lo, int tid, int l32, int hi) {
    if (!tmask) return;
    KVRegs<KW, NDS> Ra, Rb; int ja = __builtin_ctz(tmask), jb = -1; tmask &= tmask - 1;
    if (TWO && tmask) { jb = __builtin_ctz(tmask); tmask &= tmask - 1; }
    load_tile<KW, NDS>(Ra, base_b, tok_base + ja * 64 * tstride, tstride, kcol, vcol, tid);
    if (TWO && jb >= 0) load_tile<KW, NDS>(Rb, base_b, tok_base + jb * 64 * tstride, tstride, kcol, vcol, tid);
    for (;;) {
        __syncthreads(); store_tile<KW, NDS>(Ra, Ks, Vt, tid); if (TWO && jb >= 0) store_tile<KW, NDS>(Rb, Ks + SLOT, Vt + SLOT, tid); __syncthreads();
        const int ca = ja, cb = jb; const bool more = tmask != 0u;
        if (more) { ja = __builtin_ctz(tmask); tmask &= tmask - 1; jb = -1; if (TWO && tmask) { jb = __builtin_ctz(tmask); tmask &= tmask - 1; }
            load_tile<KW, NDS>(Ra, base_b, tok_base + ja * 64 * tstride, tstride, kcol, vcol, tid);
            if (TWO && jb >= 0) load_tile<KW, NDS>(Rb, base_b, tok_base + jb * 64 * tstride, tstride, kcol, vcol, tid); }
#pragma unroll 1
        for (int s = 0; s < (TWO ? 2 : 1); ++s) { const int c = s ? cb : ca;
            if (c >= 0 && c * 64 <= wave_maxq && c * 64 + 63 >= wave_lo) {
                const bool tok = ((okbits >> c) & 1u) != 0u;
                int pmode = 0; float cbias = 0.f;
                if (bk) { const int dmin = wave_maxq - 31 - c * 64 - 63, dmax = wave_maxq - c * 64;
                    if (dmin >= 0 && dmax <= maxd && dmax <= 2047) { pmode = 1; if (__all(tok) && bk[dmin] == bk[dmax]) { pmode = 2; cbias = tab[dmin]; } } }
                attn_tile<KW + 8, NDS>(qf, Ks + s * SLOT + kofs, Vt + s * SLOT, m, l, O, tab, iq - c * 64, maxd, tok, pmode, cbias, l32, hi); } }
        if (!more) break;
    }
}
__device__ __forceinline__ unsigned range_mask(int lo, int hi_incl) { const unsigned up = (hi_incl >= 31) ? 0xffffffffu : ((1u << (hi_incl + 1)) - 1u); return up & ~((1u << lo) - 1u); }

__device__ __forceinline__ void cmp_unit(const PT a, unsigned char* ldsb, unsigned* selL, int b, int g, int qt, int tid, int lane, int wave) {
    unsigned char* ws = a.ws(); const bf16* proj = (const bf16*)(ws + WS_PROJ);
    const float* kc = (const float*)(ws + WS_KC); const float* vc = (const float*)(ws + WS_VC); float* ocmp = (float*)(ws + WS_OCMP);
    bf16* Khi = (bf16*)ldsb; bf16* Klo = (bf16*)(ldsb + 18432); bf16* Vt = (bf16*)(ldsb + 104448); float* SC = (float*)ldsb;
    const int l32 = lane & 31, hi = lane >> 5;
    __syncthreads();
    {
        const int hh = g * 8 + wave, t0 = qt * 32, tq = t0 + l32, tok = b * SEQ + tq;
        {
            const int n = tid >> 2, seg = tid & 3;
            const f32x4* kp = (const f32x4*)(kc + (size_t)((b * NCMP + (n < NCMP ? n : 0)) * 2 + g) * 64 + seg * 16);
            u32x4 h0, h1, l0, l1; f32x4 x[4];
#pragma unroll
            for (int e = 0; e < 4; ++e) { x[e] = kp[e]; if (n >= NCMP) x[e] = (f32x4){0.f, 0.f, 0.f, 0.f}; }
            unsigned hw[8], lw[8];
#pragma unroll
            for (int e = 0; e < 4; ++e) { const unsigned a0 = f2bf(x[e].x), a1 = f2bf(x[e].y), a2 = f2bf(x[e].z), a3 = f2bf(x[e].w);
                hw[2 * e] = a0 | (a1 << 16); hw[2 * e + 1] = a2 | (a3 << 16);
                lw[2 * e] = pk2(x[e].x - __uint_as_float(a0 << 16), x[e].y - __uint_as_float(a1 << 16)); lw[2 * e + 1] = pk2(x[e].z - __uint_as_float(a2 << 16), x[e].w - __uint_as_float(a3 << 16)); }
            h0.x = hw[0]; h0.y = hw[1]; h0.z = hw[2]; h0.w = hw[3]; h1.x = hw[4]; h1.y = hw[5]; h1.z = hw[6]; h1.w = hw[7];
            l0.x = lw[0]; l0.y = lw[1]; l0.z = lw[2]; l0.w = lw[3]; l1.x = lw[4]; l1.y = lw[5]; l1.z = lw[6]; l1.w = lw[7];
            *(u32x4*)(Khi + n * 72 + seg * 16) = h0; *(u32x4*)(Khi + n * 72 + seg * 16 + 8) = h1;
            *(u32x4*)(Klo + n * 72 + seg * 16) = l0; *(u32x4*)(Klo + n * 72 + seg * 16 + 8) = l1;
            const int nv_ = tid & 127, dseg = tid >> 7;
            const f32x4* vp = (const f32x4*)(vc + (size_t)((b * NCMP + (nv_ < NCMP ? nv_ : 0)) * 2 + g) * 64 + dseg * 16);
#pragma unroll
            for (int e = 0; e < 4; ++e) { f32x4 v = vp[e]; if (nv_ >= NCMP) v = (f32x4){0.f, 0.f, 0.f, 0.f}; bf16* p = Vt + (dseg * 16 + e * 4) * 136 + nv_;
                p[0] = (bf16)f2bf(v.x); p[136] = (bf16)f2bf(v.y); p[272] = (bf16)f2bf(v.z); p[408] = (bf16)f2bf(v.w); }
        }
        bf16x8 qf[4]; load_qfrag(proj + (size_t)tok * NP + OFF_BQ + hh * 64, hi, qf, 0.125f);
        __syncthreads();
        f32x16 s[4];
#pragma unroll
        for (int st = 0; st < 4; ++st) {
#pragma unroll
            for (int i = 0; i < 16; ++i) s[st][i] = 0.f;
#pragma unroll
            for (int c = 0; c < 4; ++c) { const bf16x8 ah = *(const bf16x8*)(Khi + (st * 32 + l32) * 72 + c * 16 + hi * 8); const bf16x8 al = *(const bf16x8*)(Klo + (st * 32 + l32) * 72 + c * 16 + hi * 8);
                s[st] = MFMA32(ah, qf[c], s[st]); s[st] = MFMA32(al, qf[c], s[st]); }
        }
        int nvq = tq >= 31 ? (tq - 31) / 16 + 1 : 0; nvq = nvq < NCMP ? nvq : NCMP;
        float mx = -1e30f;
#pragma unroll
        for (int st = 0; st < 4; ++st)
#pragma unroll
            for (int i = 0; i < 16; ++i) { const int n = 32 * st + (i >> 2) * 8 + 4 * hi + (i & 3); if (n < nvq) mx = fmaxf(mx, s[st][i]); }
        mx = fmaxf(mx, __shfl_xor(mx, 32));
        float rs = 0.f;
#pragma unroll
        for (int st = 0; st < 4; ++st)
#pragma unroll
            for (int i = 0; i < 16; ++i) { const int n = 32 * st + (i >> 2) * 8 + 4 * hi + (i & 3); const float e = (n < nvq) ? __expf(s[st][i] - mx) : 0.f; s[st][i] = e; rs += e; }
        rs += __shfl_xor(rs, 32);
        const float inv = nvq > 0 ? 1.0f / rs : 0.f;
#pragma unroll
        for (int st = 0; st < 4; ++st)
#pragma unroll
            for (int i = 0; i < 16; ++i) s[st][i] *= inv;
        f32x16 O[2];
#pragma unroll
        for (int ds = 0; ds < 2; ++ds)
#pragma unroll
            for (int i = 0; i < 16; ++i) O[ds][i] = 0.f;
#pragma unroll
        for (int st = 0; st < 4; ++st)
#pragma unroll
            for (int c2 = 0; c2 < 2; ++c2) { const int c = 2 * st + c2; u32x4 pw;
                pw.x = pk2(s[st][8 * c2 + 0], s[st][8 * c2 + 1]); pw.y = pk2(s[st][8 * c2 + 2], s[st][8 * c2 + 3]); pw.z = pk2(s[st][8 * c2 + 4], s[st][8 * c2 + 5]); pw.w = pk2(s[st][8 * c2 + 6], s[st][8 * c2 + 7]);
                const bf16x8 pb = __builtin_bit_cast(bf16x8, pw);
#pragma unroll
                for (int ds = 0; ds < 2; ++ds) { const bf16* vp = Vt + (ds * 32 + l32) * 136 + 16 * c + 4 * hi;
                    const u32x2 lo = *(const u32x2*)vp, hi2 = *(const u32x2*)(vp + 8); u32x4 vw; vw.x = lo.x; vw.y = lo.y; vw.z = hi2.x; vw.w = hi2.y;
                    O[ds] = MFMA32(__builtin_bit_cast(bf16x8, vw), pb, O[ds]); } }
#pragma unroll
        for (int ds = 0; ds < 2; ++ds)
#pragma unroll
            for (int i4 = 0; i4 < 4; ++i4) { f32x4 v; v.x = O[ds][i4 * 4 + 0]; v.y = O[ds][i4 * 4 + 1]; v.z = O[ds][i4 * 4 + 2]; v.w = O[ds][i4 * 4 + 3];
                *(f32x4*)(ocmp + (size_t)tok * 1024 + hh * 64 + ds * 32 + i4 * 8 + 4 * hi) = v; }
        __syncthreads();
        {
            float prev_other = 0.f;
#pragma unroll
            for (int st = 0; st < 4; ++st)
#pragma unroll
                for (int i4 = 0; i4 < 4; ++i4) {
                    const float gs = (s[st][4 * i4] + s[st][4 * i4 + 1]) + (s[st][4 * i4 + 2] + s[st][4 * i4 + 3]);
                    const float other = __shfl_xor(s[st][4 * i4 + 3], 32);
                    const float c = gs + (hi ? other : prev_other);
                    prev_other = other;
                    SC[(wave * 32 + l32) * 33 + 8 * st + 2 * i4 + hi] = c;
                }
        }
        __syncthreads();
#pragma unroll 1
        for (int ps = 0; ps < 2; ++ps) {
            const int q = 4 * wave + 2 * ps + hi, j = l32, t = t0 + q, cur = t >> 6;
            float sc = 0.f;
#pragma unroll
            for (int w = 0; w < 8; ++w) sc += SC[(w * 32 + q) * 33 + j];
            if (j == 0 || cur - j == 0 || cur - j == 1) sc = 1e6f;
            if (j > cur) sc = -1e30f;
            int rank = 0;
#pragma unroll 1
            for (int i = 0; i < 32; ++i) { const float si = __shfl(sc, (lane & 32) + i); rank += (si > sc || (si == sc && i < j)) ? 1 : 0; }
            const bool sel = (rank < 16) && (j <= cur);
            const unsigned long long bal = __ballot(sel);
            if (l32 == 0) selL[q] = hi ? (unsigned)(bal >> 32) : (unsigned)bal;
        }
        __syncthreads();
    }
}


__device__ __forceinline__ void phase_nsa_mfma(const PT a, unsigned char* ldsb, int tid, int lane, int wave, int bid, int nblk) {
    unsigned char* ws = a.ws(); const bf16* proj = (const bf16*)(ws + WS_PROJ); const float* biasT = (const float*)(ws + WS_BIAST);
    const float* ocmp = (const float*)(ws + WS_OCMP); bf16* ob = (bf16*)(ws + WS_OA);
    bf16* Ks = (bf16*)ldsb; bf16* Vt = (bf16*)(ldsb + 9216); float* tabs = (float*)(ldsb + 36864); unsigned char* bk = ldsb + 102400; unsigned* selL = (unsigned*)(ldsb + 121856);
    int gcur = -1;
    __syncthreads();
    for (int u = bid; u < 512; u += nblk) {
        const int bg = u & 7, b = bg >> 1, g = bg & 1, qt = u < 256 ? 63 - (u >> 3) : ((u - 256) >> 3);
        if (g != gcur) { __syncthreads();
            for (int i = tid; i < 8 * 2048; i += 512) tabs[i] = biasT[(24 + g * 8 + (i >> 11)) * BT + (i & 2047)] * LOG2E; for (int i = tid; i < 2048; i += 512) bk[i] = (unsigned char)t5_bucket(i); gcur = g; }
        const int hh = g * 8 + wave, t0 = qt * 32;
        const bf16* base_b = proj + (size_t)b * SEQ * NP;
        cmp_unit(a, ldsb, selL, b, g, qt, tid, lane, wave);
        asm volatile("" : "+v"(lane), "+v"(tid) :: "memory");
        const int l32 = lane & 31, hi = lane >> 5, tq = t0 + l32, tok = b * SEQ + tq;
        bf16x8 qf[4]; load_qfrag(proj + (size_t)tok * NP + OFF_BQ + hh * 64, hi, qf, QSCALE2);
        const unsigned mq = selL[l32];
        unsigned un = mq;
#pragma unroll
        for (int o = 1; o < 32; o <<= 1) un |= (unsigned)__shfl_xor((int)un, o);
        un = (unsigned)__builtin_amdgcn_readfirstlane((int)un);
        const float* tab = tabs + wave * 2048;
        f32x16 Os[2], Ow[2]; float m = -1e30f, l = 0.f;
#pragma unroll
        for (int ds = 0; ds < 2; ++ds)
#pragma unroll
            for (int i = 0; i < 16; ++i) { Os[ds][i] = 0.f; Ow[ds][i] = 0.f; }
        attn_pass<64, 2, 8960, true>(un, base_b, 0, 1, OFF_BKV + (4 + g) * 64, OFF_BKV + (6 + g) * 64, Ks, Vt, 0, qf, m, l, Os, tab, bk, tq, 1 << 20, mq, t0 + 31, -(1 << 20), tid, l32, hi);
        const float isel = 1.0f / (l + __shfl_xor(l, 32));
        m = -1e30f; l = 0.f;
        const int wlo = (t0 - 511 > 0 ? t0 - 511 : 0) >> 6, whi = (t0 + 31) >> 6;
        attn_pass<64, 2, 8960, true>(range_mask(wlo, whi), base_b, 0, 1, OFF_BKV + (8 + g) * 64, OFF_BKV + (10 + g) * 64, Ks, Vt, 0, qf, m, l, Ow, tab, bk, tq, 511, 0xffffffffu, t0 + 31, -(1 << 20), tid, l32, hi);
        const float iwin = 1.0f / (l + __shfl_xor(l, 32));
        const bf16* gp = proj + (size_t)tok * NP + OFF_BG + hh * 3;
        const float g0 = sigmoidf_(bf2f(gp[0])), g1 = sigmoidf_(bf2f(gp[1])) * isel, g2 = sigmoidf_(bf2f(gp[2])) * iwin;
#pragma unroll
        for (int ds = 0; ds < 2; ++ds)
#pragma unroll
            for (int i4 = 0; i4 < 4; ++i4) { const int d = ds * 32 + i4 * 8 + 4 * hi; const size_t off = (size_t)tok * 1024 + hh * 64 + d;
                const f32x4 oc = *(const f32x4*)(ocmp + off);
                const float r0 = g0 * oc.x + g1 * Os[ds][i4 * 4 + 0] + g2 * Ow[ds][i4 * 4 + 0], r1 = g0 * oc.y + g1 * Os[ds][i4 * 4 + 1] + g2 * Ow[ds][i4 * 4 + 1];
                const float r2 = g0 * oc.z + g1 * Os[ds][i4 * 4 + 2] + g2 * Ow[ds][i4 * 4 + 2], r3 = g0 * oc.w + g1 * Os[ds][i4 * 4 + 3] + g2 * Ow[ds][i4 * 4 + 3];
                u32x2 w; w.x = pk2(r0, r1); w.y = pk2(r2, r3); *(u32x2*)(ob + (size_t)tok * KCAT + 512 + hh * 64 + d) = w; }
    }
    __syncthreads();
}

__device__ __forceinline__ void phase_diff_mfma(const PT a, int lyr, unsigned char* ldsb, int tid, int lane, int wave, int bid, int nblk) {
    unsigned char* ws = a.ws(); const bf16* proj = (const bf16*)(ws + WS_PROJ); const float* biasT = (const float*)(ws + WS_BIAST); bf16* oc = (bf16*)(ws + WS_OA);
    const float* lv = a.in(9) + (size_t)lyr * 256; const float* sg = a.in(10) + (size_t)lyr * 128;
    const float lam_init = 0.8f - 0.6f * expf(-0.3f * (float)lyr);
    const float lam = expf(wave_sum(lv[lane] * lv[64 + lane])) - expf(wave_sum(lv[128 + lane] * lv[192 + lane])) + lam_init;
    bf16* Ks = (bf16*)ldsb; bf16* Vt = (bf16*)(ldsb + 17408); float* tab = (float*)(ldsb + 69632); unsigned char* bk = ldsb + 77824; float* O2 = (float*)ldsb;
    const int l32 = lane & 31, hi = lane >> 5, mp = wave >> 2, wq = wave & 3;
    int hcur = -1;
    __syncthreads();
    for (int u = bid; u < 512; u += nblk) {
        const int bh = u & 31, b = bh >> 3, h = bh & 7, qt = u < 256 ? 15 - (u >> 5) : ((u - 256) >> 5);
        if (h != hcur) { __syncthreads(); for (int i = tid; i < 2048; i += 512) { tab[i] = biasT[(40 + h) * BT + i] * LOG2E; bk[i] = (unsigned char)t5_bucket(i); } hcur = h; }
        const int t0 = qt * 128, tq = t0 + wq * 32 + l32, tok = b * SEQ + tq;
        const bf16* base_b = proj + (size_t)b * SEQ * NP;
        bf16x8 qf[4]; load_qfrag(proj + (size_t)tok * NP + OFF_CQ + (h * 2 + mp) * 64, hi, qf, QSCALE2);
        f32x16 O[4]; float m = -1e30f, l = 0.f;
#pragma unroll
        for (int ds = 0; ds < 4; ++ds)
#pragma unroll
            for (int i = 0; i < 16; ++i) O[ds][i] = 0.f;
        attn_pass<128, 4, 17408, false>(range_mask(0, (t0 + 127) >> 6), base_b, 0, 1, OFF_CK + h * 128, OFF_CV + h * 128, Ks, Vt, mp * 64, qf, m, l, O, tab, bk, tq, 1 << 20, 0xffffffffu, t0 + wq * 32 + 31, -(1 << 20), tid, l32, hi);
        const float inv = 1.0f / (l + __shfl_xor(l, 32));
        __syncthreads();
        if (mp == 1) {
#pragma unroll
            for (int ds = 0; ds < 4; ++ds)
#pragma unroll
                for (int i = 0; i < 16; ++i) O2[(ds * 16 + i) * 256 + wq * 64 + lane] = O[ds][i] * inv;
        }
        __syncthreads();
        if (mp == 0) {
            float ss = 0.f;
#pragma unroll
            for (int ds = 0; ds < 4; ++ds)
#pragma unroll
                for (int i = 0; i < 16; ++i) { const float o = O[ds][i] * inv - lam * O2[(ds * 16 + i) * 256 + wq * 64 + lane]; O[ds][i] = o; ss += o * o; }
            ss += __shfl_xor(ss, 32);
            const float r = (1.0f - lam_init) / sqrtf(ss * (1.0f / 128.0f) + 1e-6f);
#pragma unroll
            for (int ds = 0; ds < 4; ++ds)
#pragma unroll
                for (int i4 = 0; i4 < 4; ++i4) { const int d = ds * 32 + i4 * 8 + 4 * hi; const f32x4 gn = *(const f32x4*)(sg + d);
                    u32x2 w; w.x = pk2(O[ds][i4 * 4 + 0] * r * gn.x, O[ds][i4 * 4 + 1] * r * gn.y); w.y = pk2(O[ds][i4 * 4 + 2] * r * gn.z, O[ds][i4 * 4 + 3] * r * gn.w);
                    *(u32x2*)(oc + (size_t)tok * KCAT + 1536 + h * 128 + d) = w; }
        }
        __syncthreads();
    }
}


constexpr size_t WS_OAG = WS_MIXF, WS_LSE = WS_MIXB;
__device__ __forceinline__ void phase_dilated_mfma(const PT a, unsigned char* ldsb, int tid, int lane, int wave, int bid, int nblk) {
    unsigned char* ws = a.ws(); const bf16* proj = (const bf16*)(ws + WS_PROJ); const float* biasT = (const float*)(ws + WS_BIAST);
    float* oag = (float*)(ws + WS_OAG); float* lseb = (float*)(ws + WS_LSE);
    bf16* Ks = (bf16*)ldsb; bf16* Vt = (bf16*)(ldsb + 9216); float* tab = (float*)(ldsb + 36864);
    const int l32 = lane & 31, hi = lane >> 5;
    const int nh = (nblk > 64) ? nblk - 64 : nblk, hb = (nblk > 64) ? bid - 64 : bid;
    const int n_heavy_mine = (hb >= 0) ? (512 - hb + nh - 1) / nh : 0;
    const int n_light_mine = (512 - bid + nblk - 1) / nblk;
    for (int it = 0; it < n_heavy_mine + n_light_mine; ++it) {
        const int u = it < n_heavy_mine ? hb + it * nh : 512 + bid + (it - n_heavy_mine) * nblk;
        int g, b, h, r, i0, nq;
        if (u < 256) { g = 0; b = u >> 6; h = (u >> 3) & 7; r = 0; i0 = (u & 7) * 256; nq = 256; }
        else if (u < 512) { const int v = u - 256; g = 1; b = v >> 6; h = (v >> 3) & 7; r = (v >> 1) & 3; i0 = (v & 1) * 256; nq = 256; }
        else { const int v = u - 512; g = 2; b = v >> 7; h = (v >> 4) & 7; r = v & 15; i0 = 0; nq = 128; }
        const int dil = 1 << (2 * g);
        __syncthreads();
        if (tid < 129) tab[tid] = biasT[(g * 8 + h) * BT + tid * dil] * LOG2E;
        const bool act = wave * 32 < nq;
        const int iq = i0 + ((wave * 32) % nq) + l32, tok = b * SEQ + r + dil * iq;
        const bf16* base_b = proj + (size_t)b * SEQ * NP;
        bf16x8 qf[4]; load_qfrag(proj + (size_t)tok * NP + (g * 8 + h) * 64, hi, qf, QSCALE2);
        f32x16 O[2]; float m = -1e30f, l = 0.f;
#pragma unroll
        for (int ds = 0; ds < 2; ++ds)
#pragma unroll
            for (int i = 0; i < 16; ++i) O[ds][i] = 0.f;
        const int wq0 = i0 + wave * 32;
        attn_pass<64, 2, 8960, true>(range_mask((i0 - 128 > 0 ? i0 - 128 : 0) >> 6, (i0 + nq - 1) >> 6), base_b, r, dil, ((3 + g) * 8 + h) * 64, ((6 + g) * 8 + h) * 64, Ks, Vt, 0, qf, m, l, O, tab, (const unsigned char*)nullptr, iq, 128, 0xffffffffu,
                         act ? wq0 + 31 : -1, wq0 - 128, tid, l32, hi);
        if (act) {
            const float lt = l + __shfl_xor(l, 32), inv = 1.0f / lt;
            float* op = oag + ((size_t)g * M + tok) * 512 + h * 64;
#pragma unroll
            for (int ds = 0; ds < 2; ++ds)
#pragma unroll
                for (int i4 = 0; i4 < 4; ++i4) { f32x4 v; v.x = O[ds][i4 * 4 + 0] * inv; v.y = O[ds][i4 * 4 + 1] * inv; v.z = O[ds][i4 * 4 + 2] * inv; v.w = O[ds][i4 * 4 + 3] * inv;
                    *(f32x4*)(op + ds * 32 + i4 * 8 + 4 * hi) = v; }
            if (hi == 0) lseb[((size_t)g * M + tok) * 8 + h] = (m + __log2f(lt)) * 0.6931471805599453f;
        }
    }
    __syncthreads();
}
__device__ __forceinline__ void phase_dil_combine(const PT a, int lane, int gw, int ngw) {
    unsigned char* ws = a.ws(); const float* oag = (const float*)(ws + WS_OAG); const float* lseb = (const float*)(ws + WS_LSE); bf16* oa = (bf16*)(ws + WS_OA);
    for (int tok = gw; tok < M; tok += ngw) {
        const int h = lane >> 3;
        const float l0 = lseb[((size_t)0 * M + tok) * 8 + h], l1 = lseb[((size_t)1 * M + tok) * 8 + h], l2 = lseb[((size_t)2 * M + tok) * 8 + h];
        const float mx = fmaxf(l0, fmaxf(l1, l2)); float w0 = __expf(l0 - mx), w1 = __expf(l1 - mx), w2 = __expf(l2 - mx); const float iw = 1.0f / (w0 + w1 + w2); w0 *= iw; w1 *= iw; w2 *= iw;
        const f32x4* p0 = (const f32x4*)(oag + ((size_t)0 * M + tok) * 512 + lane * 8); const f32x4* p1 = (const f32x4*)(oag + ((size_t)1 * M + tok) * 512 + lane * 8); const f32x4* p2 = (const f32x4*)(oag + ((size_t)2 * M + tok) * 512 + lane * 8);
        const f32x4 x0 = w0 * p0[0] + w1 * p1[0] + w2 * p2[0], x1 = w0 * p0[1] + w1 * p1[1] + w2 * p2[1];
        u32x4 o; o.x = pk2(x0.x, x0.y); o.y = pk2(x0.z, x0.w); o.z = pk2(x1.x, x1.y); o.w = pk2(x1.z, x1.w);
        *(u32x4*)(oa + (size_t)tok * KCAT + lane * 8) = o;
    }
}


__device__ __forceinline__ void phase_compress_mfma(const PT a, int lyr, unsigned char* ldsb, int tid, int lane, int wave, int bid, int nblk) {
    unsigned char* ws = a.ws(); const bf16* proj = (const bf16*)(ws + WS_PROJ);
    unsigned char* cw = ws + WS_CW + (size_t)lyr * 4 * MiB;
    bf16* Ab = (bf16*)ldsb; float* RED = (float*)(ldsb + 17408);
    const int l32 = lane & 31, hi = lane >> 5;
    __syncthreads();
    for (int u = bid; u < 64; u += nblk) {
        const int kv = u >> 5, rg = u & 31;
        const bf16* W1t = (const bf16*)(cw + (size_t)kv * MiB); const bf16* W2t = (const bf16*)(cw + 2 * MiB + (size_t)kv * 65536);
        const float* pos = a.in(3 + kv) + (size_t)lyr * 2048; float* dst = (float*)(ws + (kv ? WS_VC : WS_KC));
        f32x16 acc;
#pragma unroll
        for (int i = 0; i < 16; ++i) acc[i] = 0.f;
        const bf16* wrow = W1t + (size_t)(32 * wave + l32) * 2048 + hi * 8;
#pragma unroll 1
        for (int kc = 0; kc < 8; ++kc) {
            bf16x8 af[16];
#pragma unroll
            for (int kk = 0; kk < 16; ++kk) af[kk] = *(const bf16x8*)(wrow + kc * 256 + kk * 16);
            __syncthreads();
#pragma unroll
            for (int r2 = 0; r2 < 2; ++r2) { const int idx = tid + 512 * r2, row = idx >> 5, ch = idx & 31; int r = rg * 32 + row; r = r < 1016 ? r : 1015;
                const int g = r & 1, bn = r >> 1, b = bn / NCMP, n = bn % NCMP, ll = kc * 4 + (ch >> 3), d = (ch & 7) * 8;
                const u32x4 w = *(const u32x4*)(proj + (size_t)(b * SEQ + 16 * n + ll) * NP + OFF_BKV + (kv * 2 + g) * 64 + d);
                const f32x4 p0 = *(const f32x4*)(pos + ll * 64 + d), p1 = *(const f32x4*)(pos + ll * 64 + d + 4);
                u32x4 o; o.x = pk2(bf_lo(w.x) + p0.x, bf_hi(w.x) + p0.y); o.y = pk2(bf_lo(w.y) + p0.z, bf_hi(w.y) + p0.w); o.z = pk2(bf_lo(w.z) + p1.x, bf_hi(w.z) + p1.y); o.w = pk2(bf_lo(w.w) + p1.z, bf_hi(w.w) + p1.w);
                *(u32x4*)(Ab + row * 264 + ch * 8) = o; }
            __syncthreads();
#pragma unroll
            for (int kk = 0; kk < 16; ++kk) { const bf16x8 bfr = *(const bf16x8*)(Ab + l32 * 264 + kk * 16 + hi * 8); acc = MFMA32(af[kk], bfr, acc); }
        }
#pragma unroll
        for (int i = 0; i < 16; ++i) { const float v = acc[i]; acc[i] = 0.5f * v * (1.0f + tanhf(0.7978845608028654f * (v + 0.044715f * v * v * v))); }
        f32x16 o2[2];
#pragma unroll
        for (int ds = 0; ds < 2; ++ds)
#pragma unroll
            for (int i = 0; i < 16; ++i) o2[ds][i] = 0.f;
#pragma unroll
        for (int c2 = 0; c2 < 2; ++c2) { u32x4 pw; pw.x = pk2(acc[8 * c2 + 0], acc[8 * c2 + 1]); pw.y = pk2(acc[8 * c2 + 2], acc[8 * c2 + 3]); pw.z = pk2(acc[8 * c2 + 4], acc[8 * c2 + 5]); pw.w = pk2(acc[8 * c2 + 6], acc[8 * c2 + 7]);
            const bf16x8 hb = __builtin_bit_cast(bf16x8, pw);
#pragma unroll
            for (int ds = 0; ds < 2; ++ds) { const bf16* wp = W2t + (size_t)(ds * 32 + l32) * 256 + 32 * wave + 16 * c2 + 4 * hi;
                const u32x2 lo = *(const u32x2*)wp, hi2 = *(const u32x2*)(wp + 8); u32x4 vw; vw.x = lo.x; vw.y = lo.y; vw.z = hi2.x; vw.w = hi2.y;
                o2[ds] = MFMA32(__builtin_bit_cast(bf16x8, vw), hb, o2[ds]); } }
#pragma unroll
        for (int ds = 0; ds < 2; ++ds)
#pragma unroll
            for (int i = 0; i < 16; ++i) RED[(wave * 64 + ds * 32 + (i >> 2) * 8 + 4 * hi + (i & 3)) * 33 + l32] = o2[ds][i];
        __syncthreads();
#pragma unroll
        for (int e = 0; e < 4; ++e) { const int idx = tid + 512 * e, d = idx & 63, row = idx >> 6; float s = 0.f;
#pragma unroll
            for (int w = 0; w < 8; ++w) s += RED[(w * 64 + d) * 33 + row];
            const int r = rg * 32 + row; if (r < 1016) dst[(size_t)r * 64 + d] = s; }
        __syncthreads();
    }
}

#define XB_TMO      128
#define XB_XCNT(j)  (256  + 64 * (j))
#define XB_XSUB(j)  (1280 + 64 * (j))
#define XB_XGEN(j)  (2304 + 64 * (j))
#define XB_TOP      3328
#define XB_TOPGEN   3392
#define XCD_BAR_WORDS 3456
#define XB_SPIN_CAP (1u << 18)

__device__ __forceinline__ unsigned xb_ld(unsigned* p)              { return __hip_atomic_load(p, __ATOMIC_RELAXED, __HIP_MEMORY_SCOPE_AGENT); }
__device__ __forceinline__ unsigned xb_add(unsigned* p, unsigned v) { return __hip_atomic_fetch_add(p, v, __ATOMIC_RELAXED, __HIP_MEMORY_SCOPE_AGENT); }
__device__ __forceinline__ unsigned xb_xcc_id() { return (unsigned)__builtin_amdgcn_s_getreg((3 << 11) | 20) & 0xFu; }
#define XB_SPIN(cond, bar) do { unsigned _sp = 0; while (cond) { __builtin_amdgcn_s_sleep(1); \
    if ((++_sp & 255u) == 0u) { if (xb_ld(&(bar)[XB_TMO])) break; if (_sp > XB_SPIN_CAP) { atomicAdd(&(bar)[XB_TMO], 1u); break; } } } } while (0)

struct XcdBarrier {
    unsigned* bar; unsigned x;
    volatile LAS unsigned* st;
};

__device__ __forceinline__ XcdBarrier xcd_barrier_post(unsigned* bar, volatile LAS unsigned* st) {
    XcdBarrier b; b.bar = bar; b.x = xb_xcc_id(); b.st = st;
    if (threadIdx.x == 0) (void)xb_add(&bar[XB_XCNT(b.x)], 1u);
    return b;
}
__device__ __forceinline__ void xcd_barrier_complete(unsigned* bar, unsigned x, unsigned& nloc, unsigned& nx) {
    const unsigned G = gridDim.x * gridDim.y * gridDim.z;
    unsigned sum, cnt, mine, sp = 0u;
    for (;;) {
        sum = 0u; cnt = 0u; mine = 0u;
#pragma unroll
        for (unsigned j = 0; j < 16; ++j) { const unsigned c = xb_ld(&bar[XB_XCNT(j)]); sum += c; cnt += (c > 0u) ? 1u : 0u; mine = (j == x) ? c : mine; }
        if (sum == G) break;
        __builtin_amdgcn_s_sleep(1);
        if ((++sp & 255u) == 0u) { if (xb_ld(&bar[XB_TMO])) break; if (sp > XB_SPIN_CAP) { atomicAdd(&bar[XB_TMO], 1u); break; } }
    }
    nloc = mine > 0u ? mine : 1u; nx = cnt > 0u ? cnt : 1u;
}

__device__ __forceinline__ void xcd_barrier(const XcdBarrier& b) {
    asm volatile("s_waitcnt vmcnt(0)" ::: "memory");
    __syncthreads();
    if (threadIdx.x == 0) {
        unsigned* bar = b.bar;
        __builtin_amdgcn_s_waitcnt(0);
        unsigned nloc = b.st[0], nx = b.st[1];
        if (nloc == 0u) { xcd_barrier_complete(bar, b.x, nloc, nx); b.st[0] = nloc; b.st[1] = nx; }
        const unsigned old = xb_add(&bar[XB_XSUB(b.x)], 1u);
        const unsigned gen = old / nloc;
        if (old + 1u == (gen + 1u) * nloc) {
            __builtin_amdgcn_fence(__ATOMIC_RELEASE, "agent");
            asm volatile("s_waitcnt vmcnt(0)" ::: "memory");
            const unsigned og = xb_add(&bar[XB_TOP], 1u);
            const unsigned tg = og / nx;
            if (og + 1u == (tg + 1u) * nx) xb_add(&bar[XB_TOPGEN], 1u);
            else XB_SPIN(xb_ld(&bar[XB_TOPGEN]) == tg, bar);
            __builtin_amdgcn_fence(__ATOMIC_ACQUIRE, "agent");
            xb_add(&bar[XB_XGEN(b.x)], 1u);
            asm volatile("s_waitcnt vmcnt(0)" ::: "memory");
        } else {
            XB_SPIN(xb_ld(&bar[XB_XGEN(b.x)]) == gen, bar);
            __builtin_amdgcn_fence(__ATOMIC_ACQUIRE, "agent");
            asm volatile("s_waitcnt vmcnt(0)" ::: "memory");
        }
    }
    __syncthreads();
}

__global__ void __launch_bounds__(512, 2) mega_fwd(Args ka) {
    extern __shared__ __attribute__((aligned(16))) unsigned char lds[];
    LAS unsigned char* ldsl = (LAS unsigned char*)lds;
    const int tid0 = threadIdx.x;
    {
        unsigned long long* pt = (unsigned long long*)(lds + PTAB_OFF);
        if (tid0 < 21) pt[tid0] = (unsigned long long)ka.in[tid0];
        if (tid0 == 21) pt[21] = (unsigned long long)ka.out;
        if (tid0 == 22) pt[22] = (unsigned long long)ka.ws;
        if (tid0 == 23) { pt[32] = 0ull; }
        __syncthreads();
    }
    const int ph_lo = ka.ph_lo, ph_hi = ka.ph_hi;
    cg::grid_group grid = cg::this_grid();
    (void)xcd_barrier_post((unsigned*)(__attribute__((address_space(1))) unsigned*)(ka.ws + WS_BAR), (volatile LAS unsigned*)(ldsl + PTAB_OFF + 256));
    for (int ph = ph_lo; ph < ph_hi; ++ph) {
        unsigned ldso0 = 0; asm volatile("" : "+s"(ldso0));
        const PT a{(const unsigned long long*)(lds + PTAB_OFF + ldso0)};
        if (ph == 0) { int tidp = tid0; asm volatile("" : "+v"(tidp)); const int lanep = tidp & 63, wavep = __builtin_amdgcn_readfirstlane(tidp >> 6);
            phase_prologue(a, (float*)(lds + ldso0), lanep, wavep, (int)blockIdx.x * 8 + wavep, (int)gridDim.x * 8); }
        else {
            const int l = (ph - 1) / PH_PER_LAYER; int k = (ph - 1) % PH_PER_LAYER; if (k >= 2) k += 1;
            unsigned char* ws = a.ws();
            unsigned char* wl = ws + WS_WT + (size_t)l * LAYER_W;
            bf16* H = (bf16*)(ws + WS_H); bf16* proj = (bf16*)(ws + WS_PROJ);
            int njobs = 0, mode0 = 0, N = 0, K = 0; const bf16* A0 = nullptr; const bf16* B0 = nullptr; bf16* ob = nullptr; float* of = nullptr;
            if (k == 0) { njobs = 1; mode0 = 0; A0 = H; B0 = (const bf16*)(wl + WO_IN); N = NP; K = DM; ob = proj; }
            else if (k == 4) { njobs = 1; mode0 = 6; A0 = (const bf16*)(ws + WS_OA); B0 = (const bf16*)(wl + WO_A); N = DM; K = KCAT; ob = (bf16*)(ws + WS_MIXB); }
            else if (k == 5) { njobs = 1; mode0 = 4; A0 = (const bf16*)(ws + WS_MIXB); B0 = (const bf16*)(wl + WO_OUT); N = DM; K = DM; ob = (bf16*)(ws + WS_Y); }
            else if (k == 7) { njobs = 1; mode0 = 5; A0 = H; B0 = (const bf16*)(wl + WO_UP); N = DFF; K = DM; ob = (bf16*)(ws + WS_U); }
            else if (k == 8) { njobs = 1; mode0 = 4; A0 = (const bf16*)(ws + WS_U); B0 = (const bf16*)(wl + WO_DOWN); N = DM; K = DFF; ob = (bf16*)(ws + WS_Y); }
            for (int j = 0; j < njobs; ++j) {
                const bf16* A = A0; const bf16* B = B0; int Kj = K;
                pg8::Gemm g{A, B, M, N, Kj}; pg8::StaticOrder S; S.init(M, N, (int)gridDim.x, (int)blockIdx.x);
                EpiAny E{mode0 + j, ob, of, proj};
                pg8::gemm_phase<EpiAny, pg8::StaticOrder, true, true>(ldsl, g, S, E);
            }
            int tid = tid0; asm volatile("" : "+v"(tid));
            int bid = (int)blockIdx.x, nblk = (int)gridDim.x; asm volatile("" : "+s"(bid), "+s"(nblk));
            unsigned ldso = 0; asm volatile("" : "+s"(ldso));
            float* ldsf = (float*)(lds + ldso);
            const int lane = tid & 63, wave = __builtin_amdgcn_readfirstlane(tid >> 6);
            const int gw = bid * 8 + wave, ngw = nblk * 8;
            if (k == 1) {
                for (int rep = 0; rep < ((PROBE_SUB & 1) ? 2 : 1); ++rep) { asm volatile("" : "+v"(tid), "+s"(bid)); phase_compress_mfma(a, l, (unsigned char*)ldsf, tid, tid & 63, __builtin_amdgcn_readfirstlane(tid >> 6), bid, nblk); }
                for (int rep = 0; rep < ((PROBE_SUB & 2) ? 2 : 1); ++rep) { asm volatile("" : "+v"(tid), "+s"(bid)); phase_dilated_mfma(a, (unsigned char*)ldsf, tid, tid & 63, __builtin_amdgcn_readfirstlane(tid >> 6), bid, nblk); }
                for (int rep = 0; rep < ((PROBE_SUB & 4) ? 2 : 1); ++rep) { asm volatile("" : "+v"(tid), "+s"(bid)); phase_diff_mfma(a, l, (unsigned char*)ldsf, tid, tid & 63, __builtin_amdgcn_readfirstlane(tid >> 6), bid, nblk); } }
            else if (k == 3) { phase_dil_combine(a, lane, gw, ngw); phase_nsa_mfma(a, (unsigned char*)ldsf, tid, lane, wave, bid, nblk); }
            else if (k == 6) { float* xo = a.out(); const float* xi = (l == 0) ? a.in(0) : xo;
                for (int m = gw; m < M; m += ngw) rowpass_row(xi + (size_t)m * DM, (const bf16*)(ws + WS_Y) + (size_t)m * DM, a.in(16) + (size_t)l * DM, a.in(17) + (size_t)l * DM, xo + (size_t)m * DM, H + (size_t)m * DM, lane); }
            else if (k == 9) { float* xo = a.out(); const float* gn = (l + 1 < DEPTH) ? a.in(15) + (size_t)(l + 1) * DM : nullptr;
                for (int m = gw; m < M; m += ngw) rowpass_row(xo + (size_t)m * DM, (const bf16*)(ws + WS_Y) + (size_t)m * DM, a.in(18) + (size_t)l * DM, gn, xo + (size_t)m * DM, H + (size_t)m * DM, lane); }
        }
        if (ph + 1 < ph_hi) { XcdBarrier xbar; xbar.bar = (unsigned*)(a.ws() + WS_BAR); xbar.x = xb_xcc_id(); xbar.st = (volatile LAS unsigned*)(ldsl + PTAB_OFF + 256); xcd_barrier(xbar); }
        if (ph_hi > 100000) grid.sync();
    }
}

#ifndef N_LAUNCH_SPLIT
#define N_LAUNCH_SPLIT 0
#endif
extern "C" void kernel_launch(void* const* d_in, const int* in_sizes, int n_in, void* d_out, int out_size, void* d_ws, size_t ws_size, hipStream_t stream) {
    static int grid = 0;
    if (grid == 0) {
        if (n_in != 21 || out_size != M * DM || ws_size < WS_END) { fprintf(stderr, "kernel_launch: unexpected shapes (n_in %d out %d ws %zu)\n", n_in, out_size, ws_size); grid = -1; return; }
        int dev = 0, cus = 0, per_cu = 0;
        (void)hipGetDevice(&dev); (void)hipDeviceGetAttribute(&cus, hipDeviceAttributeMultiprocessorCount, dev);
        if (hipFuncSetAttribute((const void*)mega_fwd, hipFuncAttributeMaxDynamicSharedMemorySize, LDS_BYTES) != hipSuccess) { fprintf(stderr, "hipFuncSetAttribute failed\n"); grid = -1; return; }
        if (hipOccupancyMaxActiveBlocksPerMultiprocessor(&per_cu, (const void*)mega_fwd, 512, LDS_BYTES) != hipSuccess || per_cu < 1) { fprintf(stderr, "occupancy query: %d\n", per_cu); per_cu = 1; }
        (void)hipGetLastError();
        grid = cus > 0 ? cus : 256;
    }
    if (grid < 0) return;
    if (hipMemsetAsync((char*)d_ws + WS_BAR, 0, 16384, stream) != hipSuccess) { fprintf(stderr, "kernel_launch: memset of the barrier words failed\n"); return; }
    Args a{};
    for (int i = 0; i < 21; ++i) a.in[i] = (const float*)d_in[i];
    a.out = (float*)d_out; a.ws = (unsigned char*)d_ws;
#if N_LAUNCH_SPLIT
    for (int ph = 0; ph < NPH; ++ph) { a.ph_lo = ph; a.ph_hi = ph + 1; hipLaunchKernelGGL(mega_fwd, dim3(grid), dim3(512), LDS_BYTES, stream, a); }
#else
    a.ph_lo = 0; a.ph_hi = NPH;
    void* args[] = {&a};
    hipError_t e = hipLaunchCooperativeKernel((const void*)mega_fwd, dim3(grid), dim3(512), args, LDS_BYTES, stream);
    if (e != hipSuccess) fprintf(stderr, "cooperative launch failed: %s (grid %d)\n", hipGetErrorString(e), grid);
#endif
}
```

```cpp
#include <hip/hip_runtime.h>
#include <hip/hip_cooperative_groups.h>
#include <cstdio>
#include <cstdint>
namespace cg = cooperative_groups;
namespace pg8 {
#define PG8_LAS __attribute__((address_space(3)))
typedef unsigned short bf16_t;
typedef short bf16x8 __attribute__((ext_vector_type(8)));
typedef float f32x4 __attribute__((ext_vector_type(4)));
typedef unsigned u32x4 __attribute__((ext_vector_type(4)));
constexpr int BM = 256, BK = 64, HALF = 128, HTB = HALF * BK * 2  , STAGE_BYTES = 8 * HTB, NXCD = 8, WGM = 8;

__host__ __device__ __forceinline__ int lds_byte(int r, int c) { const int st = (r >> 4) * 2 + (c >> 5), rr = r & 15, cc = c & 31, ob = rr * 64 + cc * 2; return st * 1024 + (ob ^ (((ob >> 9) & 1) << 5)); }
__host__ __device__ __forceinline__ void stage_rc(int b, int& R, int& C) { const int st = b / 1024, sb = b % 1024, swz = sb ^ (((sb >> 9) & 1) << 5); R = (st >> 1) * 16 + swz / 64; C = (st & 1) * 32 + (swz % 64) / 2; }
__host__ __device__ __forceinline__ int perm32(int rho) { const int n = rho >> 4, i = rho & 15; return 8 * (i >> 2) + 4 * n + (i & 3); }

struct Unit { int pm, pn; };
struct Gemm { const bf16_t* A; const bf16_t* Bt; int M, N, K; };

struct StaticOrder {
    int nM, nN, nwg, G, c;
    __host__ __device__ void init(int M, int N, int G_, int c_) { nM = M / BM; nN = N / BM; nwg = nM * nN; G = G_; c = c_; }
    __host__ __device__ bool next(int i, Unit& u) const {
        const long L = (long)i * G + c; if (L >= nwg) return false;
        int wgid = (int)L; { const int q = nwg / NXCD, r = nwg % NXCD, xcd = wgid % NXCD, off = wgid / NXCD; wgid = (xcd < r ? xcd * (q + 1) : r * (q + 1) + (xcd - r) * q) + off; }
        const int nig = WGM * nN, gid = wgid / nig, fm = gid * WGM, gsz = (nM - fm) < WGM ? (nM - fm) : WGM;
        u.pm = fm + ((wgid % nig) % gsz); u.pn = (wgid % nig) / gsz; return true;
    }
    __device__ __forceinline__ void a_ready(const Unit&) const {}
    __device__ __forceinline__ void done(const Unit&) const {}
};

__device__ __forceinline__ unsigned cvt_pk_bf16(float lo, float hi) { unsigned r; asm volatile("v_cvt_pk_bf16_f32 %0, %1, %2" : "=v"(r) : "v"(lo), "v"(hi)); return r; }
typedef float f32x2 __attribute__((ext_vector_type(2)));
template <class Epi, class Sched, bool ALIGN_EPI = false, bool SP2 = false>
__device__ __forceinline__ void gemm_phase(PG8_LAS unsigned char* lds, const Gemm g, const Sched& S, const Epi& E) {
    const int tid = threadIdx.x, wid = __builtin_amdgcn_readfirstlane(tid >> 6), lane = tid & 63, wr = wid >> 2, wc = wid & 3, fr = lane & 15, fq = lane >> 4;
    const int K = g.K, nt = K / BK;
    unsigned voffA[2], voffB[2];
#pragma unroll
    for (int i = 0; i < 2; ++i) { int R, C; stage_rc(tid * 16 + i * 8192, R, C); const int Rb = Epi::PERM ? ((R & ~31) + perm32(R & 31)) : R;
        voffA[i] = (unsigned)(R * K + C) * 2u; voffB[i] = (unsigned)(Rb * K + C) * 2u; }
    const size_t kstep = (size_t)(BK * 2);
    const size_t hstep = (size_t)HALF * K * 2;
    const size_t tstep = 2 * hstep;
    const unsigned ldsw = (unsigned)wid * 1024u;
    const int aoff = lds_byte(wr * 64 + fr, fq * 8), boff = lds_byte(wc * 32 + fr, fq * 8);
#define PG8_SA(b, h) (((b) * 2 + (h)) * HTB)
#define PG8_SB(b, h) ((4 + (b) * 2 + (h)) * HTB)
#define PG8_STAGE(bufoff, gbase, voff) do { _Pragma("unroll") for (int _i = 0; _i < 2; ++_i) \
        __builtin_amdgcn_global_load_lds((const unsigned*)((const char*)(gbase) + (voff)[_i]), (PG8_LAS unsigned*)(lds + (bufoff) + ldsw + _i * 8192), 16, 0, 0); } while (0)
#define PG8_LDA(dst, b, h) do { _Pragma("unroll") for (int m = 0; m < 4; ++m) _Pragma("unroll") for (int k = 0; k < 2; ++k) dst[m][k] = *(const PG8_LAS bf16x8*)(lds + PG8_SA(b, h) + aoff + m * 2048 + k * 1024); } while (0)
#define PG8_LDB(dst, b, h) do { _Pragma("unroll") for (int n = 0; n < 2; ++n) _Pragma("unroll") for (int k = 0; k < 2; ++k) dst[n][k] = *(const PG8_LAS bf16x8*)(lds + PG8_SB(b, h) + boff + n * 2048 + k * 1024); } while (0)
#define PG8_MMA(ai, bj, At, Bt) do { __builtin_amdgcn_s_setprio(1); _Pragma("unroll") for (int m = 0; m < 4; ++m) _Pragma("unroll") for (int n = 0; n < 2; ++n) _Pragma("unroll") for (int k = 0; k < 2; ++k) \
        acc[ai][bj][m][n] = __builtin_amdgcn_mfma_f32_16x16x32_bf16(Bt[n][k], At[m][k], acc[ai][bj][m][n], 0, 0, 0); __builtin_amdgcn_s_setprio(0); } while (0)
#define PG8_WAIT_V(n) asm volatile("s_waitcnt vmcnt(" #n ")" ::: "memory")
#define PG8_WAIT_L(n) asm volatile("s_waitcnt lgkmcnt(" #n ")" ::: "memory")
#define PG8_BAR __builtin_amdgcn_s_barrier()
#define PG8_SCHED __builtin_amdgcn_sched_barrier(0)
    Unit cur, nxt; int ui = 0;
    if (!S.next(0, cur)) return;
    f32x4 acc[2][2][4][2];
#pragma unroll
    for (int a = 0; a < 2; ++a)
#pragma unroll
        for (int b = 0; b < 2; ++b)
#pragma unroll
            for (int m = 0; m < 4; ++m)
#pragma unroll
                for (int n = 0; n < 2; ++n) acc[a][b][m][n] = (f32x4){0.f, 0.f, 0.f, 0.f};
    bf16x8 At[4][2], B0[2][2], B1[2][2];
    const char* cA = (const char*)g.A + (size_t)cur.pm * tstep; const char* cB = (const char*)g.Bt + (size_t)cur.pn * tstep;
    S.a_ready(cur);
    if constexpr (SP2) {
        PG8_STAGE(PG8_SB(0, 0), cB, voffB); PG8_STAGE(PG8_SB(0, 1), cB + hstep, voffB); PG8_STAGE(PG8_SA(0, 0), cA, voffA); PG8_STAGE(PG8_SA(0, 1), cA + hstep, voffA);
        if (wr == 1) PG8_BAR;
        PG8_WAIT_V(2); PG8_BAR;
        PG8_STAGE(PG8_SB(1, 0), cB + kstep, voffB); PG8_STAGE(PG8_SA(1, 0), cA + kstep, voffA); PG8_STAGE(PG8_SB(1, 1), cB + hstep + kstep, voffB);
        PG8_WAIT_V(6); PG8_BAR;
    } else {
        PG8_STAGE(PG8_SB(0, 0), cB, voffB); PG8_STAGE(PG8_SA(0, 0), cA, voffA); PG8_STAGE(PG8_SB(0, 1), cB + hstep, voffB); PG8_STAGE(PG8_SA(0, 1), cA + hstep, voffA);
        if (wr == 1) PG8_BAR;
        PG8_WAIT_V(4); PG8_BAR;
        PG8_STAGE(PG8_SB(1, 0), cB + kstep, voffB); PG8_STAGE(PG8_SA(1, 0), cA + kstep, voffA); PG8_STAGE(PG8_SB(1, 1), cB + hstep + kstep, voffB);
        PG8_WAIT_V(6); PG8_BAR;
    }
    for (;;) {
        const bool has_next = S.next(ui + 1, nxt);
        const char* nA = has_next ? (const char*)g.A + (size_t)nxt.pm * tstep : cA; const char* nB = has_next ? (const char*)g.Bt + (size_t)nxt.pn * tstep : cB;
        for (int t = 0; t < nt; t += 2) {
            if constexpr (Epi::KHOOK) { if (E.khook_at(t)) E.khook(acc, cur, t, wr, wc, fr, fq); }
            const bool last = (t == nt - 2);
            const char* a1 = cA + (size_t)(t + 1) * kstep;
            const char* a2 = last ? nA : cA + (size_t)(t + 2) * kstep; const char* b2 = last ? nB : cB + (size_t)(t + 2) * kstep;
            const char* a3 = a2 + kstep; const char* b3 = b2 + kstep;
            if (last && has_next) S.a_ready(nxt);
            if constexpr (SP2) {
            PG8_LDB(B0, 0, 0); PG8_LDB(B1, 0, 1); PG8_SCHED; PG8_LDA(At, 0, 0); PG8_STAGE(PG8_SA(1, 1), a1 + hstep, voffA);
            PG8_WAIT_V(8); PG8_WAIT_L(0); PG8_BAR; PG8_MMA(0, 0, At, B0); PG8_MMA(0, 1, At, B1); PG8_BAR; PG8_SCHED;
            PG8_LDA(At, 0, 1); PG8_STAGE(PG8_SB(0, 0), b2, voffB); PG8_STAGE(PG8_SB(0, 1), b2 + hstep, voffB); PG8_STAGE(PG8_SA(0, 0), a2, voffA);
            PG8_WAIT_V(8); PG8_WAIT_L(0); PG8_BAR; PG8_MMA(1, 0, At, B0); PG8_MMA(1, 1, At, B1); PG8_BAR; PG8_SCHED;
            PG8_LDB(B0, 1, 0); PG8_LDB(B1, 1, 1); PG8_SCHED; PG8_LDA(At, 1, 0); PG8_STAGE(PG8_SA(0, 1), a2 + hstep, voffA);
            PG8_WAIT_V(8); PG8_WAIT_L(0); PG8_BAR; PG8_MMA(0, 0, At, B0); PG8_MMA(0, 1, At, B1); PG8_BAR; PG8_SCHED;
            PG8_LDA(At, 1, 1); PG8_STAGE(PG8_SB(1, 0), b3, voffB); PG8_STAGE(PG8_SB(1, 1), b3 + hstep, voffB); PG8_STAGE(PG8_SA(1, 0), a3, voffA);
            PG8_WAIT_V(8); PG8_WAIT_L(0); PG8_BAR; PG8_MMA(1, 0, At, B0); PG8_MMA(1, 1, At, B1); PG8_BAR; PG8_SCHED;
            } else {
            PG8_LDB(B0, 0, 0); PG8_SCHED; PG8_LDA(At, 0, 0); PG8_STAGE(PG8_SA(1, 1), a1 + hstep, voffA);
            PG8_WAIT_L(8); PG8_BAR; PG8_WAIT_L(0); PG8_MMA(0, 0, At, B0); PG8_BAR; PG8_SCHED;
            PG8_LDB(B1, 0, 1); PG8_STAGE(PG8_SB(0, 0), b2, voffB);
            PG8_BAR; PG8_WAIT_L(0); PG8_MMA(0, 1, At, B1); PG8_BAR;
            PG8_LDA(At, 0, 1); PG8_STAGE(PG8_SA(0, 0), a2, voffA);
            PG8_BAR; PG8_WAIT_L(0); PG8_MMA(1, 0, At, B0); PG8_BAR; PG8_SCHED;
            PG8_STAGE(PG8_SB(0, 1), b2 + hstep, voffB);
            PG8_WAIT_V(6); PG8_BAR; PG8_MMA(1, 1, At, B1); PG8_BAR;
            PG8_LDB(B0, 1, 0); PG8_SCHED; PG8_LDA(At, 1, 0); PG8_STAGE(PG8_SA(0, 1), a2 + hstep, voffA);
            PG8_WAIT_L(8); PG8_BAR; PG8_WAIT_L(0); PG8_MMA(0, 0, At, B0); PG8_BAR; PG8_SCHED;
            PG8_LDB(B1, 1, 1); PG8_STAGE(PG8_SB(1, 0), b3, voffB);
            PG8_BAR; PG8_WAIT_L(0); PG8_MMA(0, 1, At, B1); PG8_BAR;
            PG8_LDA(At, 1, 1); PG8_STAGE(PG8_SA(1, 0), a3, voffA);
            PG8_BAR; PG8_WAIT_L(0); PG8_MMA(1, 0, At, B0); PG8_BAR; PG8_SCHED;
            PG8_STAGE(PG8_SB(1, 1), b3 + hstep, voffB);
            PG8_WAIT_V(6); PG8_BAR; PG8_MMA(1, 1, At, B1); PG8_BAR;
            }
        }
        if constexpr (ALIGN_EPI) { if (wr == 0) PG8_BAR; }
        if constexpr (!Epi::AFTER_DRAIN) { E(acc, cur, wr, wc, fr, fq); S.done(cur); }
        if (!has_next) break;
#pragma unroll
        for (int a = 0; a < 2; ++a)
#pragma unroll
            for (int b = 0; b < 2; ++b)
#pragma unroll
                for (int m = 0; m < 4; ++m)
#pragma unroll
                    for (int n = 0; n < 2; ++n) acc[a][b][m][n] = (f32x4){0.f, 0.f, 0.f, 0.f};
        cur = nxt; cA = nA; cB = nB; ++ui;
        if constexpr (ALIGN_EPI) { if (wr == 1) PG8_BAR; }
    }
    PG8_WAIT_V(0);
    if constexpr (!ALIGN_EPI) { if (wr == 0) PG8_BAR; }
    PG8_BAR;
    if constexpr (Epi::AFTER_DRAIN) { E.fused(acc, cur, wr, wc, fr, fq, lds, wid, lane); S.done(cur); }
#undef PG8_SA
#undef PG8_SB
#undef PG8_STAGE
#undef PG8_LDA
#undef PG8_LDB
#undef PG8_MMA
#undef PG8_WAIT_V
#undef PG8_WAIT_L
#undef PG8_BAR
#undef PG8_SCHED
}
}
#ifndef PROBE_SUB
#define PROBE_SUB 0
#endif
#ifndef PROBE_DUP
#define PROBE_DUP 0
#endif
#ifndef PROBE_DUPK
#define PROBE_DUPK -1
#endif
#ifndef PROBE_PRO
#define PROBE_PRO 0
#endif
#define LAS __attribute__((address_space(3)))
typedef unsigned short bf16;
typedef float f32x4 __attribute__((ext_vector_type(4)));
typedef unsigned u32x4 __attribute__((ext_vector_type(4)));
typedef unsigned u32x2 __attribute__((ext_vector_type(2)));

constexpr int BATCH = 4, SEQ = 2048, DM = 2048, M = BATCH * SEQ, DEPTH = 2;
constexpr int NIN = 15664, NP = 15872, DFF = 8192;
constexpr int OFF_BQ = 4608, OFF_BKV = 5632, OFF_BG = 6400, OFF_CQ = 6448, OFF_CK = 7472, OFF_CV = 8496, OFF_MG = 9520;
constexpr int BT = 2112;
constexpr int NCMP = 127;
constexpr size_t MiB = 1u << 20;
constexpr size_t WS_WT = 0, LAYER_W = 144 * MiB;
constexpr size_t WO_IN = 0, WO_A = 62 * MiB, WO_B = 64 * MiB, WO_C = 68 * MiB, WO_OUT = 72 * MiB, WO_UP = 80 * MiB, WO_DOWN = 112 * MiB;
constexpr size_t WS_H = 288 * MiB, WS_PROJ = 320 * MiB, WS_U = WS_PROJ;
constexpr size_t WS_OA = 568 * MiB, WS_OB = 576 * MiB, WS_OC = 592 * MiB, WS_OCMP = 608 * MiB;
constexpr size_t WS_MIXF = 640 * MiB, WS_MIXB = 704 * MiB, WS_Y = 736 * MiB;
constexpr size_t WS_KC = 800 * MiB, WS_VC = 801 * MiB, WS_SELM = 802 * MiB, WS_BIAST = 803 * MiB, WS_CW = 804 * MiB, WS_BAR = 812 * MiB, WS_END = 813 * MiB;
constexpr int LDS_BYTES = 147456;
constexpr int PH_PER_LAYER = 9;
constexpr int NPH = 1 + DEPTH * PH_PER_LAYER;

struct Args { const float* in[21]; float* out; unsigned char* ws; int ph_lo, ph_hi; };
constexpr int PTAB_OFF = 131072 + 1024;
struct PT { const unsigned long long* t;
    __device__ __forceinline__ unsigned long long get(int i) const { const unsigned long long v = t[i]; const unsigned lo = __builtin_amdgcn_readfirstlane((unsigned)v), hi = __builtin_amdgcn_readfirstlane((unsigned)(v >> 32)); return ((unsigned long long)hi << 32) | lo; }
    __device__ __forceinline__ const float* in(int i) const { return (const float*)(const __attribute__((address_space(1))) float*)get(i); }
    __device__ __forceinline__ float* out() const { return (float*)(__attribute__((address_space(1))) float*)get(21); }
    __device__ __forceinline__ unsigned char* ws() const { return (unsigned char*)(__attribute__((address_space(1))) unsigned char*)get(22); } };

#define LDS_FENCE() asm volatile("s_waitcnt vmcnt(0) lgkmcnt(0)" ::: "memory")

__device__ __forceinline__ unsigned f2bf(float f) { unsigned u = __builtin_bit_cast(unsigned, f); return (u + 0x7fffu + ((u >> 16) & 1u)) >> 16; }
__device__ __forceinline__ unsigned pk2(float lo, float hi) { return f2bf(lo) | (f2bf(hi) << 16); }
typedef __bf16 bf16v2_t __attribute__((ext_vector_type(2)));
typedef float f32v2_t __attribute__((ext_vector_type(2)));
__device__ __forceinline__ unsigned pkh(float lo, float hi) { f32v2_t v; v.x = lo; v.y = hi; return __builtin_bit_cast(unsigned, __builtin_convertvector(v, bf16v2_t)); }
__device__ __forceinline__ float bf_lo(unsigned w) { return __uint_as_float(w << 16); }
__device__ __forceinline__ float bf_hi(unsigned w) { return __uint_as_float(w & 0xffff0000u); }
__device__ __forceinline__ float bf2f(bf16 h) { return __uint_as_float(((unsigned)h) << 16); }
__device__ __forceinline__ float wave_sum(float v) {
#pragma unroll
    for (int o = 32; o >= 1; o >>= 1) v += __shfl_xor(v, o);
    return v;
}
__device__ __forceinline__ float wave_max(float v) {
#pragma unroll
    for (int o = 32; o >= 1; o >>= 1) v = fmaxf(v, __shfl_xor(v, o));
    return v;
}
__device__ __forceinline__ float sigmoidf_(float x) { return 1.0f / (1.0f + __expf(-x)); }

__device__ __forceinline__ void load64(const bf16* p, float (&q)[64]) {
    const u32x4* p4 = (const u32x4*)p;
#pragma unroll
    for (int i = 0; i < 8; ++i) { const u32x4 w = p4[i];
        q[8 * i + 0] = bf_lo(w.x); q[8 * i + 1] = bf_hi(w.x); q[8 * i + 2] = bf_lo(w.y); q[8 * i + 3] = bf_hi(w.y);
        q[8 * i + 4] = bf_lo(w.z); q[8 * i + 5] = bf_hi(w.z); q[8 * i + 6] = bf_lo(w.w); q[8 * i + 7] = bf_hi(w.w); }
}
__device__ __forceinline__ float dot64(const float (&q)[64], const bf16* k) {
    const u32x4* k4 = (const u32x4*)k; float a0 = 0.f, a1 = 0.f;
#pragma unroll
    for (int i = 0; i < 8; ++i) { const u32x4 w = k4[i];
        a0 += q[8 * i + 0] * bf_lo(w.x); a1 += q[8 * i + 1] * bf_hi(w.x); a0 += q[8 * i + 2] * bf_lo(w.y); a1 += q[8 * i + 3] * bf_hi(w.y);
        a0 += q[8 * i + 4] * bf_lo(w.z); a1 += q[8 * i + 5] * bf_hi(w.z); a0 += q[8 * i + 6] * bf_lo(w.w); a1 += q[8 * i + 7] * bf_hi(w.w); }
    return a0 + a1;
}
__device__ __forceinline__ float wave_softmax(float* S, int n, int lane, float& mout) {
    float m = -3.0e38f;
    for (int i = lane; i < n; i += 64) m = fmaxf(m, S[i]);
    m = wave_max(m);
    float s = 0.f;
    for (int i = lane; i < n; i += 64) { const float e = __expf(S[i] - m); S[i] = e; s += e; }
    s = wave_sum(s); mout = m; return s;
}

struct TItem { const float* W; bf16* WT; int K, N, item, pitch; };
struct TRegs { f32x4 v0[8], v1[8]; };
__device__ __forceinline__ void titem_load(const TItem& t, TRegs& R, int lane) {
    const int nblk = (t.N + 63) / 64, kb = t.item / nblk, nb = t.item % nblk, k0 = 64 * kb, n0 = 64 * nb;
    const int rg = lane >> 4, c4 = lane & 15, nn = n0 + 4 * c4; const bool ok = nn < t.N;
#pragma unroll
    for (int i = 0; i < 8; ++i) { const float* p = t.W + (size_t)(k0 + 8 * i + 2 * rg) * t.N + nn;
        R.v0[i] = ok ? *(const f32x4*)p : (f32x4){0.f, 0.f, 0.f, 0.f}; R.v1[i] = ok ? *(const f32x4*)(p + t.N) : (f32x4){0.f, 0.f, 0.f, 0.f}; }
}
__device__ __forceinline__ void titem_store(const TItem& t, const TRegs& R, float* scrf, int lane) {
    unsigned* scr = (unsigned*)scrf;
    const int nblk = (t.N + 63) / 64, kb = t.item / nblk, nb = t.item % nblk, k0 = 64 * kb, n0 = 64 * nb;
    const int rg = lane >> 4, c4 = lane & 15;
#pragma unroll
    for (int i = 0; i < 8; ++i) { unsigned* q = scr + (4 * i + rg) * 66 + 4 * c4;
        q[0] = pkh(R.v0[i].x, R.v1[i].x); q[1] = pkh(R.v0[i].y, R.v1[i].y); q[2] = pkh(R.v0[i].z, R.v1[i].z); q[3] = pkh(R.v0[i].w, R.v1[i].w); }
    LDS_FENCE();
    const int c = lane & 7;
#pragma unroll
    for (int j = 0; j < 8; ++j) { const int n = (lane >> 3) + 8 * j; const unsigned* s = scr + (4 * c) * 66 + n;
        u32x4 o; o.x = s[0]; o.y = s[66]; o.z = s[132]; o.w = s[198];
        *(u32x4*)(t.WT + (size_t)(n0 + n) * t.pitch + k0 + 8 * c) = o; }
    LDS_FENCE();
}
__device__ __forceinline__ int t5_bucket(int d) {
    if (d < 16) return d;
    const float logd = logf((float)d / 16.0f);
    int far = 16 + (int)(logd / 4.852030263919617f * 16.0f);
    return far < 31 ? far : 31;
}
__device__ __forceinline__ void rms_row_to_bf16(const float* xrow, const float* gain, bf16* orow, int lane) {
    const f32x4* xr = (const f32x4*)xrow + lane; const f32x4* gr = (const f32x4*)gain + lane;
    f32x4 v[8]; float s = 0.f;
#pragma unroll
    for (int j = 0; j < 8; ++j) { v[j] = xr[64 * j]; s += (v[j].x * v[j].x + v[j].y * v[j].y) + (v[j].z * v[j].z + v[j].w * v[j].w); }
    const float r = 1.0f / sqrtf(wave_sum(s) * (1.0f / DM) + 1e-6f);
    u32x2* o8 = (u32x2*)orow + lane;
#pragma unroll
    for (int j = 0; j < 8; ++j) { const f32x4 g = gr[64 * j]; u32x2 w; w.x = pk2(v[j].x * r * g.x, v[j].y * r * g.y); w.y = pk2(v[j].z * r * g.z, v[j].w * r * g.w); o8[64 * j] = w; }
}
__device__ __forceinline__ void rowpass_row(const float* xi, const bf16* y, const float* gp, const float* gn, float* xo, bf16* h, int lane) {
    const u32x2* yr = (const u32x2*)y + lane; const f32x4* xr = (const f32x4*)xi + lane; const f32x4* gpr = (const f32x4*)gp + lane;
    f32x4 v[8]; float s = 0.f;
#pragma unroll
    for (int j = 0; j < 8; ++j) { const u32x2 w = yr[64 * j]; v[j].x = bf_lo(w.x); v[j].y = bf_hi(w.x); v[j].z = bf_lo(w.y); v[j].w = bf_hi(w.y); s += (v[j].x * v[j].x + v[j].y * v[j].y) + (v[j].z * v[j].z + v[j].w * v[j].w); }
    const float r = 1.0f / sqrtf(wave_sum(s) * (1.0f / DM) + 1e-6f);
    float s2 = 0.f;
#pragma unroll
    for (int j = 0; j < 8; ++j) { const f32x4 g = gpr[64 * j]; const f32x4 x = xr[64 * j]; v[j] = x + v[j] * r * g; s2 += (v[j].x * v[j].x + v[j].y * v[j].y) + (v[j].z * v[j].z + v[j].w * v[j].w); }
    f32x4* xw = (f32x4*)xo + lane;
#pragma unroll
    for (int j = 0; j < 8; ++j) xw[64 * j] = v[j];
    if (gn) {
        const float r2 = 1.0f / sqrtf(wave_sum(s2) * (1.0f / DM) + 1e-6f);
        const f32x4* gnr = (const f32x4*)gn + lane; u32x2* o8 = (u32x2*)h + lane;
#pragma unroll
        for (int j = 0; j < 8; ++j) { const f32x4 g = gnr[64 * j]; u32x2 w; w.x = pk2(v[j].x * r2 * g.x, v[j].y * r2 * g.y); w.y = pk2(v[j].z * r2 * g.z, v[j].w * r2 * g.w); o8[64 * j] = w; }
    }
}

constexpr int IT_IN = 32 * 245, IT_A = 8 * 32, IT_B = 16 * 32, IT_C = 16 * 32, IT_OUT = 32 * 32, IT_UP = 32 * 128, IT_DOWN = 128 * 32;
constexpr int IT_W1 = 32 * 4, IT_W2 = 4 * 1;
constexpr int IT_LAYER = IT_IN + IT_A + IT_B + IT_C + IT_OUT + IT_UP + IT_DOWN + 2 * IT_W1 + 2 * IT_W2;

__device__ __forceinline__ TItem decode_item(const PT a, unsigned char* ws, int it) {
    const int l = it / IT_LAYER; int r = it % IT_LAYER;
    unsigned char* wl = ws + WS_WT + (size_t)l * LAYER_W; unsigned char* cw = ws + WS_CW + (size_t)l * 4 * MiB;
    TItem t;
    if (r < IT_IN) { t.W = a.in(2) + (size_t)l * DM * NIN; t.K = DM; t.N = NIN; t.WT = (bf16*)(wl + WO_IN); t.item = r; t.pitch = t.K; return t; } r -= IT_IN;
    if (r < IT_A) { t.W = a.in(11) + (size_t)l * 512 * DM; t.K = 512; t.N = DM; t.WT = (bf16*)(wl + WO_A); t.item = r; t.pitch = 2560; return t; } r -= IT_A;
    if (r < IT_B) { t.W = a.in(12) + (size_t)l * 1024 * DM; t.K = 1024; t.N = DM; t.WT = (bf16*)(wl + WO_A) + 512; t.item = r; t.pitch = 2560; return t; } r -= IT_B;
    if (r < IT_C) { t.W = a.in(13) + (size_t)l * 1024 * DM; t.K = 1024; t.N = DM; t.WT = (bf16*)(wl + WO_A) + 1536; t.item = r; t.pitch = 2560; return t; } r -= IT_C;
    if (r < IT_OUT) { t.W = a.in(14) + (size_t)l * DM * DM; t.K = DM; t.N = DM; t.WT = (bf16*)(wl + WO_OUT); t.item = r; t.pitch = t.K; return t; } r -= IT_OUT;
    if (r < IT_UP) { t.W = a.in(19) + (size_t)l * DM * DFF; t.K = DM; t.N = DFF; t.WT = (bf16*)(wl + WO_UP); t.item = r; t.pitch = t.K; return t; } r -= IT_UP;
    if (r < IT_DOWN) { t.W = a.in(20) + (size_t)l * DFF * DM; t.K = DFF; t.N = DM; t.WT = (bf16*)(wl + WO_DOWN); t.item = r; t.pitch = t.K; return t; } r -= IT_DOWN;
    if (r < IT_W1) { t.W = a.in(5) + (size_t)l * 2048 * 256; t.K = 2048; t.N = 256; t.WT = (bf16*)cw; t.item = r; t.pitch = t.K; return t; } r -= IT_W1;
    if (r < IT_W1) { t.W = a.in(7) + (size_t)l * 2048 * 256; t.K = 2048; t.N = 256; t.WT = (bf16*)(cw + MiB); t.item = r; t.pitch = t.K; return t; } r -= IT_W1;
    if (r < IT_W2) { t.W = a.in(6) + (size_t)l * 256 * 64; t.K = 256; t.N = 64; t.WT = (bf16*)(cw + 2 * MiB); t.item = r; t.pitch = t.K; return t; } r -= IT_W2;
    t.W = a.in(8) + (size_t)l * 256 * 64; t.K = 256; t.N = 64; t.WT = (bf16*)(cw + 2 * MiB + 65536); t.item = r; t.pitch = t.K; return t;
}
__device__ __forceinline__ void phase_prologue(const PT a, float* ldsf, int lane, int wave, int gw, int ngw) {
    float* scr = ldsf + wave * 4096;
    unsigned char* ws = a.ws();
    constexpr int NIT = DEPTH * IT_LAYER;
    if (gw < NIT) {
        int it = gw; TItem cur = decode_item(a, ws, it); TRegs R; titem_load(cur, R, lane);
        for (;;) {
            const int nx = it + ngw; const bool more = nx < NIT;
            TItem nxt = cur; TRegs R2 = R;
            if (more) { nxt = decode_item(a, ws, nx); titem_load(nxt, R2, lane); }
            titem_store(cur, R, scr, lane);
            if (!more) break;
            cur = nxt; R = R2; it = nx;
        }
    }
    float* biasT = (float*)(ws + WS_BIAST);
    for (int i = gw * 64 + lane; i < 48 * BT; i += ngw * 64) { const int col = i / BT, d = i % BT; biasT[i] = a.in(1)[t5_bucket(d) * 48 + col]; }
    for (int m = gw; m < M; m += ngw) rms_row_to_bf16(a.in(0) + (size_t)m * DM, a.in(15), (bf16*)(ws + WS_H) + (size_t)m * DM, lane);
}

struct EpiAny { static constexpr bool PERM = true, AFTER_DRAIN = false, KHOOK = true;
    int mode; bf16* ob; float* of; const bf16* proj;
    __device__ __forceinline__ bool khook_at(int t) const { return mode == 6 && (t == 8 || t == 24); }
    __device__ __forceinline__ void khook(pg8::f32x4 (&acc)[2][2][4][2], const pg8::Unit& u, int t, int wr, int wc, int fr, int fq) const {
        const int step = (t == 8) ? 0 : 1;
        { int tl = (int)threadIdx.x; asm volatile("" : "+v"(tl)); fr = tl & 15; fq = (tl >> 4) & 3; }
#pragma unroll
        for (int ai = 0; ai < 2; ++ai) {
                u32x2 zc[16], zn[16];
#pragma unroll
                for (int q = 0; q < 16; ++q) { const int m = q >> 2, bj = (q >> 1) & 1, n = q & 1;
                    const int row = u.pm * 256 + ai * 128 + wr * 64 + m * 16 + fr, col = u.pn * 256 + bj * 128 + wc * 32 + 8 * fq + 4 * n;
                    const bf16* gp = proj + (size_t)row * NP + OFF_MG + step * DM + col; zc[q] = *(const u32x2*)gp; zn[q] = *(const u32x2*)(gp + DM); }
#pragma unroll
                for (int q = 0; q < 16; ++q) { const int m = q >> 2, bj = (q >> 1) & 1, n = q & 1;
                    pg8::f32x4 t0 = acc[ai][bj][m][n];
                    t0[0] *= (1.f + __expf(-bf_lo(zn[q].x))) * __builtin_amdgcn_rcpf(1.f + __expf(-bf_lo(zc[q].x))); t0[1] *= (1.f + __expf(-bf_hi(zn[q].x))) * __builtin_amdgcn_rcpf(1.f + __expf(-bf_hi(zc[q].x)));
                    t0[2] *= (1.f + __expf(-bf_lo(zn[q].y))) * __builtin_amdgcn_rcpf(1.f + __expf(-bf_lo(zc[q].y))); t0[3] *= (1.f + __expf(-bf_hi(zn[q].y))) * __builtin_amdgcn_rcpf(1.f + __expf(-bf_hi(zc[q].y)));
                    acc[ai][bj][m][n] = t0; }
                asm volatile("" ::: "memory"); }
    }
    __device__ __forceinline__ void store8(int row, int col, f32x4 v0, f32x4 v1, u32x4 gpre) const {
        u32x4 w;
        if (mode == 0) { w.x = pkh(v0.x, v0.y); w.y = pkh(v0.z, v0.w); w.z = pkh(v1.x, v1.y); w.w = pkh(v1.z, v1.w); *(u32x4*)(ob + (size_t)row * NP + col) = w; }
        else if (mode == 4) { w.x = pkh(v0.x, v0.y); w.y = pkh(v0.z, v0.w); w.z = pkh(v1.x, v1.y); w.w = pkh(v1.z, v1.w); *(u32x4*)(ob + (size_t)row * DM + col) = w; }
        else if (mode == 5) {
            v0.x = fmaxf(v0.x, 0.f); v0.y = fmaxf(v0.y, 0.f); v0.z = fmaxf(v0.z, 0.f); v0.w = fmaxf(v0.w, 0.f); v1.x = fmaxf(v1.x, 0.f); v1.y = fmaxf(v1.y, 0.f); v1.z = fmaxf(v1.z, 0.f); v1.w = fmaxf(v1.w, 0.f);
            w.x = pkh(v0.x * v0.x, v0.y * v0.y); w.y = pkh(v0.z * v0.z, v0.w * v0.w); w.z = pkh(v1.x * v1.x, v1.y * v1.y); w.w = pkh(v1.z * v1.z, v1.w * v1.w); *(u32x4*)(ob + (size_t)row * DFF + col) = w; }
        else if (mode == 6) {
            const u32x4 gw_ = gpre;
            w.x = pkh(sigmoidf_(bf_lo(gw_.x)) * v0.x, sigmoidf_(bf_hi(gw_.x)) * v0.y); w.y = pkh(sigmoidf_(bf_lo(gw_.y)) * v0.z, sigmoidf_(bf_hi(gw_.y)) * v0.w);
            w.z = pkh(sigmoidf_(bf_lo(gw_.z)) * v1.x, sigmoidf_(bf_hi(gw_.z)) * v1.y); w.w = pkh(sigmoidf_(bf_lo(gw_.w)) * v1.z, sigmoidf_(bf_hi(gw_.w)) * v1.w);
            *(u32x4*)(ob + (size_t)row * DM + col) = w; }
        else {
            const u32x4 gw_ = *(const u32x4*)(proj + (size_t)row * NP + OFF_MG + (mode - 1) * DM + col);
            f32x4 r0, r1;
            r0.x = sigmoidf_(bf_lo(gw_.x)) * v0.x; r0.y = sigmoidf_(bf_hi(gw_.x)) * v0.y; r0.z = sigmoidf_(bf_lo(gw_.y)) * v0.z; r0.w = sigmoidf_(bf_hi(gw_.y)) * v0.w;
            r1.x = sigmoidf_(bf_lo(gw_.z)) * v1.x; r1.y = sigmoidf_(bf_hi(gw_.z)) * v1.y; r1.z = sigmoidf_(bf_lo(gw_.w)) * v1.z; r1.w = sigmoidf_(bf_hi(gw_.w)) * v1.w;
            u32x4* mp = (u32x4*)(ob + (size_t)row * DM + col);
            if (mode != 1) { const u32x4 o = *mp; r0.x += bf_lo(o.x); r0.y += bf_hi(o.x); r0.z += bf_lo(o.y); r0.w += bf_hi(o.y); r1.x += bf_lo(o.z); r1.y += bf_hi(o.z); r1.z += bf_lo(o.w); r1.w += bf_hi(o.w); }
            w.x = pkh(r0.x, r0.y); w.y = pkh(r0.z, r0.w); w.z = pkh(r1.x, r1.y); w.w = pkh(r1.z, r1.w); *mp = w;
        }
    }
    __device__ __forceinline__ void operator()(const pg8::f32x4 (&acc)[2][2][4][2], const pg8::Unit& u, int wr, int wc, int fr, int fq) const {
#pragma unroll
        for (int ai = 0; ai < 2; ++ai)
#pragma unroll
            for (int mp = 0; mp < 2; ++mp) {
                u32x4 gpre[4];
#pragma unroll
                for (int q = 0; q < 4; ++q) { const int m = 2 * mp + (q >> 1), bj = q & 1; const int row = u.pm * 256 + ai * 128 + wr * 64 + m * 16 + fr, col = u.pn * 256 + bj * 128 + wc * 32 + 8 * fq;
                    gpre[q] = (mode == 6) ? *(const u32x4*)(proj + (size_t)row * NP + OFF_MG + 2 * DM + col) : (u32x4){0u, 0u, 0u, 0u}; }
#pragma unroll
                for (int q = 0; q < 4; ++q) { const int m = 2 * mp + (q >> 1), bj = q & 1; const int row = u.pm * 256 + ai * 128 + wr * 64 + m * 16 + fr, col = u.pn * 256 + bj * 128 + wc * 32 + 8 * fq;
                    const pg8::f32x4 t0 = acc[ai][bj][m][0], t1 = acc[ai][bj][m][1];
                    f32x4 v0, v1; v0.x = t0[0]; v0.y = t0[1]; v0.z = t0[2]; v0.w = t0[3]; v1.x = t1[0]; v1.y = t1[1]; v1.z = t1[2]; v1.w = t1[3]; store8(row, col, v0, v1, gpre[q]); }
                asm volatile("" ::: "memory"); }
    } };


constexpr int KCAT = 2560;
typedef short bf16x8 __attribute__((ext_vector_type(8)));
typedef short bf16x4 __attribute__((ext_vector_type(4)));
typedef float f32x16 __attribute__((ext_vector_type(16)));
#define MFMA32(a, b, c) __builtin_amdgcn_mfma_f32_32x32x16_bf16(a, b, c, 0, 0, 0)

template <int KW, int NDS> struct KVRegs { u32x4 k[KW / 64]; u32x4 v[NDS / 2]; };

template <int KW, int NDS> __device__ __forceinline__ void load_tile(KVRegs<KW, NDS>& R, const bf16* base_b, int tok0, int tstride, int kcol, int vcol, int tid) {
#pragma unroll
    for (int r = 0; r < KW / 64; ++r) { const int idx = tid + 512 * r, key = idx / (KW / 8), ch = idx % (KW / 8);
        R.k[r] = *(const u32x4*)(base_b + (size_t)(tok0 + key * tstride) * NP + kcol + ch * 8); }
#pragma unroll
    for (int r = 0; r < NDS / 2; ++r) { const int idx = tid + 512 * r, key = idx & 63, ch = idx >> 6;
        R.v[r] = *(const u32x4*)(base_b + (size_t)(tok0 + key * tstride) * NP + vcol + ch * 8); }
}
template <int KW, int NDS> __device__ __forceinline__ void store_tile(const KVRegs<KW, NDS>& R, bf16* Ks, bf16* Vt, int tid) {
#pragma unroll
    for (int r = 0; r < KW / 64; ++r) { const int idx = tid + 512 * r, key = idx / (KW / 8), ch = idx % (KW / 8);
        *(u32x4*)(Ks + key * (KW + 8) + ch * 8) = R.k[r]; }
#pragma unroll
    for (int r = 0; r < NDS / 2; ++r) { const int idx = tid + 512 * r, key = idx & 63, ch = idx >> 6; const u32x4 w = R.v[r]; bf16* p = Vt + (ch * 8) * 68 + key;
        p[0 * 68] = (bf16)(w.x & 0xffffu); p[1 * 68] = (bf16)(w.x >> 16); p[2 * 68] = (bf16)(w.y & 0xffffu); p[3 * 68] = (bf16)(w.y >> 16);
        p[4 * 68] = (bf16)(w.z & 0xffffu); p[5 * 68] = (bf16)(w.z >> 16); p[6 * 68] = (bf16)(w.w & 0xffffu); p[7 * 68] = (bf16)(w.w >> 16); }
}
constexpr float LOG2E = 1.4426950408889634f;
constexpr float QSCALE2 = 0.125f * LOG2E;
__device__ __forceinline__ void load_qfrag(const bf16* qrow, int hi, bf16x8 (&qf)[4], float sc) {
#pragma unroll
    for (int c = 0; c < 4; ++c) { const u32x4 w = *(const u32x4*)(qrow + c * 16 + hi * 8); u32x4 o;
        o.x = pkh(bf_lo(w.x) * sc, bf_hi(w.x) * sc); o.y = pkh(bf_lo(w.y) * sc, bf_hi(w.y) * sc);
        o.z = pkh(bf_lo(w.z) * sc, bf_hi(w.z) * sc); o.w = pkh(bf_lo(w.w) * sc, bf_hi(w.w) * sc);
        qf[c] = __builtin_bit_cast(bf16x8, o); }
}
template <int KP, int NDS> __device__ __forceinline__ void attn_tile(const bf16x8 (&qf)[4], const bf16* Ks, const bf16* Vt, float& m, float& l, f32x16 (&O)[NDS],
                                                                       const float* tab, int dq, int maxd, bool tile_ok, int pmode, float cb, int l32, int hi) {
    f32x16 s0, s1;
#pragma unroll
    for (int i = 0; i < 16; ++i) { s0[i] = 0.f; s1[i] = 0.f; }
#pragma unroll
    for (int c = 0; c < 4; ++c) { const bf16x8 a0 = *(const bf16x8*)(Ks + l32 * KP + c * 16 + hi * 8); const bf16x8 a1 = *(const bf16x8*)(Ks + (32 + l32) * KP + c * 16 + hi * 8);
        s0 = MFMA32(a0, qf[c], s0); s1 = MFMA32(a1, qf[c], s1); }
    float mx = -1e30f, sub;
    if (pmode == 2) {
#pragma unroll
        for (int i = 0; i < 16; ++i) mx = fmaxf(mx, fmaxf(s0[i], s1[i]));
        mx = fmaxf(mx, __shfl_xor(mx, 32)) + cb;
    } else if (pmode == 1) {
        const float* tp = tab + (dq - 4 * hi);
#pragma unroll
        for (int h4 = 0; h4 < 4; ++h4) { float bb[4];
#pragma unroll
            for (int j = 0; j < 4; ++j) bb[j] = tp[-(h4 * 8 + j)];
#pragma unroll
            for (int j = 0; j < 4; ++j) { const int i = 4 * h4 + j; s0[i] = tile_ok ? s0[i] + bb[j] : -INFINITY; mx = fmaxf(mx, s0[i]); } }
#pragma unroll
        for (int h4 = 0; h4 < 4; ++h4) { float bb[4];
#pragma unroll
            for (int j = 0; j < 4; ++j) bb[j] = tp[-(32 + h4 * 8 + j)];
#pragma unroll
            for (int j = 0; j < 4; ++j) { const int i = 4 * h4 + j; s1[i] = tile_ok ? s1[i] + bb[j] : -INFINITY; mx = fmaxf(mx, s1[i]); } }
        mx = fmaxf(mx, __shfl_xor(mx, 32));
    } else {
        const int dq4 = dq - 4 * hi, cl = maxd < 2047 ? maxd : 2047;
#pragma unroll
        for (int h4 = 0; h4 < 4; ++h4) { float bb[4];
#pragma unroll
            for (int j = 0; j < 4; ++j) { const int d0 = dq4 - (h4 * 8 + j); bb[j] = tab[d0 < 0 ? 0 : (d0 > cl ? cl : d0)]; }
#pragma unroll
            for (int j = 0; j < 4; ++j) { const int i = 4 * h4 + j; const int d0 = dq4 - (h4 * 8 + j); const bool v0 = tile_ok && (unsigned)d0 <= (unsigned)maxd;
                s0[i] = v0 ? s0[i] + bb[j] : -INFINITY; mx = fmaxf(mx, s0[i]); } }
#pragma unroll
        for (int h4 = 0; h4 < 4; ++h4) { float bb[4];
#pragma unroll
            for (int j = 0; j < 4; ++j) { const int d1 = dq4 - 32 - (h4 * 8 + j); bb[j] = tab[d1 < 0 ? 0 : (d1 > cl ? cl : d1)]; }
#pragma unroll
            for (int j = 0; j < 4; ++j) { const int i = 4 * h4 + j; const int d1 = dq4 - 32 - (h4 * 8 + j); const bool v1 = tile_ok && (unsigned)d1 <= (unsigned)maxd;
                s1[i] = v1 ? s1[i] + bb[j] : -INFINITY; mx = fmaxf(mx, s1[i]); } }
        mx = fmaxf(mx, __shfl_xor(mx, 32));
    }
    const float mn = fmaxf(m, mx), alpha = __builtin_amdgcn_exp2f(m - mn);
    const bool resc = __any(mn != m);
    m = mn; sub = (pmode == 2) ? mn - cb : mn;
    s0 = s0 - sub; s1 = s1 - sub;
#pragma unroll
    for (int i = 0; i < 16; ++i) { s0[i] = __builtin_amdgcn_exp2f(s0[i]); s1[i] = __builtin_amdgcn_exp2f(s1[i]); }
    const f32x16 ss = s0 + s1;
    const float rs = ((ss[0] + ss[1]) + (ss[2] + ss[3])) + ((ss[4] + ss[5]) + (ss[6] + ss[7])) + (((ss[8] + ss[9]) + (ss[10] + ss[11])) + ((ss[12] + ss[13]) + (ss[14] + ss[15])));
    l = l * alpha + rs;
    if (resc) {
#pragma unroll
        for (int ds = 0; ds < NDS; ++ds)
#pragma unroll
            for (int i = 0; i < 16; ++i) O[ds][i] *= alpha;
    }
#pragma unroll
    for (int c = 0; c < 4; ++c) {
        u32x4 pw;
        if (c == 0) { pw.x = pkh(s0[0], s0[1]); pw.y = pkh(s0[2], s0[3]); pw.z = pkh(s0[4], s0[5]); pw.w = pkh(s0[6], s0[7]); }
        else if (c == 1) { pw.x = pkh(s0[8], s0[9]); pw.y = pkh(s0[10], s0[11]); pw.z = pkh(s0[12], s0[13]); pw.w = pkh(s0[14], s0[15]); }
        else if (c == 2) { pw.x = pkh(s1[0], s1[1]); pw.y = pkh(s1[2], s1[3]); pw.z = pkh(s1[4], s1[5]); pw.w = pkh(s1[6], s1[7]); }
        else { pw.x = pkh(s1[8], s1[9]); pw.y = pkh(s1[10], s1[11]); pw.z = pkh(s1[12], s1[13]); pw.w = pkh(s1[14], s1[15]); }
        const bf16x8 pb = __builtin_bit_cast(bf16x8, pw);
#pragma unroll
        for (int ds = 0; ds < NDS; ++ds) { const bf16* vp = Vt + (ds * 32 + l32) * 68 + 16 * c + 4 * hi;
            const u32x2 lo = *(const u32x2*)vp, hi2 = *(const u32x2*)(vp + 8); u32x4 vw; vw.x = lo.x; vw.y = lo.y; vw.z = hi2.x; vw.w = hi2.y;
            O[ds] = MFMA32(__builtin_bit_cast(bf16x8, vw), pb, O[ds]); }
    }
}
template <int KW, int NDS, int SLOT, bool TWO> __device__ __forceinline__ void attn_pass(unsigned tmask, const bf16* base_b, int tok_base, int tstride, int kcol, int vcol, bf16* Ks, bf16* Vt, int kofs,
        const bf16x8 (&qf)[4], float& m, float& l, f32x16 (&O)[NDS], const float* tab, const unsigned char* bk, int iq, int maxd, unsigned okbits, int wave_maxq, int wave_lo, int tid, int l32, int hi) {
    if (!tmask) return;
    KVRegs<KW, NDS> Ra, Rb; int ja = __builtin_ctz(tmask), jb = -1; tmask &= tmask - 1;
    if (TWO && tmask) { jb = __builtin_ctz(tmask); tmask &= tmask - 1; }
    load_tile<KW, NDS>(Ra, base_b, tok_base + ja * 64 * tstride, tstride, kcol, vcol, tid);
    if (TWO && jb >= 0) load_tile<KW, NDS>(Rb, base_b, tok_base + jb * 64 * tstride, tstride, kcol, vcol, tid);
    for (;;) {
        __syncthreads(); store_tile<KW, NDS>(Ra, Ks, Vt, tid); if (TWO && jb >= 0) store_tile<KW, NDS>(Rb, Ks + SLOT, Vt + SLOT, tid); __syncthreads();
        const int ca = ja, cb = jb; const bool more = tmask != 0u;
        if (more) { ja = __builtin_ctz(tmask); tmask &= tmask - 1; jb = -1; if (TWO && tmask) { jb = __builtin_ctz(tmask); tmask &= tmask - 1; }
            load_tile<KW, NDS>(Ra, base_b, tok_base + ja * 64 * tstride, tstride, kcol, vcol, tid);
            if (TWO && jb >= 0) load_tile<KW, NDS>(Rb, base_b, tok_base + jb * 64 * tstride, tstride, kcol, vcol, tid); }
#pragma unroll 1
        for (int s = 0; s < (TWO ? 2 : 1); ++s) { const int c = s ? cb : ca;
            if (c >= 0 && c * 64 <= wave_maxq && c * 64 + 63 >= wave_lo) {
                const bool tok = ((okbits >> c) & 1u) != 0u;
                int pmode = 0; float cbias = 0.f;
                if (bk) { const int dmin = wave_maxq - 31 - c * 64 - 63, dmax = wave_maxq - c * 64;
                    if (dmin >= 0 && dmax <= maxd && dmax <= 2047) { pmode = 1; if (__all(tok) && bk[dmin] == bk[dmax]) { pmode = 2; cbias = tab[dmin]; } } }
                attn_tile<KW + 8, NDS>(qf, Ks + s * SLOT + kofs, Vt + s * SLOT, m, l, O, tab, iq - c * 64, maxd, tok, pmode, cbias, l32, hi); } }
        if (!more) break;
    }
}
__device__ __forceinline__ unsigned range_mask(int lo, int hi_incl) { const unsigned up = (hi_incl >= 31) ? 0xffffffffu : ((1u << (hi_incl + 1)) - 1u); return up & ~((1u << lo) - 1u); }

__device__ __forceinline__ void cmp_unit(const PT a, unsigned char* ldsb, unsigned* selL, int b, int g, int qt, int tid, int lane, int wave) {
    unsigned char* ws = a.ws(); const bf16* proj = (const bf16*)(ws + WS_PROJ);
    const float* kc = (const float*)(ws + WS_KC); const float* vc = (const float*)(ws + WS_VC); float* ocmp = (float*)(ws + WS_OCMP);
    bf16* Khi = (bf16*)ldsb; bf16* Klo = (bf16*)(ldsb + 18432); bf16* Vt = (bf16*)(ldsb + 104448); float* SC = (float*)ldsb;
    const int l32 = lane & 31, hi = lane >> 5;
    __syncthreads();
    {
        const int hh = g * 8 + wave, t0 = qt * 32, tq = t0 + l32, tok = b * SEQ + tq;
        {
            const int n = tid >> 2, seg = tid & 3;
            const f32x4* kp = (const f32x4*)(kc + (size_t)((b * NCMP + (n < NCMP ? n : 0)) * 2 + g) * 64 + seg * 16);
            u32x4 h0, h1, l0, l1; f32x4 x[4];
#pragma unroll
            for (int e = 0; e < 4; ++e) { x[e] = kp[e]; if (n >= NCMP) x[e] = (f32x4){0.f, 0.f, 0.f, 0.f}; }
            unsigned hw[8], lw[8];
#pragma unroll
            for (int e = 0; e < 4; ++e) { const unsigned a0 = f2bf(x[e].x), a1 = f2bf(x[e].y), a2 = f2bf(x[e].z), a3 = f2bf(x[e].w);
                hw[2 * e] = a0 | (a1 << 16); hw[2 * e + 1] = a2 | (a3 << 16);
                lw[2 * e] = pk2(x[e].x - __uint_as_float(a0 << 16), x[e].y - __uint_as_float(a1 << 16)); lw[2 * e + 1] = pk2(x[e].z - __uint_as_float(a2 << 16), x[e].w - __uint_as_float(a3 << 16)); }
            h0.x = hw[0]; h0.y = hw[1]; h0.z = hw[2]; h0.w = hw[3]; h1.x = hw[4]; h1.y = hw[5]; h1.z = hw[6]; h1.w = hw[7];
            l0.x = lw[0]; l0.y = lw[1]; l0.z = lw[2]; l0.w = lw[3]; l1.x = lw[4]; l1.y = lw[5]; l1.z = lw[6]; l1.w = lw[7];
            *(u32x4*)(Khi + n * 72 + seg * 16) = h0; *(u32x4*)(Khi + n * 72 + seg * 16 + 8) = h1;
            *(u32x4*)(Klo + n * 72 + seg * 16) = l0; *(u32x4*)(Klo + n * 72 + seg * 16 + 8) = l1;
            const int nv_ = tid & 127, dseg = tid >> 7;
            const f32x4* vp = (const f32x4*)(vc + (size_t)((b * NCMP + (nv_ < NCMP ? nv_ : 0)) * 2 + g) * 64 + dseg * 16);
#pragma unroll
            for (int e = 0; e < 4; ++e) { f32x4 v = vp[e]; if (nv_ >= NCMP) v = (f32x4){0.f, 0.f, 0.f, 0.f}; bf16* p = Vt + (dseg * 16 + e * 4) * 136 + nv_;
                p[0] = (bf16)f2bf(v.x); p[136] = (bf16)f2bf(v.y); p[272] = (bf16)f2bf(v.z); p[408] = (bf16)f2bf(v.w); }
        }
        bf16x8 qf[4]; load_qfrag(proj + (size_t)tok * NP + OFF_BQ + hh * 64, hi, qf, 0.125f);
        __syncthreads();
        f32x16 s[4];
#pragma unroll
        for (int st = 0; st < 4; ++st) {
#pragma unroll
            for (int i = 0; i < 16; ++i) s[st][i] = 0.f;
#pragma unroll
            for (int c = 0; c < 4; ++c) { const bf16x8 ah = *(const bf16x8*)(Khi + (st * 32 + l32) * 72 + c * 16 + hi * 8); const bf16x8 al = *(const bf16x8*)(Klo + (st * 32 + l32) * 72 + c * 16 + hi * 8);
                s[st] = MFMA32(ah, qf[c], s[st]); s[st] = MFMA32(al, qf[c], s[st]); }
        }
        int nvq = tq >= 31 ? (tq - 31) / 16 + 1 : 0; nvq = nvq < NCMP ? nvq : NCMP;
        float mx = -1e30f;
#pragma unroll
        for (int st = 0; st < 4; ++st)
#pragma unroll
            for (int i = 0; i < 16; ++i) { const int n = 32 * st + (i >> 2) * 8 + 4 * hi + (i & 3); if (n < nvq) mx = fmaxf(mx, s[st][i]); }
        mx = fmaxf(mx, __shfl_xor(mx, 32));
        float rs = 0.f;
#pragma unroll
        for (int st = 0; st < 4; ++st)
#pragma unroll
            for (int i = 0; i < 16; ++i) { const int n = 32 * st + (i >> 2) * 8 + 4 * hi + (i & 3); const float e = (n < nvq) ? __expf(s[st][i] - mx) : 0.f; s[st][i] = e; rs += e; }
        rs += __shfl_xor(rs, 32);
        const float inv = nvq > 0 ? 1.0f / rs : 0.f;
#pragma unroll
        for (int st = 0; st < 4; ++st)
#pragma unroll
            for (int i = 0; i < 16; ++i) s[st][i] *= inv;
        f32x16 O[2];
#pragma unroll
        for (int ds = 0; ds < 2; ++ds)
#pragma unroll
            for (int i = 0; i < 16; ++i) O[ds][i] = 0.f;
#pragma unroll
        for (int st = 0; st < 4; ++st)
#pragma unroll
            for (int c2 = 0; c2 < 2; ++c2) { const int c = 2 * st + c2; u32x4 pw;
                pw.x = pk2(s[st][8 * c2 + 0], s[st][8 * c2 + 1]); pw.y = pk2(s[st][8 * c2 + 2], s[st][8 * c2 + 3]); pw.z = pk2(s[st][8 * c2 + 4], s[st][8 * c2 + 5]); pw.w = pk2(s[st][8 * c2 + 6], s[st][8 * c2 + 7]);
                const bf16x8 pb = __builtin_bit_cast(bf16x8, pw);
#pragma unroll
                for (int ds = 0; ds < 2; ++ds) { const bf16* vp = Vt + (ds * 32 + l32) * 136 + 16 * c + 4 * hi;
                    const u32x2 lo = *(const u32x2*)vp, hi2 = *(const u32x2*)(vp + 8); u32x4 vw; vw.x = lo.x; vw.y = lo.y; vw.z = hi2.x; vw.w = hi2.y;
                    O[ds] = MFMA32(__builtin_bit_cast(bf16x8, vw), pb, O[ds]); } }
#pragma unroll
        for (int ds = 0; ds < 2; ++ds)
#pragma unroll
            for (int i4 = 0; i4 < 4; ++i4) { f32x4 v; v.x = O[ds][i4 * 4 + 0]; v.y = O[ds][i4 * 4 + 1]; v.z = O[ds][i4 * 4 + 2]; v.w = O[ds][i4 * 4 + 3];
                *(f32x4*)(ocmp + (size_t)tok * 1024 + hh * 64 + ds * 32 + i4 * 8 + 4 * hi) = v; }
        __syncthreads();
        {
            float prev_other = 0.f;
#pragma unroll
            for (int st = 0; st < 4; ++st)
#pragma unroll
                for (int i4 = 0; i4 < 4; ++i4) {
                    const float gs = (s[st][4 * i4] + s[st][4 * i4 + 1]) + (s[st][4 * i4 + 2] + s[st][4 * i4 + 3]);
                    const float other = __shfl_xor(s[st][4 * i4 + 3], 32);
                    const float c = gs + (hi ? other : prev_other);
                    prev_other = other;
                    SC[(wave * 32 + l32) * 33 + 8 * st + 2 * i4 + hi] = c;
                }
        }
        __syncthreads();
#pragma unroll 1
        for (int ps = 0; ps < 2; ++ps) {
            const int q = 4 * wave + 2 * ps + hi, j = l32, t = t0 + q, cur = t >> 6;
            float sc = 0.f;
#pragma unroll
            for (int w = 0; w < 8; ++w) sc += SC[(w * 32 + q) * 33 + j];
            if (j == 0 || cur - j == 0 || cur - j == 1) sc = 1e6f;
            if (j > cur) sc = -1e30f;
            int rank = 0;
#pragma unroll 1
            for (int i = 0; i < 32; ++i) { const float si = __shfl(sc, (lane & 32) + i); rank += (si > sc || (si == sc && i < j)) ? 1 : 0; }
            const bool sel = (rank < 16) && (j <= cur);
            const unsigned long long bal = __ballot(sel);
            if (l32 == 0) selL[q] = hi ? (unsigned)(bal >> 32) : (unsigned)bal;
        }
        __syncthreads();
    }
}


__device__ __forceinline__ void phase_nsa_mfma(const PT a, unsigned char* ldsb, int tid, int lane, int wave, int bid, int nblk) {
    unsigned char* ws = a.ws(); const bf16* proj = (const bf16*)(ws + WS_PROJ); const float* biasT = (const float*)(ws + WS_BIAST);
    const float* ocmp = (const float*)(ws + WS_OCMP); bf16* ob = (bf16*)(ws + WS_OA);
    bf16* Ks = (bf16*)ldsb; bf16* Vt = (bf16*)(ldsb + 9216); float* tabs = (float*)(ldsb + 36864); unsigned char* bk = ldsb + 102400; unsigned* selL = (unsigned*)(ldsb + 121856);
    int gcur = -1;
    __syncthreads();
    for (int u = bid; u < 512; u += nblk) {
        const int bg = u & 7, b = bg >> 1, g = bg & 1, qt = u < 256 ? 63 - (u >> 3) : ((u - 256) >> 3);
        if (g != gcur) { __syncthreads();
            for (int i = tid; i < 8 * 2048; i += 512) tabs[i] = biasT[(24 + g * 8 + (i >> 11)) * BT + (i & 2047)] * LOG2E; for (int i = tid; i < 2048; i += 512) bk[i] = (unsigned char)t5_bucket(i); gcur = g; }
        const int hh = g * 8 + wave, t0 = qt * 32;
        const bf16* base_b = proj + (size_t)b * SEQ * NP;
        cmp_unit(a, ldsb, selL, b, g, qt, tid, lane, wave);
        asm volatile("" : "+v"(lane), "+v"(tid) :: "memory");
        const int l32 = lane & 31, hi = lane >> 5, tq = t0 + l32, tok = b * SEQ + tq;
        bf16x8 qf[4]; load_qfrag(proj + (size_t)tok * NP + OFF_BQ + hh * 64, hi, qf, QSCALE2);
        const unsigned mq = selL[l32];
        unsigned un = mq;
#pragma unroll
        for (int o = 1; o < 32; o <<= 1) un |= (unsigned)__shfl_xor((int)un, o);
        un = (unsigned)__builtin_amdgcn_readfirstlane((int)un);
        const float* tab = tabs + wave * 2048;
        f32x16 Os[2], Ow[2]; float m = -1e30f, l = 0.f;
#pragma unroll
        for (int ds = 0; ds < 2; ++ds)
#pragma unroll
            for (int i = 0; i < 16; ++i) { Os[ds][i] = 0.f; Ow[ds][i] = 0.f; }
        attn_pass<64, 2, 8960, true>(un, base_b, 0, 1, OFF_BKV + (4 + g) * 64, OFF_BKV + (6 + g) * 64, Ks, Vt, 0, qf, m, l, Os, tab, bk, tq, 1 << 20, mq, t0 + 31, -(1 << 20), tid, l32, hi);
        const float isel = 1.0f / (l + __shfl_xor(l, 32));
        m = -1e30f; l = 0.f;
        const int wlo = (t0 - 511 > 0 ? t0 - 511 : 0) >> 6, whi = (t0 + 31) >> 6;
        attn_pass<64, 2, 8960, true>(range_mask(wlo, whi), base_b, 0, 1, OFF_BKV + (8 + g) * 64, OFF_BKV + (10 + g) * 64, Ks, Vt, 0, qf, m, l, Ow, tab, bk, tq, 511, 0xffffffffu, t0 + 31, -(1 << 20), tid, l32, hi);
        const float iwin = 1.0f / (l + __shfl_xor(l, 32));
        const bf16* gp = proj + (size_t)tok * NP + OFF_BG + hh * 3;
        const float g0 = sigmoidf_(bf2f(gp[0])), g1 = sigmoidf_(bf2f(gp[1])) * isel, g2 = sigmoidf_(bf2f(gp[2])) * iwin;
#pragma unroll
        for (int ds = 0; ds < 2; ++ds)
#pragma unroll
            for (int i4 = 0; i4 < 4; ++i4) { const int d = ds * 32 + i4 * 8 + 4 * hi; const size_t off = (size_t)tok * 1024 + hh * 64 + d;
                const f32x4 oc = *(const f32x4*)(ocmp + off);
                const float r0 = g0 * oc.x + g1 * Os[ds][i4 * 4 + 0] + g2 * Ow[ds][i4 * 4 + 0], r1 = g0 * oc.y + g1 * Os[ds][i4 * 4 + 1] + g2 * Ow[ds][i4 * 4 + 1];
                const float r2 = g0 * oc.z + g1 * Os[ds][i4 * 4 + 2] + g2 * Ow[ds][i4 * 4 + 2], r3 = g0 * oc.w + g1 * Os[ds][i4 * 4 + 3] + g2 * Ow[ds][i4 * 4 + 3];
                u32x2 w; w.x = pk2(r0, r1); w.y = pk2(r2, r3); *(u32x2*)(ob + (size_t)tok * KCAT + 512 + hh * 64 + d) = w; }
    }
    __syncthreads();
}

__device__ __forceinline__ void phase_diff_mfma(const PT a, int lyr, unsigned char* ldsb, int tid, int lane, int wave, int bid, int nblk) {
    unsigned char* ws = a.ws(); const bf16* proj = (const bf16*)(ws + WS_PROJ); const float* biasT = (const float*)(ws + WS_BIAST); bf16* oc = (bf16*)(ws + WS_OA);
    const float* lv = a.in(9) + (size_t)lyr * 256; const float* sg = a.in(10) + (size_t)lyr * 128;
    const float lam_init = 0.8f - 0.6f * expf(-0.3f * (float)lyr);
    const float lam = expf(wave_sum(lv[lane] * lv[64 + lane])) - expf(wave_sum(lv[128 + lane] * lv[192 + lane])) + lam_init;
    bf16* Ks = (bf16*)ldsb; bf16* Vt = (bf16*)(ldsb + 17408); float* tab = (float*)(ldsb + 69632); unsigned char* bk = ldsb + 77824; float* O2 = (float*)ldsb;
    const int l32 = lane & 31, hi = lane >> 5, mp = wave >> 2, wq = wave & 3;
    int hcur = -1;
    __syncthreads();
    for (int u = bid; u < 512; u += nblk) {
        const int bh = u & 31, b = bh >> 3, h = bh & 7, qt = u < 256 ? 15 - (u >> 5) : ((u - 256) >> 5);
        if (h != hcur) { __syncthreads(); for (int i = tid; i < 2048; i += 512) { tab[i] = biasT[(40 + h) * BT + i] * LOG2E; bk[i] = (unsigned char)t5_bucket(i); } hcur = h; }
        const int t0 = qt * 128, tq = t0 + wq * 32 + l32, tok = b * SEQ + tq;
        const bf16* base_b = proj + (size_t)b * SEQ * NP;
        bf16x8 qf[4]; load_qfrag(proj + (size_t)tok * NP + OFF_CQ + (h * 2 + mp) * 64, hi, qf, QSCALE2);
        f32x16 O[4]; float m = -1e30f, l = 0.f;
#pragma unroll
        for (int ds = 0; ds < 4; ++ds)
#pragma unroll
            for (int i = 0; i < 16; ++i) O[ds][i] = 0.f;
        attn_pass<128, 4, 17408, false>(range_mask(0, (t0 + 127) >> 6), base_b, 0, 1, OFF_CK + h * 128, OFF_CV + h * 128, Ks, Vt, mp * 64, qf, m, l, O, tab, bk, tq, 1 << 20, 0xffffffffu, t0 + wq * 32 + 31, -(1 << 20), tid, l32, hi);
        const float inv = 1.0f / (l + __shfl_xor(l, 32));
        __syncthreads();
        if (mp == 1) {
#pragma unroll
            for (int ds = 0; ds < 4; ++ds)
#pragma unroll
                for (int i = 0; i < 16; ++i) O2[(ds * 16 + i) * 256 + wq * 64 + lane] = O[ds][i] * inv;
        }
        __syncthreads();
        if (mp == 0) {
            float ss = 0.f;
#pragma unroll
            for (int ds = 0; ds < 4; ++ds)
#pragma unroll
                for (int i = 0; i < 16; ++i) { const float o = O[ds][i] * inv - lam * O2[(ds * 16 + i) * 256 + wq * 64 + lane]; O[ds][i] = o; ss += o * o; }
            ss += __shfl_xor(ss, 32);
            const float r = (1.0f - lam_init) / sqrtf(ss * (1.0f / 128.0f) + 1e-6f);
#pragma unroll
            for (int ds = 0; ds < 4; ++ds)
#pragma unroll
                for (int i4 = 0; i4 < 4; ++i4) { const int d = ds * 32 + i4 * 8 + 4 * hi; const f32x4 gn = *(const f32x4*)(sg + d);
                    u32x2 w; w.x = pk2(O[ds][i4 * 4 + 0] * r * gn.x, O[ds][i4 * 4 + 1] * r * gn.y); w.y = pk2(O[ds][i4 * 4 + 2] * r * gn.z, O[ds][i4 * 4 + 3] * r * gn.w);
                    *(u32x2*)(oc + (size_t)tok * KCAT + 1536 + h * 128 + d) = w; }
        }
        __syncthreads();
    }
}


constexpr size_t WS_OAG = WS_MIXF, WS_LSE = WS_MIXB;
__device__ __forceinline__ void phase_dilated_mfma(const PT a, unsigned char* ldsb, int tid, int lane, int wave, int bid, int nblk) {
    unsigned char* ws = a.ws(); const bf16* proj = (const bf16*)(ws + WS_PROJ); const float* biasT = (const float*)(ws + WS_BIAST);
    float* oag = (float*)(ws + WS_OAG); float* lseb = (float*)(ws + WS_LSE);
    bf16* Ks = (bf16*)ldsb; bf16* Vt = (bf16*)(ldsb + 9216); float* tab = (float*)(ldsb + 36864);
    const int l32 = lane & 31, hi = lane >> 5;
    const int nh = (nblk > 64) ? nblk - 64 : nblk, hb = (nblk > 64) ? bid - 64 : bid;
    const int n_heavy_mine = (hb >= 0) ? (512 - hb + nh - 1) / nh : 0;
    const int n_light_mine = (512 - bid + nblk - 1) / nblk;
    for (int it = 0; it < n_heavy_mine + n_light_mine; ++it) {
        const int u = it < n_heavy_mine ? hb + it * nh : 512 + bid + (it - n_heavy_mine) * nblk;
        int g, b, h, r, i0, nq;
        if (u < 256) { g = 0; b = u >> 6; h = (u >> 3) & 7; r = 0; i0 = (u & 7) * 256; nq = 256; }
        else if (u < 512) { const int v = u - 256; g = 1; b = v >> 6; h = (v >> 3) & 7; r = (v >> 1) & 3; i0 = (v & 1) * 256; nq = 256; }
        else { const int v = u - 512; g = 2; b = v >> 7; h = (v >> 4) & 7; r = v & 15; i0 = 0; nq = 128; }
        const int dil = 1 << (2 * g);
        __syncthreads();
        if (tid < 129) tab[tid] = biasT[(g * 8 + h) * BT + tid * dil] * LOG2E;
        const bool act = wave * 32 < nq;
        const int iq = i0 + ((wave * 32) % nq) + l32, tok = b * SEQ + r + dil * iq;
        const bf16* base_b = proj + (size_t)b * SEQ * NP;
        bf16x8 qf[4]; load_qfrag(proj + (size_t)tok * NP + (g * 8 + h) * 64, hi, qf, QSCALE2);
        f32x16 O[2]; float m = -1e30f, l = 0.f;
#pragma unroll
        for (int ds = 0; ds < 2; ++ds)
#pragma unroll
            for (int i = 0; i < 16; ++i) O[ds][i] = 0.f;
        const int wq0 = i0 + wave * 32;
        attn_pass<64, 2, 8960, true>(range_mask((i0 - 128 > 0 ? i0 - 128 : 0) >> 6, (i0 + nq - 1) >> 6), base_b, r, dil, ((3 + g) * 8 + h) * 64, ((6 + g) * 8 + h) * 64, Ks, Vt, 0, qf, m, l, O, tab, (const unsigned char*)nullptr, iq, 128, 0xffffffffu,
                         act ? wq0 + 31 : -1, wq0 - 128, tid, l32, hi);
        if (act) {
            const float lt = l + __shfl_xor(l, 32), inv = 1.0f / lt;
            float* op = oag + ((size_t)g * M + tok) * 512 + h * 64;
#pragma unroll
            for (int ds = 0; ds < 2; ++ds)
#pragma unroll
                for (int i4 = 0; i4 < 4; ++i4) { f32x4 v; v.x = O[ds][i4 * 4 + 0] * inv; v.y = O[ds][i4 * 4 + 1] * inv; v.z = O[ds][i4 * 4 + 2] * inv; v.w = O[ds][i4 * 4 + 3] * inv;
                    *(f32x4*)(op + ds * 32 + i4 * 8 + 4 * hi) = v; }
            if (hi == 0) lseb[((size_t)g * M + tok) * 8 + h] = (m + __log2f(lt)) * 0.6931471805599453f;
        }
    }
    __syncthreads();
}
__device__ __forceinline__ void phase_dil_combine(const PT a, int lane, int gw, int ngw) {
    unsigned char* ws = a.ws(); const float* oag = (const float*)(ws + WS_OAG); const float* lseb = (const float*)(ws + WS_LSE); bf16* oa = (bf16*)(ws + WS_OA);
    for (int tok = gw; tok < M; tok += ngw) {
        const int h = lane >> 3;
        const float l0 = lseb[((size_t)0 * M + tok) * 8 + h], l1 = lseb[((size_t)1 * M + tok) * 8 + h], l2 = lseb[((size_t)2 * M + tok) * 8 + h];
        const float mx = fmaxf(l0, fmaxf(l1, l2)); float w0 = __expf(l0 - mx), w1 = __expf(l1 - mx), w2 = __expf(l2 - mx); const float iw = 1.0f / (w0 + w1 + w2); w0 *= iw; w1 *= iw; w2 *= iw;
        const f32x4* p0 = (const f32x4*)(oag + ((size_t)0 * M + tok) * 512 + lane * 8); const f32x4* p1 = (const f32x4*)(oag + ((size_t)1 * M + tok) * 512 + lane * 8); const f32x4* p2 = (const f32x4*)(oag + ((size_t)2 * M + tok) * 512 + lane * 8);
        const f32x4 x0 = w0 * p0[0] + w1 * p1[0] + w2 * p2[0], x1 = w0 * p0[1] + w1 * p1[1] + w2 * p2[1];
        u32x4 o; o.x = pk2(x0.x, x0.y); o.y = pk2(x0.z, x0.w); o.z = pk2(x1.x, x1.y); o.w = pk2(x1.z, x1.w);
        *(u32x4*)(oa + (size_t)tok * KCAT + lane * 8) = o;
    }
}


__device__ __forceinline__ void phase_compress_mfma(const PT a, int lyr, unsigned char* ldsb, int tid, int lane, int wave, int bid, int nblk) {
    unsigned char* ws = a.ws(); const bf16* proj = (const bf16*)(ws + WS_PROJ);
    unsigned char* cw = ws + WS_CW + (size_t)lyr * 4 * MiB;
    bf16* Ab = (bf16*)ldsb; float* RED = (float*)(ldsb + 17408);
    const int l32 = lane & 31, hi = lane >> 5;
    __syncthreads();
    for (int u = bid; u < 64; u += nblk) {
        const int kv = u >> 5, rg = u & 31;
        const bf16* W1t = (const bf16*)(cw + (size_t)kv * MiB); const bf16* W2t = (const bf16*)(cw + 2 * MiB + (size_t)kv * 65536);
        const float* pos = a.in(3 + kv) + (size_t)lyr * 2048; float* dst = (float*)(ws + (kv ? WS_VC : WS_KC));
        f32x16 acc;
#pragma unroll
        for (int i = 0; i < 16; ++i) acc[i] = 0.f;
        const bf16* wrow = W1t + (size_t)(32 * wave + l32) * 2048 + hi * 8;
#pragma unroll 1
        for (int kc = 0; kc < 8; ++kc) {
            bf16x8 af[16];
#pragma unroll
            for (int kk = 0; kk < 16; ++kk) af[kk] = *(const bf16x8*)(wrow + kc * 256 + kk * 16);
            __syncthreads();
#pragma unroll
            for (int r2 = 0; r2 < 2; ++r2) { const int idx = tid + 512 * r2, row = idx >> 5, ch = idx & 31; int r = rg * 32 + row; r = r < 1016 ? r : 1015;
                const int g = r & 1, bn = r >> 1, b = bn / NCMP, n = bn % NCMP, ll = kc * 4 + (ch >> 3), d = (ch & 7) * 8;
                const u32x4 w = *(const u32x4*)(proj + (size_t)(b * SEQ + 16 * n + ll) * NP + OFF_BKV + (kv * 2 + g) * 64 + d);
                const f32x4 p0 = *(const f32x4*)(pos + ll * 64 + d), p1 = *(const f32x4*)(pos + ll * 64 + d + 4);
                u32x4 o; o.x = pk2(bf_lo(w.x) + p0.x, bf_hi(w.x) + p0.y); o.y = pk2(bf_lo(w.y) + p0.z, bf_hi(w.y) + p0.w); o.z = pk2(bf_lo(w.z) + p1.x, bf_hi(w.z) + p1.y); o.w = pk2(bf_lo(w.w) + p1.z, bf_hi(w.w) + p1.w);
                *(u32x4*)(Ab + row * 264 + ch * 8) = o; }
            __syncthreads();
#pragma unroll
            for (int kk = 0; kk < 16; ++kk) { const bf16x8 bfr = *(const bf16x8*)(Ab + l32 * 264 + kk * 16 + hi * 8); acc = MFMA32(af[kk], bfr, acc); }
        }
#pragma unroll
        for (int i = 0; i < 16; ++i) { const float v = acc[i]; acc[i] = 0.5f * v * (1.0f + tanhf(0.7978845608028654f * (v + 0.044715f * v * v * v))); }
        f32x16 o2[2];
#pragma unroll
        for (int ds = 0; ds < 2; ++ds)
#pragma unroll
            for (int i = 0; i < 16; ++i) o2[ds][i] = 0.f;
#pragma unroll
        for (int c2 = 0; c2 < 2; ++c2) { u32x4 pw; pw.x = pk2(acc[8 * c2 + 0], acc[8 * c2 + 1]); pw.y = pk2(acc[8 * c2 + 2], acc[8 * c2 + 3]); pw.z = pk2(acc[8 * c2 + 4], acc[8 * c2 + 5]); pw.w = pk2(acc[8 * c2 + 6], acc[8 * c2 + 7]);
            const bf16x8 hb = __builtin_bit_cast(bf16x8, pw);
#pragma unroll
            for (int ds = 0; ds < 2; ++ds) { const bf16* wp = W2t + (size_t)(ds * 32 + l32) * 256 + 32 * wave + 16 * c2 + 4 * hi;
                const u32x2 lo = *(const u32x2*)wp, hi2 = *(const u32x2*)(wp + 8); u32x4 vw; vw.x = lo.x; vw.y = lo.y; vw.z = hi2.x; vw.w = hi2.y;
                o2[ds] = MFMA32(__builtin_bit_cast(bf16x8, vw), hb, o2[ds]); } }
#pragma unroll
        for (int ds = 0; ds < 2; ++ds)
#pragma unroll
            for (int i = 0; i < 16; ++i) RED[(wave * 64 + ds * 32 + (i >> 2) * 8 + 4 * hi + (i & 3)) * 33 + l32] = o2[ds][i];
        __syncthreads();
#pragma unroll
        for (int e = 0; e < 4; ++e) { const int idx = tid + 512 * e, d = idx & 63, row = idx >> 6; float s = 0.f;
#pragma unroll
            for (int w = 0; w < 8; ++w) s += RED[(w * 64 + d) * 33 + row];
            const int r = rg * 32 + row; if (r < 1016) dst[(size_t)r * 64 + d] = s; }
        __syncthreads();
    }
}

#define XB_TMO      128
#define XB_XCNT(j)  (256  + 64 * (j))
#define XB_XSUB(j)  (1280 + 64 * (j))
#define XB_XGEN(j)  (2304 + 64 * (j))
#define XB_TOP      3328
#define XB_TOPGEN   3392
#define XCD_BAR_WORDS 3456
#define XB_SPIN_CAP (1u << 18)

__device__ __forceinline__ unsigned xb_ld(unsigned* p)              { return __hip_atomic_load(p, __ATOMIC_RELAXED, __HIP_MEMORY_SCOPE_AGENT); }
__device__ __forceinline__ unsigned xb_add(unsigned* p, unsigned v) { return __hip_atomic_fetch_add(p, v, __ATOMIC_RELAXED, __HIP_MEMORY_SCOPE_AGENT); }
__device__ __forceinline__ unsigned xb_xcc_id() { return (unsigned)__builtin_amdgcn_s_getreg((3 << 11) | 20) & 0xFu; }
#define XB_SPIN(cond, bar) do { unsigned _sp = 0; while (cond) { __builtin_amdgcn_s_sleep(1); \
    if ((++_sp & 255u) == 0u) { if (xb_ld(&(bar)[XB_TMO])) break; if (_sp > XB_SPIN_CAP) { atomicAdd(&(bar)[XB_TMO], 1u); break; } } } } while (0)

struct XcdBarrier {
    unsigned* bar; unsigned x;
    volatile LAS unsigned* st;
};

__device__ __forceinline__ XcdBarrier xcd_barrier_post(unsigned* bar, volatile LAS unsigned* st) {
    XcdBarrier b; b.bar = bar; b.x = xb_xcc_id(); b.st = st;
    if (threadIdx.x == 0) (void)xb_add(&bar[XB_XCNT(b.x)], 1u);
    return b;
}
__device__ __forceinline__ void xcd_barrier_complete(unsigned* bar, unsigned x, unsigned& nloc, unsigned& nx) {
    const unsigned G = gridDim.x * gridDim.y * gridDim.z;
    unsigned sum, cnt, mine, sp = 0u;
    for (;;) {
        sum = 0u; cnt = 0u; mine = 0u;
#pragma unroll
        for (unsigned j = 0; j < 16; ++j) { const unsigned c = xb_ld(&bar[XB_XCNT(j)]); sum += c; cnt += (c > 0u) ? 1u : 0u; mine = (j == x) ? c : mine; }
        if (sum == G) break;
        __builtin_amdgcn_s_sleep(1);
        if ((++sp & 255u) == 0u) { if (xb_ld(&bar[XB_TMO])) break; if (sp > XB_SPIN_CAP) { atomicAdd(&bar[XB_TMO], 1u); break; } }
    }
    nloc = mine > 0u ? mine : 1u; nx = cnt > 0u ? cnt : 1u;
}

__device__ __forceinline__ void xcd_barrier(const XcdBarrier& b) {
    asm volatile("s_waitcnt vmcnt(0)" ::: "memory");
    __syncthreads();
    if (threadIdx.x == 0) {
        unsigned* bar = b.bar;
        __builtin_amdgcn_s_waitcnt(0);
        unsigned nloc = b.st[0], nx = b.st[1];
        if (nloc == 0u) { xcd_barrier_complete(bar, b.x, nloc, nx); b.st[0] = nloc; b.st[1] = nx; }
        const unsigned old = xb_add(&bar[XB_XSUB(b.x)], 1u);
        const unsigned gen = old / nloc;
        if (old + 1u == (gen + 1u) * nloc) {
            __builtin_amdgcn_fence(__ATOMIC_RELEASE, "agent");
            asm volatile("s_waitcnt vmcnt(0)" ::: "memory");
            const unsigned og = xb_add(&bar[XB_TOP], 1u);
            const unsigned tg = og / nx;
            if (og + 1u == (tg + 1u) * nx) xb_add(&bar[XB_TOPGEN], 1u);
            else XB_SPIN(xb_ld(&bar[XB_TOPGEN]) == tg, bar);
            __builtin_amdgcn_fence(__ATOMIC_ACQUIRE, "agent");
            xb_add(&bar[XB_XGEN(b.x)], 1u);
            asm volatile("s_waitcnt vmcnt(0)" ::: "memory");
        } else {
            XB_SPIN(xb_ld(&bar[XB_XGEN(b.x)]) == gen, bar);
            __builtin_amdgcn_fence(__ATOMIC_ACQUIRE, "agent");
            asm volatile("s_waitcnt vmcnt(0)" ::: "memory");
        }
    }
    __syncthreads();
}

__global__ void __launch_bounds__(512, 2) mega_fwd(Args ka) {
    extern __shared__ __attribute__((aligned(16))) unsigned char lds[];
    LAS unsigned char* ldsl = (LAS unsigned char*)lds;
    const int tid0 = threadIdx.x;
    {
        unsigned long long* pt = (unsigned long long*)(lds + PTAB_OFF);
        if (tid0 < 21) pt[tid0] = (unsigned long long)ka.in[tid0];
        if (tid0 == 21) pt[21] = (unsigned long long)ka.out;
        if (tid0 == 22) pt[22] = (unsigned long long)ka.ws;
        if (tid0 == 23) { pt[32] = 0ull; }
        __syncthreads();
    }
    const int ph_lo = ka.ph_lo, ph_hi = ka.ph_hi;
    cg::grid_group grid = cg::this_grid();
    (void)xcd_barrier_post((unsigned*)(__attribute__((address_space(1))) unsigned*)(ka.ws + WS_BAR), (volatile LAS unsigned*)(ldsl + PTAB_OFF + 256));
    for (int ph = ph_lo; ph < ph_hi; ++ph) {
        unsigned ldso0 = 0; asm volatile("" : "+s"(ldso0));
        const PT a{(const unsigned long long*)(lds + PTAB_OFF + ldso0)};
        if (ph == 0) { int tidp = tid0; asm volatile("" : "+v"(tidp)); const int lanep = tidp & 63, wavep = __builtin_amdgcn_readfirstlane(tidp >> 6);
            phase_prologue(a, (float*)(lds + ldso0), lanep, wavep, (int)blockIdx.x * 8 + wavep, (int)gridDim.x * 8); }
        else {
            const int l = (ph - 1) / PH_PER_LAYER; int k = (ph - 1) % PH_PER_LAYER; if (k >= 2) k += 1;
            unsigned char* ws = a.ws();
            unsigned char* wl = ws + WS_WT + (size_t)l * LAYER_W;
            bf16* H = (bf16*)(ws + WS_H); bf16* proj = (bf16*)(ws + WS_PROJ);
            int njobs = 0, mode0 = 0, N = 0, K = 0; const bf16* A0 = nullptr; const bf16* B0 = nullptr; bf16* ob = nullptr; float* of = nullptr;
            if (k == 0) { njobs = 1; mode0 = 0; A0 = H; B0 = (const bf16*)(wl + WO_IN); N = NP; K = DM; ob = proj; }
            else if (k == 4) { njobs = 1; mode0 = 6; A0 = (const bf16*)(ws + WS_OA); B0 = (const bf16*)(wl + WO_A); N = DM; K = KCAT; ob = (bf16*)(ws + WS_MIXB); }
            else if (k == 5) { njobs = 1; mode0 = 4; A0 = (const bf16*)(ws + WS_MIXB); B0 = (const bf16*)(wl + WO_OUT); N = DM; K = DM; ob = (bf16*)(ws + WS_Y); }
            else if (k == 7) { njobs = 1; mode0 = 5; A0 = H; B0 = (const bf16*)(wl + WO_UP); N = DFF; K = DM; ob = (bf16*)(ws + WS_U); }
            else if (k == 8) { njobs = 1; mode0 = 4; A0 = (const bf16*)(ws + WS_U); B0 = (const bf16*)(wl + WO_DOWN); N = DM; K = DFF; ob = (bf16*)(ws + WS_Y); }
            for (int j = 0; j < njobs; ++j) {
                const bf16* A = A0; const bf16* B = B0; int Kj = K;
                pg8::Gemm g{A, B, M, N, Kj}; pg8::StaticOrder S; S.init(M, N, (int)gridDim.x, (int)blockIdx.x);
                EpiAny E{mode0 + j, ob, of, proj};
                pg8::gemm_phase<EpiAny, pg8::StaticOrder, true, true>(ldsl, g, S, E);
            }
            int tid = tid0; asm volatile("" : "+v"(tid));
            int bid = (int)blockIdx.x, nblk = (int)gridDim.x; asm volatile("" : "+s"(bid), "+s"(nblk));
            unsigned ldso = 0; asm volatile("" : "+s"(ldso));
            float* ldsf = (float*)(lds + ldso);
            const int lane = tid & 63, wave = __builtin_amdgcn_readfirstlane(tid >> 6);
            const int gw = bid * 8 + wave, ngw = nblk * 8;
            if (k == 1) {
                for (int rep = 0; rep < ((PROBE_SUB & 1) ? 2 : 1); ++rep) { asm volatile("" : "+v"(tid), "+s"(bid)); phase_compress_mfma(a, l, (unsigned char*)ldsf, tid, tid & 63, __builtin_amdgcn_readfirstlane(tid >> 6), bid, nblk); }
                for (int rep = 0; rep < ((PROBE_SUB & 2) ? 2 : 1); ++rep) { asm volatile("" : "+v"(tid), "+s"(bid)); phase_dilated_mfma(a, (unsigned char*)ldsf, tid, tid & 63, __builtin_amdgcn_readfirstlane(tid >> 6), bid, nblk); }
                for (int rep = 0; rep < ((PROBE_SUB & 4) ? 2 : 1); ++rep) { asm volatile("" : "+v"(tid), "+s"(bid)); phase_diff_mfma(a, l, (unsigned char*)ldsf, tid, tid & 63, __builtin_amdgcn_readfirstlane(tid >> 6), bid, nblk); } }
            else if (k == 3) { phase_dil_combine(a, lane, gw, ngw); phase_nsa_mfma(a, (unsigned char*)ldsf, tid, lane, wave, bid, nblk); }
            else if (k == 6) { float* xo = a.out(); const float* xi = (l == 0) ? a.in(0) : xo;
                for (int m = gw; m < M; m += ngw) rowpass_row(xi + (size_t)m * DM, (const bf16*)(ws + WS_Y) + (size_t)m * DM, a.in(16) + (size_t)l * DM, a.in(17) + (size_t)l * DM, xo + (size_t)m * DM, H + (size_t)m * DM, lane); }
            else if (k == 9) { float* xo = a.out(); const float* gn = (l + 1 < DEPTH) ? a.in(15) + (size_t)(l + 1) * DM : nullptr;
                for (int m = gw; m < M; m += ngw) rowpass_row(xo + (size_t)m * DM, (const bf16*)(ws + WS_Y) + (size_t)m * DM, a.in(18) + (size_t)l * DM, gn, xo + (size_t)m * DM, H + (size_t)m * DM, lane); }
        }
        if (ph + 1 < ph_hi) { XcdBarrier xbar; xbar.bar = (unsigned*)(a.ws() + WS_BAR); xbar.x = xb_xcc_id(); xbar.st = (volatile LAS unsigned*)(ldsl + PTAB_OFF + 256); xcd_barrier(xbar); }
        if (ph_hi > 100000) grid.sync();
    }
}

#ifndef N_LAUNCH_SPLIT
#define N_LAUNCH_SPLIT 0
#endif
extern "C" void kernel_launch(void* const* d_in, const int* in_sizes, int n_in, void* d_out, int out_size, void* d_ws, size_t ws_size, hipStream_t stream) {
    static int grid = 0;
    if (grid == 0) {
        if (n_in != 21 || out_size != M * DM || ws_size < WS_END) { fprintf(stderr, "kernel_launch: unexpected shapes (n_in %d out %d ws %zu)\n", n_in, out_size, ws_size); grid = -1; return; }
        int dev = 0, cus = 0, per_cu = 0;
        (void)hipGetDevice(&dev); (void)hipDeviceGetAttribute(&cus, hipDeviceAttributeMultiprocessorCount, dev);
        if (hipFuncSetAttribute((const void*)mega_fwd, hipFuncAttributeMaxDynamicSharedMemorySize, LDS_BYTES) != hipSuccess) { fprintf(stderr, "hipFuncSetAttribute failed\n"); grid = -1; return; }
        if (hipOccupancyMaxActiveBlocksPerMultiprocessor(&per_cu, (const void*)mega_fwd, 512, LDS_BYTES) != hipSuccess || per_cu < 1) { fprintf(stderr, "occupancy query: %d\n", per_cu); per_cu = 1; }
        (void)hipGetLastError();
        grid = cus > 0 ? cus : 256;
    }
    if (grid < 0) return;
    if (hipMemsetAsync((char*)d_ws + WS_BAR, 0, 16384, stream) != hipSuccess) { fprintf(stderr, "kernel_launch: memset of the barrier words failed\n"); return; }
    Args a{};
    for (int i = 0; i < 21; ++i) a.in[i] = (const float*)d_in[i];
    a.out = (float*)d_out; a.ws = (unsigned char*)d_ws;
#if N_LAUNCH_SPLIT
    for (int ph = 0; ph < NPH; ++ph) { a.ph_lo = ph; a.ph_hi = ph + 1; hipLaunchKernelGGL(mega_fwd, dim3(grid), dim3(512), LDS_BYTES, stream, a); }
#else
    a.ph_lo = 0; a.ph_hi = NPH;
    void* args[] = {&a};
    hipError_t e = hipLaunchCooperativeKernel((const void*)mega_fwd, dim3(grid), dim3(512), args, LDS_BYTES, stream);
    if (e != hipSuccess) fprintf(stderr, "cooperative launch failed: %s (grid %d)\n", hipGetErrorString(e), grid);
#endif
}
```

```cpp
#include <hip/hip_runtime.h>
#include <hip/hip_cooperative_groups.h>
#include <cstdio>
#include <cstdint>
namespace cg = cooperative_groups;
namespace pg8 {
#define PG8_LAS __attribute__((address_space(3)))
typedef unsigned short bf16_t;
typedef short bf16x8 __attribute__((ext_vector_type(8)));
typedef float f32x4 __attribute__((ext_vector_type(4)));
typedef unsigned u32x4 __attribute__((ext_vector_type(4)));
constexpr int BM = 256, BK = 64, HALF = 128, HTB = HALF * BK * 2  , STAGE_BYTES = 8 * HTB, NXCD = 8, WGM = 8;

__host__ __device__ __forceinline__ int lds_byte(int r, int c) { const int st = (r >> 4) * 2 + (c >> 5), rr = r & 15, cc = c & 31, ob = rr * 64 + cc * 2; return st * 1024 + (ob ^ (((ob >> 9) & 1) << 5)); }
__host__ __device__ __forceinline__ void stage_rc(int b, int& R, int& C) { const int st = b / 1024, sb = b % 1024, swz = sb ^ (((sb >> 9) & 1) << 5); R = (st >> 1) * 16 + swz / 64; C = (st & 1) * 32 + (swz % 64) / 2; }
__host__ __device__ __forceinline__ int perm32(int rho) { const int n = rho >> 4, i = rho & 15; return 8 * (i >> 2) + 4 * n + (i & 3); }

struct Unit { int pm, pn; };
struct Gemm { const bf16_t* A; const bf16_t* Bt; int M, N, K; };

struct StaticOrder {
    int nM, nN, nwg, G, c;
    __host__ __device__ void init(int M, int N, int G_, int c_) { nM = M / BM; nN = N / BM; nwg = nM * nN; G = G_; c = c_; }
    __host__ __device__ bool next(int i, Unit& u) const {
        const long L = (long)i * G + c; if (L >= nwg) return false;
        int wgid = (int)L; { const int q = nwg / NXCD, r = nwg % NXCD, xcd = wgid % NXCD, off = wgid / NXCD; wgid = (xcd < r ? xcd * (q + 1) : r * (q + 1) + (xcd - r) * q) + off; }
        const int nig = WGM * nN, gid = wgid / nig, fm = gid * WGM, gsz = (nM - fm) < WGM ? (nM - fm) : WGM;
        u.pm = fm + ((wgid % nig) % gsz); u.pn = (wgid % nig) / gsz; return true;
    }
    __device__ __forceinline__ void a_ready(const Unit&) const {}
    __device__ __forceinline__ void done(const Unit&) const {}
};

__device__ __forceinline__ unsigned cvt_pk_bf16(float lo, float hi) { unsigned r; asm volatile("v_cvt_pk_bf16_f32 %0, %1, %2" : "=v"(r) : "v"(lo), "v"(hi)); return r; }
typedef float f32x2 __attribute__((ext_vector_type(2)));
template <class Epi, class Sched, bool ALIGN_EPI = false, bool SP2 = false>
__device__ __forceinline__ void gemm_phase(PG8_LAS unsigned char* lds, const Gemm g, const Sched& S, const Epi& E) {
    const int tid = threadIdx.x, wid = __builtin_amdgcn_readfirstlane(tid >> 6), lane = tid & 63, wr = wid >> 2, wc = wid & 3, fr = lane & 15, fq = lane >> 4;
    const int K = g.K, nt = K / BK;
    unsigned voffA[2], voffB[2];
#pragma unroll
    for (int i = 0; i < 2; ++i) { int R, C; stage_rc(tid * 16 + i * 8192, R, C); const int Rb = Epi::PERM ? ((R & ~31) + perm32(R & 31)) : R;
        voffA[i] = (unsigned)(R * K + C) * 2u; voffB[i] = (unsigned)(Rb * K + C) * 2u; }
    const size_t kstep = (size_t)(BK * 2);
    const size_t hstep = (size_t)HALF * K * 2;
    const size_t tstep = 2 * hstep;
    const unsigned ldsw = (unsigned)wid * 1024u;
    const int aoff = lds_byte(wr * 64 + fr, fq * 8), boff = lds_byte(wc * 32 + fr, fq * 8);
#define PG8_SA(b, h) (((b) * 2 + (h)) * HTB)
#define PG8_SB(b, h) ((4 + (b) * 2 + (h)) * HTB)
#define PG8_STAGE(bufoff, gbase, voff) do { _Pragma("unroll") for (int _i = 0; _i < 2; ++_i) \
        __builtin_amdgcn_global_load_lds((const unsigned*)((const char*)(gbase) + (voff)[_i]), (PG8_LAS unsigned*)(lds + (bufoff) + ldsw + _i * 8192), 16, 0, 0); } while (0)
#define PG8_LDA(dst, b, h) do { _Pragma("unroll") for (int m = 0; m < 4; ++m) _Pragma("unroll") for (int k = 0; k < 2; ++k) dst[m][k] = *(const PG8_LAS bf16x8*)(lds + PG8_SA(b, h) + aoff + m * 2048 + k * 1024); } while (0)
#define PG8_LDB(dst, b, h) do { _Pragma("unroll") for (int n = 0; n < 2; ++n) _Pragma("unroll") for (int k = 0; k < 2; ++k) dst[n][k] = *(const PG8_LAS bf16x8*)(lds + PG8_SB(b, h) + boff + n * 2048 + k * 1024); } while (0)
#define PG8_MMA(ai, bj, At, Bt) do { __builtin_amdgcn_s_setprio(1); _Pragma("unroll") for (int m = 0; m < 4; ++m) _Pragma("unroll") for (int n = 0; n < 2; ++n) _Pragma("unroll") for (int k = 0; k < 2; ++k) \
        acc[ai][bj][m][n] = __builtin_amdgcn_mfma_f32_16x16x32_bf16(Bt[n][k], At[m][k], acc[ai][bj][m][n], 0, 0, 0); __builtin_amdgcn_s_setprio(0); } while (0)
#define PG8_WAIT_V(n) asm volatile("s_waitcnt vmcnt(" #n ")" ::: "memory")
#define PG8_WAIT_L(n) asm volatile("s_waitcnt lgkmcnt(" #n ")" ::: "memory")
#define PG8_BAR __builtin_amdgcn_s_barrier()
#define PG8_SCHED __builtin_amdgcn_sched_barrier(0)
    Unit cur, nxt; int ui = 0;
    if (!S.next(0, cur)) return;
    f32x4 acc[2][2][4][2];
#pragma unroll
    for (int a = 0; a < 2; ++a)
#pragma unroll
        for (int b = 0; b < 2; ++b)
#pragma unroll
            for (int m = 0; m < 4; ++m)
#pragma unroll
                for (int n = 0; n < 2; ++n) acc[a][b][m][n] = (f32x4){0.f, 0.f, 0.f, 0.f};
    bf16x8 At[4][2], B0[2][2], B1[2][2];
    const char* cA = (const char*)g.A + (size_t)cur.pm * tstep; const char* cB = (const char*)g.Bt + (size_t)cur.pn * tstep;
    S.a_ready(cur);
    if constexpr (SP2) {
        PG8_STAGE(PG8_SB(0, 0), cB, voffB); PG8_STAGE(PG8_SB(0, 1), cB + hstep, voffB); PG8_STAGE(PG8_SA(0, 0), cA, voffA); PG8_STAGE(PG8_SA(0, 1), cA + hstep, voffA);
        if (wr == 1) PG8_BAR;
        PG8_WAIT_V(2); PG8_BAR;
        PG8_STAGE(PG8_SB(1, 0), cB + kstep, voffB); PG8_STAGE(PG8_SA(1, 0), cA + kstep, voffA); PG8_STAGE(PG8_SB(1, 1), cB + hstep + kstep, voffB);
        PG8_WAIT_V(6); PG8_BAR;
    } else {
        PG8_STAGE(PG8_SB(0, 0), cB, voffB); PG8_STAGE(PG8_SA(0, 0), cA, voffA); PG8_STAGE(PG8_SB(0, 1), cB + hstep, voffB); PG8_STAGE(PG8_SA(0, 1), cA + hstep, voffA);
        if (wr == 1) PG8_BAR;
        PG8_WAIT_V(4); PG8_BAR;
        PG8_STAGE(PG8_SB(1, 0), cB + kstep, voffB); PG8_STAGE(PG8_SA(1, 0), cA + kstep, voffA); PG8_STAGE(PG8_SB(1, 1), cB + hstep + kstep, voffB);
        PG8_WAIT_V(6); PG8_BAR;
    }
    for (;;) {
        const bool has_next = S.next(ui + 1, nxt);
        const char* nA = has_next ? (const char*)g.A + (size_t)nxt.pm * tstep : cA; const char* nB = has_next ? (const char*)g.Bt + (size_t)nxt.pn * tstep : cB;
        for (int t = 0; t < nt; t += 2) {
            if constexpr (Epi::KHOOK) { if (E.khook_at(t)) E.khook(acc, cur, t, wr, wc, fr, fq); }
            const bool last = (t == nt - 2);
            const char* a1 = cA + (size_t)(t + 1) * kstep;
            const char* a2 = last ? nA : cA + (size_t)(t + 2) * kstep; const char* b2 = last ? nB : cB + (size_t)(t + 2) * kstep;
            const char* a3 = a2 + kstep; const char* b3 = b2 + kstep;
            if (last && has_next) S.a_ready(nxt);
            if constexpr (SP2) {
            PG8_LDB(B0, 0, 0); PG8_LDB(B1, 0, 1); PG8_SCHED; PG8_LDA(At, 0, 0); PG8_STAGE(PG8_SA(1, 1), a1 + hstep, voffA);
            PG8_WAIT_V(8); PG8_WAIT_L(0); PG8_BAR; PG8_MMA(0, 0, At, B0); PG8_MMA(0, 1, At, B1); PG8_BAR; PG8_SCHED;
            PG8_LDA(At, 0, 1); PG8_STAGE(PG8_SB(0, 0), b2, voffB); PG8_STAGE(PG8_SB(0, 1), b2 + hstep, voffB); PG8_STAGE(PG8_SA(0, 0), a2, voffA);
            PG8_WAIT_V(8); PG8_WAIT_L(0); PG8_BAR; PG8_MMA(1, 0, At, B0); PG8_MMA(1, 1, At, B1); PG8_BAR; PG8_SCHED;
            PG8_LDB(B0, 1, 0); PG8_LDB(B1, 1, 1); PG8_SCHED; PG8_LDA(At, 1, 0); PG8_STAGE(PG8_SA(0, 1), a2 + hstep, voffA);
            PG8_WAIT_V(8); PG8_WAIT_L(0); PG8_BAR; PG8_MMA(0, 0, At, B0); PG8_MMA(0, 1, At, B1); PG8_BAR; PG8_SCHED;
            PG8_LDA(At, 1, 1); PG8_STAGE(PG8_SB(1, 0), b3, voffB); PG8_STAGE(PG8_SB(1, 1), b3 + hstep, voffB); PG8_STAGE(PG8_SA(1, 0), a3, voffA);
            PG8_WAIT_V(8); PG8_WAIT_L(0); PG8_BAR; PG8_MMA(1, 0, At, B0); PG8_MMA(1, 1, At, B1); PG8_BAR; PG8_SCHED;
            } else {
            PG8_LDB(B0, 0, 0); PG8_SCHED; PG8_LDA(At, 0, 0); PG8_STAGE(PG8_SA(1, 1), a1 + hstep, voffA);
            PG8_WAIT_L(8); PG8_BAR; PG8_WAIT_L(0); PG8_MMA(0, 0, At, B0); PG8_BAR; PG8_SCHED;
            PG8_LDB(B1, 0, 1); PG8_STAGE(PG8_SB(0, 0), b2, voffB);
            PG8_BAR; PG8_WAIT_L(0); PG8_MMA(0, 1, At, B1); PG8_BAR;
            PG8_LDA(At, 0, 1); PG8_STAGE(PG8_SA(0, 0), a2, voffA);
            PG8_BAR; PG8_WAIT_L(0); PG8_MMA(1, 0, At, B0); PG8_BAR; PG8_SCHED;
            PG8_STAGE(PG8_SB(0, 1), b2 + hstep, voffB);
            PG8_WAIT_V(6); PG8_BAR; PG8_MMA(1, 1, At, B1); PG8_BAR;
            PG8_LDB(B0, 1, 0); PG8_SCHED; PG8_LDA(At, 1, 0); PG8_STAGE(PG8_SA(0, 1), a2 + hstep, voffA);
            PG8_WAIT_L(8); PG8_BAR; PG8_WAIT_L(0); PG8_MMA(0, 0, At, B0); PG8_BAR; PG8_SCHED;
            PG8_LDB(B1, 1, 1); PG8_STAGE(PG8_SB(1, 0), b3, voffB);
            PG8_BAR; PG8_WAIT_L(0); PG8_MMA(0, 1, At, B1); PG8_BAR;
            PG8_LDA(At, 1, 1); PG8_STAGE(PG8_SA(1, 0), a3, voffA);
            PG8_BAR; PG8_WAIT_L(0); PG8_MMA(1, 0, At, B0); PG8_BAR; PG8_SCHED;
            PG8_STAGE(PG8_SB(1, 1), b3 + hstep, voffB);
            PG8_WAIT_V(6); PG8_BAR; PG8_MMA(1, 1, At, B1); PG8_BAR;
            }
        }
        if constexpr (ALIGN_EPI) { if (wr == 0) PG8_BAR; }
        if constexpr (!Epi::AFTER_DRAIN) { E(acc, cur, wr, wc, fr, fq); S.done(cur); }
        if (!has_next) break;
#pragma unroll
        for (int a = 0; a < 2; ++a)
#pragma unroll
            for (int b = 0; b < 2; ++b)
#pragma unroll
                for (int m = 0; m < 4; ++m)
#pragma unroll
                    for (int n = 0; n < 2; ++n) acc[a][b][m][n] = (f32x4){0.f, 0.f, 0.f, 0.f};
        cur = nxt; cA = nA; cB = nB; ++ui;
        if constexpr (ALIGN_EPI) { if (wr == 1) PG8_BAR; }
    }
    PG8_WAIT_V(0);
    if constexpr (!ALIGN_EPI) { if (wr == 0) PG8_BAR; }
    PG8_BAR;
    if constexpr (Epi::AFTER_DRAIN) { E.fused(acc, cur, wr, wc, fr, fq, lds, wid, lane); S.done(cur); }
#undef PG8_SA
#undef PG8_SB
#undef PG8_STAGE
#undef PG8_LDA
#undef PG8_LDB
#undef PG8_MMA
#undef PG8_WAIT_V
#undef PG8_WAIT_L
#undef PG8_BAR
#undef PG8_SCHED
}
}
#ifndef PROBE_SUB
#define PROBE_SUB 0
#endif
#ifndef PROBE_DUP
#define PROBE_DUP 0
#endif
#ifndef PROBE_DUPK
#define PROBE_DUPK -1
#endif
#ifndef PROBE_PRO
#define PROBE_PRO 0
#endif
#define LAS __attribute__((address_space(3)))
typedef unsigned short bf16;
typedef float f32x4 __attribute__((ext_vector_type(4)));
typedef unsigned u32x4 __attribute__((ext_vector_type(4)));
typedef unsigned u32x2 __attribute__((ext_vector_type(2)));

constexpr int BATCH = 4, SEQ = 2048, DM = 2048, M = BATCH * SEQ, DEPTH = 2;
constexpr int NIN = 15664, NP = 15872, DFF = 8192;
constexpr int OFF_BQ = 4608, OFF_BKV = 5632, OFF_BG = 6400, OFF_CQ = 6448, OFF_CK = 7472, OFF_CV = 8496, OFF_MG = 9520;
constexpr int BT = 2112;
constexpr int NCMP = 127;
constexpr size_t MiB = 1u << 20;
constexpr size_t WS_WT = 0, LAYER_W = 144 * MiB;
constexpr size_t WO_IN = 0, WO_A = 62 * MiB, WO_B = 64 * MiB, WO_C = 68 * MiB, WO_OUT = 72 * MiB, WO_UP = 80 * MiB, WO_DOWN = 112 * MiB;
constexpr size_t WS_H = 288 * MiB, WS_PROJ = 320 * MiB, WS_U = WS_PROJ;
constexpr size_t WS_OA = 568 * MiB, WS_OB = 576 * MiB, WS_OC = 592 * MiB, WS_OCMP = 608 * MiB;
constexpr size_t WS_MIXF = 640 * MiB, WS_MIXB = 704 * MiB, WS_Y = 736 * MiB;
constexpr size_t WS_KC = 800 * MiB, WS_VC = 801 * MiB, WS_SELM = 802 * MiB, WS_BIAST = 803 * MiB, WS_CW = 804 * MiB, WS_BAR = 812 * MiB, WS_END = 813 * MiB;
constexpr int LDS_BYTES = 147456;
constexpr int PH_PER_LAYER = 9;
constexpr int NPH = 1 + DEPTH * PH_PER_LAYER;

struct Args { const float* in[21]; float* out; unsigned char* ws; int ph_lo, ph_hi; };
constexpr int PTAB_OFF = 131072 + 1024;
struct PT { const unsigned long long* t;
    __device__ __forceinline__ unsigned long long get(int i) const { const unsigned long long v = t[i]; const unsigned lo = __builtin_amdgcn_readfirstlane((unsigned)v), hi = __builtin_amdgcn_readfirstlane((unsigned)(v >> 32)); return ((unsigned long long)hi << 32) | lo; }
    __device__ __forceinline__ const float* in(int i) const { return (const float*)(const __attribute__((address_space(1))) float*)get(i); }
    __device__ __forceinline__ float* out() const { return (float*)(__attribute__((address_space(1))) float*)get(21); }
    __device__ __forceinline__ unsigned char* ws() const { return (unsigned char*)(__attribute__((address_space(1))) unsigned char*)get(22); } };

#define LDS_FENCE() asm volatile("s_waitcnt vmcnt(0) lgkmcnt(0)" ::: "memory")

__device__ __forceinline__ unsigned f2bf(float f) { unsigned u = __builtin_bit_cast(unsigned, f); return (u + 0x7fffu + ((u >> 16) & 1u)) >> 16; }
__device__ __forceinline__ unsigned pk2(float lo, float hi) { return f2bf(lo) | (f2bf(hi) << 16); }
typedef __bf16 bf16v2_t __attribute__((ext_vector_type(2)));
typedef float f32v2_t __attribute__((ext_vector_type(2)));
__device__ __forceinline__ unsigned pkh(float lo, float hi) { f32v2_t v; v.x = lo; v.y = hi; return __builtin_bit_cast(unsigned, __builtin_convertvector(v, bf16v2_t)); }
__device__ __forceinline__ float bf_lo(unsigned w) { return __uint_as_float(w << 16); }
__device__ __forceinline__ float bf_hi(unsigned w) { return __uint_as_float(w & 0xffff0000u); }
__device__ __forceinline__ float bf2f(bf16 h) { return __uint_as_float(((unsigned)h) << 16); }
__device__ __forceinline__ float wave_sum(float v) {
#pragma unroll
    for (int o = 32; o >= 1; o >>= 1) v += __shfl_xor(v, o);
    return v;
}
__device__ __forceinline__ float wave_max(float v) {
#pragma unroll
    for (int o = 32; o >= 1; o >>= 1) v = fmaxf(v, __shfl_xor(v, o));
    return v;
}
__device__ __forceinline__ float sigmoidf_(float x) { return 1.0f / (1.0f + __expf(-x)); }

__device__ __forceinline__ void load64(const bf16* p, float (&q)[64]) {
    const u32x4* p4 = (const u32x4*)p;
#pragma unroll
    for (int i = 0; i < 8; ++i) { const u32x4 w = p4[i];
        q[8 * i + 0] = bf_lo(w.x); q[8 * i + 1] = bf_hi(w.x); q[8 * i + 2] = bf_lo(w.y); q[8 * i + 3] = bf_hi(w.y);
        q[8 * i + 4] = bf_lo(w.z); q[8 * i + 5] = bf_hi(w.z); q[8 * i + 6] = bf_lo(w.w); q[8 * i + 7] = bf_hi(w.w); }
}
__device__ __forceinline__ float dot64(const float (&q)[64], const bf16* k) {
    const u32x4* k4 = (const u32x4*)k; float a0 = 0.f, a1 = 0.f;
#pragma unroll
    for (int i = 0; i < 8; ++i) { const u32x4 w = k4[i];
        a0 += q[8 * i + 0] * bf_lo(w.x); a1 += q[8 * i + 1] * bf_hi(w.x); a0 += q[8 * i + 2] * bf_lo(w.y); a1 += q[8 * i + 3] * bf_hi(w.y);
        a0 += q[8 * i + 4] * bf_lo(w.z); a1 += q[8 * i + 5] * bf_hi(w.z); a0 += q[8 * i + 6] * bf_lo(w.w); a1 += q[8 * i + 7] * bf_hi(w.w); }
    return a0 + a1;
}
__device__ __forceinline__ float wave_softmax(float* S, int n, int lane, float& mout) {
    float m = -3.0e38f;
    for (int i = lane; i < n; i += 64) m = fmaxf(m, S[i]);
    m = wave_max(m);
    float s = 0.f;
    for (int i = lane; i < n; i += 64) { const float e = __expf(S[i] - m); S[i] = e; s += e; }
    s = wave_sum(s); mout = m; return s;
}

struct TItem { const float* W; bf16* WT; int K, N, item, pitch; };
struct TRegs { f32x4 v0[8], v1[8]; };
__device__ __forceinline__ void titem_load(const TItem& t, TRegs& R, int lane) {
    const int nblk = (t.N + 63) / 64, kb = t.item / nblk, nb = t.item % nblk, k0 = 64 * kb, n0 = 64 * nb;
    const int rg = lane >> 4, c4 = lane & 15, nn = n0 + 4 * c4; const bool ok = nn < t.N;
#pragma unroll
    for (int i = 0; i < 8; ++i) { const float* p = t.W + (size_t)(k0 + 8 * i + 2 * rg) * t.N + nn;
        R.v0[i] = ok ? *(const f32x4*)p : (f32x4){0.f, 0.f, 0.f, 0.f}; R.v1[i] = ok ? *(const f32x4*)(p + t.N) : (f32x4){0.f, 0.f, 0.f, 0.f}; }
}
__device__ __forceinline__ void titem_store(const TItem& t, const TRegs& R, float* scrf, int lane) {
    unsigned* scr = (unsigned*)scrf;
    const int nblk = (t.N + 63) / 64, kb = t.item / nblk, nb = t.item % nblk, k0 = 64 * kb, n0 = 64 * nb;
    const int rg = lane >> 4, c4 = lane & 15;
#pragma unroll
    for (int i = 0; i < 8; ++i) { unsigned* q = scr + (4 * i + rg) * 66 + 4 * c4;
        q[0] = pkh(R.v0[i].x, R.v1[i].x); q[1] = pkh(R.v0[i].y, R.v1[i].y); q[2] = pkh(R.v0[i].z, R.v1[i].z); q[3] = pkh(R.v0[i].w, R.v1[i].w); }
    LDS_FENCE();
    const int c = lane & 7;
#pragma unroll
    for (int j = 0; j < 8; ++j) { const int n = (lane >> 3) + 8 * j; const unsigned* s = scr + (4 * c) * 66 + n;
        u32x4 o; o.x = s[0]; o.y = s[66]; o.z = s[132]; o.w = s[198];
        *(u32x4*)(t.WT + (size_t)(n0 + n) * t.pitch + k0 + 8 * c) = o; }
    LDS_FENCE();
}
__device__ __forceinline__ int t5_bucket(int d) {
    if (d < 16) return d;
    const float logd = logf((float)d / 16.0f);
    int far = 16 + (int)(logd / 4.852030263919617f * 16.0f);
    return far < 31 ? far : 31;
}
__device__ __forceinline__ void rms_row_to_bf16(const float* xrow, const float* gain, bf16* orow, int lane) {
    const f32x4* xr = (const f32x4*)xrow + lane; const f32x4* gr = (const f32x4*)gain + lane;
    f32x4 v[8]; float s = 0.f;
#pragma unroll
    for (int j = 0; j < 8; ++j) { v[j] = xr[64 * j]; s += (v[j].x * v[j].x + v[j].y * v[j].y) + (v[j].z * v[j].z + v[j].w * v[j].w); }
    const float r = 1.0f / sqrtf(wave_sum(s) * (1.0f / DM) + 1e-6f);
    u32x2* o8 = (u32x2*)orow + lane;
#pragma unroll
    for (int j = 0; j < 8; ++j) { const f32x4 g = gr[64 * j]; u32x2 w; w.x = pk2(v[j].x * r * g.x, v[j].y * r * g.y); w.y = pk2(v[j].z * r * g.z, v[j].w * r * g.w); o8[64 * j] = w; }
}
__device__ __forceinline__ void rowpass_row(const float* xi, const bf16* y, const float* gp, const float* gn, float* xo, bf16* h, int lane) {
    const u32x2* yr = (const u32x2*)y + lane; const f32x4* xr = (const f32x4*)xi + lane; const f32x4* gpr = (const f32x4*)gp + lane;
    f32x4 v[8]; float s = 0.f;
#pragma unroll
    for (int j = 0; j < 8; ++j) { const u32x2 w = yr[64 * j]; v[j].x = bf_lo(w.x); v[j].y = bf_hi(w.x); v[j].z = bf_lo(w.y); v[j].w = bf_hi(w.y); s += (v[j].x * v[j].x + v[j].y * v[j].y) + (v[j].z * v[j].z + v[j].w * v[j].w); }
    const float r = 1.0f / sqrtf(wave_sum(s) * (1.0f / DM) + 1e-6f);
    float s2 = 0.f;
#pragma unroll
    for (int j = 0; j < 8; ++j) { const f32x4 g = gpr[64 * j]; const f32x4 x = xr[64 * j]; v[j] = x + v[j] * r * g; s2 += (v[j].x * v[j].x + v[j].y * v[j].y) + (v[j].z * v[j].z + v[j].w * v[j].w); }
    f32x4* xw = (f32x4*)xo + lane;
#pragma unroll
    for (int j = 0; j < 8; ++j) xw[64 * j] = v[j];
    if (gn) {
        const float r2 = 1.0f / sqrtf(wave_sum(s2) * (1.0f / DM) + 1e-6f);
        const f32x4* gnr = (const f32x4*)gn + lane; u32x2* o8 = (u32x2*)h + lane;
#pragma unroll
        for (int j = 0; j < 8; ++j) { const f32x4 g = gnr[64 * j]; u32x2 w; w.x = pk2(v[j].x * r2 * g.x, v[j].y * r2 * g.y); w.y = pk2(v[j].z * r2 * g.z, v[j].w * r2 * g.w); o8[64 * j] = w; }
    }
}

constexpr int IT_IN = 32 * 245, IT_A = 8 * 32, IT_B = 16 * 32, IT_C = 16 * 32, IT_OUT = 32 * 32, IT_UP = 32 * 128, IT_DOWN = 128 * 32;
constexpr int IT_W1 = 32 * 4, IT_W2 = 4 * 1;
constexpr int IT_LAYER = IT_IN + IT_A + IT_B + IT_C + IT_OUT + IT_UP + IT_DOWN + 2 * IT_W1 + 2 * IT_W2;

__device__ __forceinline__ TItem decode_item(const PT a, unsigned char* ws, int it) {
    const int l = it / IT_LAYER; int r = it % IT_LAYER;
    unsigned char* wl = ws + WS_WT + (size_t)l * LAYER_W; unsigned char* cw = ws + WS_CW + (size_t)l * 4 * MiB;
    TItem t;
    if (r < IT_IN) { t.W = a.in(2) + (size_t)l * DM * NIN; t.K = DM; t.N = NIN; t.WT = (bf16*)(wl + WO_IN); t.item = r; t.pitch = t.K; return t; } r -= IT_IN;
    if (r < IT_A) { t.W = a.in(11) + (size_t)l * 512 * DM; t.K = 512; t.N = DM; t.WT = (bf16*)(wl + WO_A); t.item = r; t.pitch = 2560; return t; } r -= IT_A;
    if (r < IT_B) { t.W = a.in(12) + (size_t)l * 1024 * DM; t.K = 1024; t.N = DM; t.WT = (bf16*)(wl + WO_A) + 512; t.item = r; t.pitch = 2560; return t; } r -= IT_B;
    if (r < IT_C) { t.W = a.in(13) + (size_t)l * 1024 * DM; t.K = 1024; t.N = DM; t.WT = (bf16*)(wl + WO_A) + 1536; t.item = r; t.pitch = 2560; return t; } r -= IT_C;
    if (r < IT_OUT) { t.W = a.in(14) + (size_t)l * DM * DM; t.K = DM; t.N = DM; t.WT = (bf16*)(wl + WO_OUT); t.item = r; t.pitch = t.K; return t; } r -= IT_OUT;
    if (r < IT_UP) { t.W = a.in(19) + (size_t)l * DM * DFF; t.K = DM; t.N = DFF; t.WT = (bf16*)(wl + WO_UP); t.item = r; t.pitch = t.K; return t; } r -= IT_UP;
    if (r < IT_DOWN) { t.W = a.in(20) + (size_t)l * DFF * DM; t.K = DFF; t.N = DM; t.WT = (bf16*)(wl + WO_DOWN); t.item = r; t.pitch = t.K; return t; } r -= IT_DOWN;
    if (r < IT_W1) { t.W = a.in(5) + (size_t)l * 2048 * 256; t.K = 2048; t.N = 256; t.WT = (bf16*)cw; t.item = r; t.pitch = t.K; return t; } r -= IT_W1;
    if (r < IT_W1) { t.W = a.in(7) + (size_t)l * 2048 * 256; t.K = 2048; t.N = 256; t.WT = (bf16*)(cw + MiB); t.item = r; t.pitch = t.K; return t; } r -= IT_W1;
    if (r < IT_W2) { t.W = a.in(6) + (size_t)l * 256 * 64; t.K = 256; t.N = 64; t.WT = (bf16*)(cw + 2 * MiB); t.item = r; t.pitch = t.K; return t; } r -= IT_W2;
    t.W = a.in(8) + (size_t)l * 256 * 64; t.K = 256; t.N = 64; t.WT = (bf16*)(cw + 2 * MiB + 65536); t.item = r; t.pitch = t.K; return t;
}
__device__ __forceinline__ void phase_prologue(const PT a, float* ldsf, int lane, int wave, int gw, int ngw) {
    float* scr = ldsf + wave * 4096;
    unsigned char* ws = a.ws();
    constexpr int NIT = DEPTH * IT_LAYER;
    if (gw < NIT) {
        int it = gw; TItem cur = decode_item(a, ws, it); TRegs R; titem_load(cur, R, lane);
        for (;;) {
            const int nx = it + ngw; const bool more = nx < NIT;
            TItem nxt = cur; TRegs R2 = R;
            if (more) { nxt = decode_item(a, ws, nx); titem_load(nxt, R2, lane); }
            titem_store(cur, R, scr, lane);
            if (!more) break;
            cur = nxt; R = R2; it = nx;
        }
    }
    float* biasT = (float*)(ws + WS_BIAST);
    for (int i = gw * 64 + lane; i < 48 * BT; i += ngw * 64) { const int col = i / BT, d = i % BT; biasT[i] = a.in(1)[t5_bucket(d) * 48 + col]; }
    for (int m = gw; m < M; m += ngw) rms_row_to_bf16(a.in(0) + (size_t)m * DM, a.in(15), (bf16*)(ws + WS_H) + (size_t)m * DM, lane);
}

struct EpiAny { static constexpr bool PERM = true, AFTER_DRAIN = false, KHOOK = true;
    int mode; bf16* ob; float* of; const bf16* proj;
    __device__ __forceinline__ bool khook_at(int t) const { return mode == 6 && (t == 8 || t == 24); }
    __device__ __forceinline__ void khook(pg8::f32x4 (&acc)[2][2][4][2], const pg8::Unit& u, int t, int wr, int wc, int fr, int fq) const {
        const int step = (t == 8) ? 0 : 1;
        { int tl = (int)threadIdx.x; asm volatile("" : "+v"(tl)); fr = tl & 15; fq = (tl >> 4) & 3; }
#pragma unroll
        for (int ai = 0; ai < 2; ++ai) {
                u32x2 zc[16], zn[16];
#pragma unroll
                for (int q = 0; q < 16; ++q) { const int m = q >> 2, bj = (q >> 1) & 1, n = q & 1;
                    const int row = u.pm * 256 + ai * 128 + wr * 64 + m * 16 + fr, col = u.pn * 256 + bj * 128 + wc * 32 + 8 * fq + 4 * n;
                    const bf16* gp = proj + (size_t)row * NP + OFF_MG + step * DM + col; zc[q] = *(const u32x2*)gp; zn[q] = *(const u32x2*)(gp + DM); }
#pragma unroll
                for (int q = 0; q < 16; ++q) { const int m = q >> 2, bj = (q >> 1) & 1, n = q & 1;
                    pg8::f32x4 t0 = acc[ai][bj][m][n];
                    t0[0] *= (1.f + __expf(-bf_lo(zn[q].x))) * __builtin_amdgcn_rcpf(1.f + __expf(-bf_lo(zc[q].x))); t0[1] *= (1.f + __expf(-bf_hi(zn[q].x))) * __builtin_amdgcn_rcpf(1.f + __expf(-bf_hi(zc[q].x)));
                    t0[2] *= (1.f + __expf(-bf_lo(zn[q].y))) * __builtin_amdgcn_rcpf(1.f + __expf(-bf_lo(zc[q].y))); t0[3] *= (1.f + __expf(-bf_hi(zn[q].y))) * __builtin_amdgcn_rcpf(1.f + __expf(-bf_hi(zc[q].y)));
                    acc[ai][bj][m][n] = t0; }
                asm volatile("" ::: "memory"); }
    }
    template <int MODE> __device__ __forceinline__ void run(const pg8::f32x4 (&acc)[2][2][4][2], const pg8::Unit& u, int wr, int wc, int fr, int fq) const {
        constexpr int LDC = (MODE == 0) ? NP : (MODE == 5 ? DFF : DM);
        { int tl = (int)threadIdx.x; asm volatile("" : "+v"(tl)); fr = tl & 15; fq = (tl >> 4) & 3; }
#pragma unroll
        for (int ai = 0; ai < 2; ++ai)
#pragma unroll
            for (int mp = 0; mp < 2; ++mp) {
                u32x4 gpre[4];
                if constexpr (MODE == 6) {
#pragma unroll
                    for (int q = 0; q < 4; ++q) { const int m = 2 * mp + (q >> 1), bj = q & 1; const int row = u.pm * 256 + ai * 128 + wr * 64 + m * 16 + fr, col = u.pn * 256 + bj * 128 + wc * 32 + 8 * fq;
                        gpre[q] = *(const u32x4*)(proj + (size_t)row * NP + OFF_MG + 2 * DM + col); }
                }
#pragma unroll
                for (int q = 0; q < 4; ++q) { const int m = 2 * mp + (q >> 1), bj = q & 1; const int row = u.pm * 256 + ai * 128 + wr * 64 + m * 16 + fr, col = u.pn * 256 + bj * 128 + wc * 32 + 8 * fq;
                    const pg8::f32x4 t0 = acc[ai][bj][m][0], t1 = acc[ai][bj][m][1];
                    float v[8] = {t0[0], t0[1], t0[2], t0[3], t1[0], t1[1], t1[2], t1[3]};
                    if constexpr (MODE == 5) {
#pragma unroll
                        for (int e = 0; e < 8; ++e) { const float r = fmaxf(v[e], 0.f); v[e] = r * r; }
                    }
                    if constexpr (MODE == 6) { const u32x4 g = gpre[q];
                        v[0] *= sigmoidf_(bf_lo(g.x)); v[1] *= sigmoidf_(bf_hi(g.x)); v[2] *= sigmoidf_(bf_lo(g.y)); v[3] *= sigmoidf_(bf_hi(g.y));
                        v[4] *= sigmoidf_(bf_lo(g.z)); v[5] *= sigmoidf_(bf_hi(g.z)); v[6] *= sigmoidf_(bf_lo(g.w)); v[7] *= sigmoidf_(bf_hi(g.w)); }
                    u32x4 w; w.x = pkh(v[0], v[1]); w.y = pkh(v[2], v[3]); w.z = pkh(v[4], v[5]); w.w = pkh(v[6], v[7]);
                    *(u32x4*)(ob + (size_t)row * LDC + col) = w; }
                asm volatile("" ::: "memory"); }
    }
    __device__ __forceinline__ void operator()(const pg8::f32x4 (&acc)[2][2][4][2], const pg8::Unit& u, int wr, int wc, int fr, int fq) const {
        if (mode == 0) run<0>(acc, u, wr, wc, fr, fq);
        else if (mode == 4) run<4>(acc, u, wr, wc, fr, fq);
        else if (mode == 5) run<5>(acc, u, wr, wc, fr, fq);
        else run<6>(acc, u, wr, wc, fr, fq);
    } };


constexpr int KCAT = 2560;
typedef short bf16x8 __attribute__((ext_vector_type(8)));
typedef short bf16x4 __attribute__((ext_vector_type(4)));
typedef float f32x16 __attribute__((ext_vector_type(16)));
#define MFMA32(a, b, c) __builtin_amdgcn_mfma_f32_32x32x16_bf16(a, b, c, 0, 0, 0)

template <int KW, int NDS> struct KVRegs { u32x4 k[KW / 64]; u32x4 v[NDS / 2]; };

template <int KW, int NDS> __device__ __forceinline__ void load_tile(KVRegs<KW, NDS>& R, const bf16* base_b, int tok0, int tstride, int kcol, int vcol, int tid) {
#pragma unroll
    for (int r = 0; r < KW / 64; ++r) { const int idx = tid + 512 * r, key = idx / (KW / 8), ch = idx % (KW / 8);
        R.k[r] = *(const u32x4*)(base_b + (size_t)(tok0 + key * tstride) * NP + kcol + ch * 8); }
#pragma unroll
    for (int r = 0; r < NDS / 2; ++r) { const int idx = tid + 512 * r, key = idx & 63, ch = idx >> 6;
        R.v[r] = *(const u32x4*)(base_b + (size_t)(tok0 + key * tstride) * NP + vcol + ch * 8); }
}
template <int KW, int NDS> __device__ __forceinline__ void store_tile(const KVRegs<KW, NDS>& R, bf16* Ks, bf16* Vt, int tid) {
#pragma unroll
    for (int r = 0; r < KW / 64; ++r) { const int idx = tid + 512 * r, key = idx / (KW / 8), ch = idx % (KW / 8);
        *(u32x4*)(Ks + key * (KW + 8) + ch * 8) = R.k[r]; }
#pragma unroll
    for (int r = 0; r < NDS / 2; ++r) { const int idx = tid + 512 * r, key = idx & 63, ch = idx >> 6; const u32x4 w = R.v[r]; bf16* p = Vt + (ch * 8) * 68 + key;
        p[0 * 68] = (bf16)(w.x & 0xffffu); p[1 * 68] = (bf16)(w.x >> 16); p[2 * 68] = (bf16)(w.y & 0xffffu); p[3 * 68] = (bf16)(w.y >> 16);
        p[4 * 68] = (bf16)(w.z & 0xffffu); p[5 * 68] = (bf16)(w.z >> 16); p[6 * 68] = (bf16)(w.w & 0xffffu); p[7 * 68] = (bf16)(w.w >> 16); }
}
constexpr float LOG2E = 1.4426950408889634f;
constexpr float QSCALE2 = 0.125f * LOG2E;
__device__ __forceinline__ void load_qfrag(const bf16* qrow, int hi, bf16x8 (&qf)[4], float sc) {
#pragma unroll
    for (int c = 0; c < 4; ++c) { const u32x4 w = *(const u32x4*)(qrow + c * 16 + hi * 8); u32x4 o;
        o.x = pkh(bf_lo(w.x) * sc, bf_hi(w.x) * sc); o.y = pkh(bf_lo(w.y) * sc, bf_hi(w.y) * sc);
        o.z = pkh(bf_lo(w.z) * sc, bf_hi(w.z) * sc); o.w = pkh(bf_lo(w.w) * sc, bf_hi(w.w) * sc);
        qf[c] = __builtin_bit_cast(bf16x8, o); }
}
template <int KP, int NDS> __device__ __forceinline__ void attn_tile(const bf16x8 (&qf)[4], const bf16* Ks, const bf16* Vt, float& m, float& l, f32x16 (&O)[NDS],
                                                                       const float* tab, int dq, int maxd, bool tile_ok, int pmode, float cb, int l32, int hi) {
    f32x16 s0, s1;
#pragma unroll
    for (int i = 0; i < 16; ++i) { s0[i] = 0.f; s1[i] = 0.f; }
#pragma unroll
    for (int c = 0; c < 4; ++c) { const bf16x8 a0 = *(const bf16x8*)(Ks + l32 * KP + c * 16 + hi * 8); const bf16x8 a1 = *(const bf16x8*)(Ks + (32 + l32) * KP + c * 16 + hi * 8);
        s0 = MFMA32(a0, qf[c], s0); s1 = MFMA32(a1, qf[c], s1); }
    float mx = -1e30f, sub;
    if (pmode == 2) {
#pragma unroll
        for (int i = 0; i < 16; ++i) mx = fmaxf(mx, fmaxf(s0[i], s1[i]));
        mx = fmaxf(mx, __shfl_xor(mx, 32)) + cb;
    } else if (pmode == 1) {
        const float* tp = tab + (dq - 4 * hi);
#pragma unroll
        for (int h4 = 0; h4 < 4; ++h4) { float bb[4];
#pragma unroll
            for (int j = 0; j < 4; ++j) bb[j] = tp[-(h4 * 8 + j)];
#pragma unroll
            for (int j = 0; j < 4; ++j) { const int i = 4 * h4 + j; s0[i] = tile_ok ? s0[i] + bb[j] : -INFINITY; mx = fmaxf(mx, s0[i]); } }
#pragma unroll
        for (int h4 = 0; h4 < 4; ++h4) { float bb[4];
#pragma unroll
            for (int j = 0; j < 4; ++j) bb[j] = tp[-(32 + h4 * 8 + j)];
#pragma unroll
            for (int j = 0; j < 4; ++j) { const int i = 4 * h4 + j; s1[i] = tile_ok ? s1[i] + bb[j] : -INFINITY; mx = fmaxf(mx, s1[i]); } }
        mx = fmaxf(mx, __shfl_xor(mx, 32));
    } else {
        const int dq4 = dq - 4 * hi, cl = maxd < 2047 ? maxd : 2047;
#pragma unroll
        for (int h4 = 0; h4 < 4; ++h4) { float bb[4];
#pragma unroll
            for (int j = 0; j < 4; ++j) { const int d0 = dq4 - (h4 * 8 + j); bb[j] = tab[d0 < 0 ? 0 : (d0 > cl ? cl : d0)]; }
#pragma unroll
            for (int j = 0; j < 4; ++j) { const int i = 4 * h4 + j; const int d0 = dq4 - (h4 * 8 + j); const bool v0 = tile_ok && (unsigned)d0 <= (unsigned)maxd;
                s0[i] = v0 ? s0[i] + bb[j] : -INFINITY; mx = fmaxf(mx, s0[i]); } }
#pragma unroll
        for (int h4 = 0; h4 < 4; ++h4) { float bb[4];
#pragma unroll
            for (int j = 0; j < 4; ++j) { const int d1 = dq4 - 32 - (h4 * 8 + j); bb[j] = tab[d1 < 0 ? 0 : (d1 > cl ? cl : d1)]; }
#pragma unroll
            for (int j = 0; j < 4; ++j) { const int i = 4 * h4 + j; const int d1 = dq4 - 32 - (h4 * 8 + j); const bool v1 = tile_ok && (unsigned)d1 <= (unsigned)maxd;
                s1[i] = v1 ? s1[i] + bb[j] : -INFINITY; mx = fmaxf(mx, s1[i]); } }
        mx = fmaxf(mx, __shfl_xor(mx, 32));
    }
    const float mn = fmaxf(m, mx), alpha = __builtin_amdgcn_exp2f(m - mn);
    const bool resc = __any(mn != m);
    m = mn; sub = (pmode == 2) ? mn - cb : mn;
    s0 = s0 - sub; s1 = s1 - sub;
#pragma unroll
    for (int i = 0; i < 16; ++i) { s0[i] = __builtin_amdgcn_exp2f(s0[i]); s1[i] = __builtin_amdgcn_exp2f(s1[i]); }
    const f32x16 ss = s0 + s1;
    const float rs = ((ss[0] + ss[1]) + (ss[2] + ss[3])) + ((ss[4] + ss[5]) + (ss[6] + ss[7])) + (((ss[8] + ss[9]) + (ss[10] + ss[11])) + ((ss[12] + ss[13]) + (ss[14] + ss[15])));
    l = l * alpha + rs;
    if (resc) {
#pragma unroll
        for (int ds = 0; ds < NDS; ++ds)
#pragma unroll
            for (int i = 0; i < 16; ++i) O[ds][i] *= alpha;
    }
#pragma unroll
    for (int c = 0; c < 4; ++c) {
        u32x4 pw;
        if (c == 0) { pw.x = pkh(s0[0], s0[1]); pw.y = pkh(s0[2], s0[3]); pw.z = pkh(s0[4], s0[5]); pw.w = pkh(s0[6], s0[7]); }
        else if (c == 1) { pw.x = pkh(s0[8], s0[9]); pw.y = pkh(s0[10], s0[11]); pw.z = pkh(s0[12], s0[13]); pw.w = pkh(s0[14], s0[15]); }
        else if (c == 2) { pw.x = pkh(s1[0], s1[1]); pw.y = pkh(s1[2], s1[3]); pw.z = pkh(s1[4], s1[5]); pw.w = pkh(s1[6], s1[7]); }
        else { pw.x = pkh(s1[8], s1[9]); pw.y = pkh(s1[10], s1[11]); pw.z = pkh(s1[12], s1[13]); pw.w = pkh(s1[14], s1[15]); }
        const bf16x8 pb = __builtin_bit_cast(bf16x8, pw);
#pragma unroll
        for (int ds = 0; ds < NDS; ++ds) { const bf16* vp = Vt + (ds * 32 + l32) * 68 + 16 * c + 4 * hi;
            const u32x2 lo = *(const u32x2*)vp, hi2 = *(const u32x2*)(vp + 8); u32x4 vw; vw.x = lo.x; vw.y = lo.y; vw.z = hi2.x; vw.w = hi2.y;
            O[ds] = MFMA32(__builtin_bit_cast(bf16x8, vw), pb, O[ds]); }
    }
}
template <int KW, int NDS, int SLOT, bool TWO> __device__ __forceinline__ void attn_pass(unsigned tmask, const bf16* base_b, int tok_base, int tstride, int kcol, int vcol, bf16* Ks, bf16* Vt, int kofs,
        const bf16x8 (&qf)[4], float& m, float& l, f32x16 (&O)[NDS], const float* tab, const unsigned char* bk, int iq, int maxd, unsigned okbits, int wave_maxq, int wave_lo, int tid, int l32, int hi) {
    if (!tmask) return;
    KVRegs<KW, NDS> Ra, Rb; int ja = __builtin_ctz(tmask), jb = -1; tmask &= tmask - 1;
    if (TWO && tmask) { jb = __builtin_ctz(tmask); tmask &= tmask - 1; }
    load_tile<KW, NDS>(Ra, base_b, tok_base + ja * 64 * tstride, tstride, kcol, vcol, tid);
    if (TWO && jb >= 0) load_tile<KW, NDS>(Rb, base_b, tok_base + jb * 64 * tstride, tstride, kcol, vcol, tid);
    for (;;) {
        __syncthreads(); store_tile<KW, NDS>(Ra, Ks, Vt, tid); if (TWO && jb >= 0) store_tile<KW, NDS>(Rb, Ks + SLOT, Vt + SLOT, tid); __syncthreads();
        const int ca = ja, cb = jb; const bool more = tmask != 0u;
        if (more) { ja = __builtin_ctz(tmask); tmask &= tmask - 1; jb = -1; if (TWO && tmask) { jb = __builtin_ctz(tmask); tmask &= tmask - 1; }
            load_tile<KW, NDS>(Ra, base_b, tok_base + ja * 64 * tstride, tstride, kcol, vcol, tid);
            if (TWO && jb >= 0) load_tile<KW, NDS>(Rb, base_b, tok_base + jb * 64 * tstride, tstride, kcol, vcol, tid); }
#pragma unroll 1
        for (int s = 0; s < (TWO ? 2 : 1); ++s) { const int c = s ? cb : ca;
            if (c >= 0 && c * 64 <= wave_maxq && c * 64 + 63 >= wave_lo) {
                const bool tok = ((okbits >> c) & 1u) != 0u;
                int pmode = 0; float cbias = 0.f;
                if (bk) { const int dmin = wave_maxq - 31 - c * 64 - 63, dmax = wave_maxq - c * 64;
                    if (dmin >= 0 && dmax <= maxd && dmax <= 2047) { pmode = 1; if (__all(tok) && bk[dmin] == bk[dmax]) { pmode = 2; cbias = tab[dmin]; } } }
                attn_tile<KW + 8, NDS>(qf, Ks + s * SLOT + kofs, Vt + s * SLOT, m, l, O, tab, iq - c * 64, maxd, tok, pmode, cbias, l32, hi); } }
        if (!more) break;
    }
}
__device__ __forceinline__ unsigned range_mask(int lo, int hi_incl) { const unsigned up = (hi_incl >= 31) ? 0xffffffffu : ((1u << (hi_incl + 1)) - 1u); return up & ~((1u << lo) - 1u); }

__device__ __forceinline__ void cmp_unit(const PT a, unsigned char* ldsb, unsigned* selL, int b, int g, int qt, int tid, int lane, int wave) {
    unsigned char* ws = a.ws(); const bf16* proj = (const bf16*)(ws + WS_PROJ);
    const float* kc = (const float*)(ws + WS_KC); const float* vc = (const float*)(ws + WS_VC); float* ocmp = (float*)(ws + WS_OCMP);
    bf16* Khi = (bf16*)ldsb; bf16* Klo = (bf16*)(ldsb + 18432); bf16* Vt = (bf16*)(ldsb + 104448); float* SC = (float*)ldsb;
    const int l32 = lane & 31, hi = lane >> 5;
    __syncthreads();
    {
        const int hh = g * 8 + wave, t0 = qt * 32, tq = t0 + l32, tok = b * SEQ + tq;
        {
            const int n = tid >> 2, seg = tid & 3;
            const f32x4* kp = (const f32x4*)(kc + (size_t)((b * NCMP + (n < NCMP ? n : 0)) * 2 + g) * 64 + seg * 16);
            u32x4 h0, h1, l0, l1; f32x4 x[4];
#pragma unroll
            for (int e = 0; e < 4; ++e) { x[e] = kp[e]; if (n >= NCMP) x[e] = (f32x4){0.f, 0.f, 0.f, 0.f}; }
            unsigned hw[8], lw[8];
#pragma unroll
            for (int e = 0; e < 4; ++e) { const unsigned a0 = f2bf(x[e].x), a1 = f2bf(x[e].y), a2 = f2bf(x[e].z), a3 = f2bf(x[e].w);
                hw[2 * e] = a0 | (a1 << 16); hw[2 * e + 1] = a2 | (a3 << 16);
                lw[2 * e] = pk2(x[e].x - __uint_as_float(a0 << 16), x[e].y - __uint_as_float(a1 << 16)); lw[2 * e + 1] = pk2(x[e].z - __uint_as_float(a2 << 16), x[e].w - __uint_as_float(a3 << 16)); }
            h0.x = hw[0]; h0.y = hw[1]; h0.z = hw[2]; h0.w = hw[3]; h1.x = hw[4]; h1.y = hw[5]; h1.z = hw[6]; h1.w = hw[7];
            l0.x = lw[0]; l0.y = lw[1]; l0.z = lw[2]; l0.w = lw[3]; l1.x = lw[4]; l1.y = lw[5]; l1.z = lw[6]; l1.w = lw[7];
            *(u32x4*)(Khi + n * 72 + seg * 16) = h0; *(u32x4*)(Khi + n * 72 + seg * 16 + 8) = h1;
            *(u32x4*)(Klo + n * 72 + seg * 16) = l0; *(u32x4*)(Klo + n * 72 + seg * 16 + 8) = l1;
            const int nv_ = tid & 127, dseg = tid >> 7;
            const f32x4* vp = (const f32x4*)(vc + (size_t)((b * NCMP + (nv_ < NCMP ? nv_ : 0)) * 2 + g) * 64 + dseg * 16);
#pragma unroll
            for (int e = 0; e < 4; ++e) { f32x4 v = vp[e]; if (nv_ >= NCMP) v = (f32x4){0.f, 0.f, 0.f, 0.f}; bf16* p = Vt + (dseg * 16 + e * 4) * 136 + nv_;
                p[0] = (bf16)f2bf(v.x); p[136] = (bf16)f2bf(v.y); p[272] = (bf16)f2bf(v.z); p[408] = (bf16)f2bf(v.w); }
        }
        bf16x8 qf[4]; load_qfrag(proj + (size_t)tok * NP + OFF_BQ + hh * 64, hi, qf, 0.125f);
        __syncthreads();
        f32x16 s[4];
#pragma unroll
        for (int st = 0; st < 4; ++st) {
#pragma unroll
            for (int i = 0; i < 16; ++i) s[st][i] = 0.f;
#pragma unroll
            for (int c = 0; c < 4; ++c) { const bf16x8 ah = *(const bf16x8*)(Khi + (st * 32 + l32) * 72 + c * 16 + hi * 8); const bf16x8 al = *(const bf16x8*)(Klo + (st * 32 + l32) * 72 + c * 16 + hi * 8);
                s[st] = MFMA32(ah, qf[c], s[st]); s[st] = MFMA32(al, qf[c], s[st]); }
        }
        int nvq = tq >= 31 ? (tq - 31) / 16 + 1 : 0; nvq = nvq < NCMP ? nvq : NCMP;
        float mx = -1e30f;
#pragma unroll
        for (int st = 0; st < 4; ++st)
#pragma unroll
            for (int i = 0; i < 16; ++i) { const int n = 32 * st + (i >> 2) * 8 + 4 * hi + (i & 3); if (n < nvq) mx = fmaxf(mx, s[st][i]); }
        mx = fmaxf(mx, __shfl_xor(mx, 32));
        float rs = 0.f;
#pragma unroll
        for (int st = 0; st < 4; ++st)
#pragma unroll
            for (int i = 0; i < 16; ++i) { const int n = 32 * st + (i >> 2) * 8 + 4 * hi + (i & 3); const float e = (n < nvq) ? __expf(s[st][i] - mx) : 0.f; s[st][i] = e; rs += e; }
        rs += __shfl_xor(rs, 32);
        const float inv = nvq > 0 ? 1.0f / rs : 0.f;
#pragma unroll
        for (int st = 0; st < 4; ++st)
#pragma unroll
            for (int i = 0; i < 16; ++i) s[st][i] *= inv;
        f32x16 O[2];
#pragma unroll
        for (int ds = 0; ds < 2; ++ds)
#pragma unroll
            for (int i = 0; i < 16; ++i) O[ds][i] = 0.f;
#pragma unroll
        for (int st = 0; st < 4; ++st)
#pragma unroll
            for (int c2 = 0; c2 < 2; ++c2) { const int c = 2 * st + c2; u32x4 pw;
                pw.x = pk2(s[st][8 * c2 + 0], s[st][8 * c2 + 1]); pw.y = pk2(s[st][8 * c2 + 2], s[st][8 * c2 + 3]); pw.z = pk2(s[st][8 * c2 + 4], s[st][8 * c2 + 5]); pw.w = pk2(s[st][8 * c2 + 6], s[st][8 * c2 + 7]);
                const bf16x8 pb = __builtin_bit_cast(bf16x8, pw);
#pragma unroll
                for (int ds = 0; ds < 2; ++ds) { const bf16* vp = Vt + (ds * 32 + l32) * 136 + 16 * c + 4 * hi;
                    const u32x2 lo = *(const u32x2*)vp, hi2 = *(const u32x2*)(vp + 8); u32x4 vw; vw.x = lo.x; vw.y = lo.y; vw.z = hi2.x; vw.w = hi2.y;
                    O[ds] = MFMA32(__builtin_bit_cast(bf16x8, vw), pb, O[ds]); } }
#pragma unroll
        for (int ds = 0; ds < 2; ++ds)
#pragma unroll
            for (int i4 = 0; i4 < 4; ++i4) { f32x4 v; v.x = O[ds][i4 * 4 + 0]; v.y = O[ds][i4 * 4 + 1]; v.z = O[ds][i4 * 4 + 2]; v.w = O[ds][i4 * 4 + 3];
                *(f32x4*)(ocmp + (size_t)tok * 1024 + hh * 64 + ds * 32 + i4 * 8 + 4 * hi) = v; }
        __syncthreads();
        {
            float prev_other = 0.f;
#pragma unroll
            for (int st = 0; st < 4; ++st)
#pragma unroll
                for (int i4 = 0; i4 < 4; ++i4) {
                    const float gs = (s[st][4 * i4] + s[st][4 * i4 + 1]) + (s[st][4 * i4 + 2] + s[st][4 * i4 + 3]);
                    const float other = __shfl_xor(s[st][4 * i4 + 3], 32);
                    const float c = gs + (hi ? other : prev_other);
                    prev_other = other;
                    SC[(wave * 32 + l32) * 33 + 8 * st + 2 * i4 + hi] = c;
                }
        }
        __syncthreads();
#pragma unroll 1
        for (int ps = 0; ps < 2; ++ps) {
            const int q = 4 * wave + 2 * ps + hi, j = l32, t = t0 + q, cur = t >> 6;
            float sc = 0.f;
#pragma unroll
            for (int w = 0; w < 8; ++w) sc += SC[(w * 32 + q) * 33 + j];
            if (j == 0 || cur - j == 0 || cur - j == 1) sc = 1e6f;
            if (j > cur) sc = -1e30f;
            int rank = 0;
#pragma unroll 1
            for (int i = 0; i < 32; ++i) { const float si = __shfl(sc, (lane & 32) + i); rank += (si > sc || (si == sc && i < j)) ? 1 : 0; }
            const bool sel = (rank < 16) && (j <= cur);
            const unsigned long long bal = __ballot(sel);
            if (l32 == 0) selL[q] = hi ? (unsigned)(bal >> 32) : (unsigned)bal;
        }
        __syncthreads();
    }
}


__device__ __forceinline__ void phase_nsa_mfma(const PT a, unsigned char* ldsb, int tid, int lane, int wave, int bid, int nblk) {
    unsigned char* ws = a.ws(); const bf16* proj = (const bf16*)(ws + WS_PROJ); const float* biasT = (const float*)(ws + WS_BIAST);
    const float* ocmp = (const float*)(ws + WS_OCMP); bf16* ob = (bf16*)(ws + WS_OA);
    bf16* Ks = (bf16*)ldsb; bf16* Vt = (bf16*)(ldsb + 9216); float* tabs = (float*)(ldsb + 36864); unsigned char* bk = ldsb + 102400; unsigned* selL = (unsigned*)(ldsb + 121856);
    int gcur = -1;
    __syncthreads();
    for (int u = bid; u < 512; u += nblk) {
        const int bg = u & 7, b = bg >> 1, g = bg & 1, qt = u < 256 ? 63 - (u >> 3) : ((u - 256) >> 3);
        if (g != gcur) { __syncthreads();
            for (int i = tid; i < 8 * 2048; i += 512) tabs[i] = biasT[(24 + g * 8 + (i >> 11)) * BT + (i & 2047)] * LOG2E; for (int i = tid; i < 2048; i += 512) bk[i] = (unsigned char)t5_bucket(i); gcur = g; }
        const int hh = g * 8 + wave, t0 = qt * 32;
        const bf16* base_b = proj + (size_t)b * SEQ * NP;
        cmp_unit(a, ldsb, selL, b, g, qt, tid, lane, wave);
        asm volatile("" : "+v"(lane), "+v"(tid) :: "memory");
        const int l32 = lane & 31, hi = lane >> 5, tq = t0 + l32, tok = b * SEQ + tq;
        bf16x8 qf[4]; load_qfrag(proj + (size_t)tok * NP + OFF_BQ + hh * 64, hi, qf, QSCALE2);
        const unsigned mq = selL[l32];
        unsigned un = mq;
#pragma unroll
        for (int o = 1; o < 32; o <<= 1) un |= (unsigned)__shfl_xor((int)un, o);
        un = (unsigned)__builtin_amdgcn_readfirstlane((int)un);
        const float* tab = tabs + wave * 2048;
        f32x16 Os[2], Ow[2]; float m = -1e30f, l = 0.f;
#pragma unroll
        for (int ds = 0; ds < 2; ++ds)
#pragma unroll
            for (int i = 0; i < 16; ++i) { Os[ds][i] = 0.f; Ow[ds][i] = 0.f; }
        attn_pass<64, 2, 8960, true>(un, base_b, 0, 1, OFF_BKV + (4 + g) * 64, OFF_BKV + (6 + g) * 64, Ks, Vt, 0, qf, m, l, Os, tab, bk, tq, 1 << 20, mq, t0 + 31, -(1 << 20), tid, l32, hi);
        const float isel = 1.0f / (l + __shfl_xor(l, 32));
        m = -1e30f; l = 0.f;
        const int wlo = (t0 - 511 > 0 ? t0 - 511 : 0) >> 6, whi = (t0 + 31) >> 6;
        attn_pass<64, 2, 8960, true>(range_mask(wlo, whi), base_b, 0, 1, OFF_BKV + (8 + g) * 64, OFF_BKV + (10 + g) * 64, Ks, Vt, 0, qf, m, l, Ow, tab, bk, tq, 511, 0xffffffffu, t0 + 31, -(1 << 20), tid, l32, hi);
        const float iwin = 1.0f / (l + __shfl_xor(l, 32));
        const bf16* gp = proj + (size_t)tok * NP + OFF_BG + hh * 3;
        const float g0 = sigmoidf_(bf2f(gp[0])), g1 = sigmoidf_(bf2f(gp[1])) * isel, g2 = sigmoidf_(bf2f(gp[2])) * iwin;
#pragma unroll
        for (int ds = 0; ds < 2; ++ds)
#pragma unroll
            for (int i4 = 0; i4 < 4; ++i4) { const int d = ds * 32 + i4 * 8 + 4 * hi; const size_t off = (size_t)tok * 1024 + hh * 64 + d;
                const f32x4 oc = *(const f32x4*)(ocmp + off);
                const float r0 = g0 * oc.x + g1 * Os[ds][i4 * 4 + 0] + g2 * Ow[ds][i4 * 4 + 0], r1 = g0 * oc.y + g1 * Os[ds][i4 * 4 + 1] + g2 * Ow[ds][i4 * 4 + 1];
                const float r2 = g0 * oc.z + g1 * Os[ds][i4 * 4 + 2] + g2 * Ow[ds][i4 * 4 + 2], r3 = g0 * oc.w + g1 * Os[ds][i4 * 4 + 3] + g2 * Ow[ds][i4 * 4 + 3];
                u32x2 w; w.x = pk2(r0, r1); w.y = pk2(r2, r3); *(u32x2*)(ob + (size_t)tok * KCAT + 512 + hh * 64 + d) = w; }
    }
    __syncthreads();
}

__device__ __forceinline__ void phase_diff_mfma(const PT a, int lyr, unsigned char* ldsb, int tid, int lane, int wave, int bid, int nblk) {
    unsigned char* ws = a.ws(); const bf16* proj = (const bf16*)(ws + WS_PROJ); const float* biasT = (const float*)(ws + WS_BIAST); bf16* oc = (bf16*)(ws + WS_OA);
    const float* lv = a.in(9) + (size_t)lyr * 256; const float* sg = a.in(10) + (size_t)lyr * 128;
    const float lam_init = 0.8f - 0.6f * expf(-0.3f * (float)lyr);
    const float lam = expf(wave_sum(lv[lane] * lv[64 + lane])) - expf(wave_sum(lv[128 + lane] * lv[192 + lane])) + lam_init;
    bf16* Ks = (bf16*)ldsb; bf16* Vt = (bf16*)(ldsb + 17408); float* tab = (float*)(ldsb + 69632); unsigned char* bk = ldsb + 77824; float* O2 = (float*)ldsb;
    const int l32 = lane & 31, hi = lane >> 5, mp = wave >> 2, wq = wave & 3;
    int hcur = -1;
    __syncthreads();
    for (int u = bid; u < 512; u += nblk) {
        const int bh = u & 31, b = bh >> 3, h = bh & 7, qt = u < 256 ? 15 - (u >> 5) : ((u - 256) >> 5);
        if (h != hcur) { __syncthreads(); for (int i = tid; i < 2048; i += 512) { tab[i] = biasT[(40 + h) * BT + i] * LOG2E; bk[i] = (unsigned char)t5_bucket(i); } hcur = h; }
        const int t0 = qt * 128, tq = t0 + wq * 32 + l32, tok = b * SEQ + tq;
        const bf16* base_b = proj + (size_t)b * SEQ * NP;
        bf16x8 qf[4]; load_qfrag(proj + (size_t)tok * NP + OFF_CQ + (h * 2 + mp) * 64, hi, qf, QSCALE2);
        f32x16 O[4]; float m = -1e30f, l = 0.f;
#pragma unroll
        for (int ds = 0; ds < 4; ++ds)
#pragma unroll
            for (int i = 0; i < 16; ++i) O[ds][i] = 0.f;
        attn_pass<128, 4, 17408, false>(range_mask(0, (t0 + 127) >> 6), base_b, 0, 1, OFF_CK + h * 128, OFF_CV + h * 128, Ks, Vt, mp * 64, qf, m, l, O, tab, bk, tq, 1 << 20, 0xffffffffu, t0 + wq * 32 + 31, -(1 << 20), tid, l32, hi);
        const float inv = 1.0f / (l + __shfl_xor(l, 32));
        __syncthreads();
        if (mp == 1) {
#pragma unroll
            for (int ds = 0; ds < 4; ++ds)
#pragma unroll
                for (int i = 0; i < 16; ++i) O2[(ds * 16 + i) * 256 + wq * 64 + lane] = O[ds][i] * inv;
        }
        __syncthreads();
        if (mp == 0) {
            float ss = 0.f;
#pragma unroll
            for (int ds = 0; ds < 4; ++ds)
#pragma unroll
                for (int i = 0; i < 16; ++i) { const float o = O[ds][i] * inv - lam * O2[(ds * 16 + i) * 256 + wq * 64 + lane]; O[ds][i] = o; ss += o * o; }
            ss += __shfl_xor(ss, 32);
            const float r = (1.0f - lam_init) / sqrtf(ss * (1.0f / 128.0f) + 1e-6f);
#pragma unroll
            for (int ds = 0; ds < 4; ++ds)
#pragma unroll
                for (int i4 = 0; i4 < 4; ++i4) { const int d = ds * 32 + i4 * 8 + 4 * hi; const f32x4 gn = *(const f32x4*)(sg + d);
                    u32x2 w; w.x = pk2(O[ds][i4 * 4 + 0] * r * gn.x, O[ds][i4 * 4 + 1] * r * gn.y); w.y = pk2(O[ds][i4 * 4 + 2] * r * gn.z, O[ds][i4 * 4 + 3] * r * gn.w);
                    *(u32x2*)(oc + (size_t)tok * KCAT + 1536 + h * 128 + d) = w; }
        }
        __syncthreads();
    }
}


constexpr size_t WS_OAG = WS_MIXF, WS_LSE = WS_MIXB;
__device__ __forceinline__ void phase_dilated_mfma(const PT a, unsigned char* ldsb, int tid, int lane, int wave, int bid, int nblk) {
    unsigned char* ws = a.ws(); const bf16* proj = (const bf16*)(ws + WS_PROJ); const float* biasT = (const float*)(ws + WS_BIAST);
    float* oag = (float*)(ws + WS_OAG); float* lseb = (float*)(ws + WS_LSE);
    bf16* Ks = (bf16*)ldsb; bf16* Vt = (bf16*)(ldsb + 9216); float* tab = (float*)(ldsb + 36864);
    const int l32 = lane & 31, hi = lane >> 5;
    const int nh = (nblk > 64) ? nblk - 64 : nblk, hb = (nblk > 64) ? bid - 64 : bid;
    const int n_heavy_mine = (hb >= 0) ? (512 - hb + nh - 1) / nh : 0;
    const int n_light_mine = (512 - bid + nblk - 1) / nblk;
    for (int it = 0; it < n_heavy_mine + n_light_mine; ++it) {
        const int u = it < n_heavy_mine ? hb + it * nh : 512 + bid + (it - n_heavy_mine) * nblk;
        int g, b, h, r, i0, nq;
        if (u < 256) { g = 0; b = u >> 6; h = (u >> 3) & 7; r = 0; i0 = (u & 7) * 256; nq = 256; }
        else if (u < 512) { const int v = u - 256; g = 1; b = v >> 6; h = (v >> 3) & 7; r = (v >> 1) & 3; i0 = (v & 1) * 256; nq = 256; }
        else { const int v = u - 512; g = 2; b = v >> 7; h = (v >> 4) & 7; r = v & 15; i0 = 0; nq = 128; }
        const int dil = 1 << (2 * g);
        __syncthreads();
        if (tid < 129) tab[tid] = biasT[(g * 8 + h) * BT + tid * dil] * LOG2E;
        const bool act = wave * 32 < nq;
        const int iq = i0 + ((wave * 32) % nq) + l32, tok = b * SEQ + r + dil * iq;
        const bf16* base_b = proj + (size_t)b * SEQ * NP;
        bf16x8 qf[4]; load_qfrag(proj + (size_t)tok * NP + (g * 8 + h) * 64, hi, qf, QSCALE2);
        f32x16 O[2]; float m = -1e30f, l = 0.f;
#pragma unroll
        for (int ds = 0; ds < 2; ++ds)
#pragma unroll
            for (int i = 0; i < 16; ++i) O[ds][i] = 0.f;
        const int wq0 = i0 + wave * 32;
        attn_pass<64, 2, 8960, true>(range_mask((i0 - 128 > 0 ? i0 - 128 : 0) >> 6, (i0 + nq - 1) >> 6), base_b, r, dil, ((3 + g) * 8 + h) * 64, ((6 + g) * 8 + h) * 64, Ks, Vt, 0, qf, m, l, O, tab, (const unsigned char*)nullptr, iq, 128, 0xffffffffu,
                         act ? wq0 + 31 : -1, wq0 - 128, tid, l32, hi);
        if (act) {
            const float lt = l + __shfl_xor(l, 32), inv = 1.0f / lt;
            float* op = oag + ((size_t)g * M + tok) * 512 + h * 64;
#pragma unroll
            for (int ds = 0; ds < 2; ++ds)
#pragma unroll
                for (int i4 = 0; i4 < 4; ++i4) { f32x4 v; v.x = O[ds][i4 * 4 + 0] * inv; v.y = O[ds][i4 * 4 + 1] * inv; v.z = O[ds][i4 * 4 + 2] * inv; v.w = O[ds][i4 * 4 + 3] * inv;
                    *(f32x4*)(op + ds * 32 + i4 * 8 + 4 * hi) = v; }
            if (hi == 0) lseb[((size_t)g * M + tok) * 8 + h] = (m + __log2f(lt)) * 0.6931471805599453f;
        }
    }
    __syncthreads();
}
__device__ __forceinline__ void phase_dil_combine(const PT a, int lane, int gw, int ngw) {
    unsigned char* ws = a.ws(); const float* oag = (const float*)(ws + WS_OAG); const float* lseb = (const float*)(ws + WS_LSE); bf16* oa = (bf16*)(ws + WS_OA);
    for (int tok = gw; tok < M; tok += ngw) {
        const int h = lane >> 3;
        const float l0 = lseb[((size_t)0 * M + tok) * 8 + h], l1 = lseb[((size_t)1 * M + tok) * 8 + h], l2 = lseb[((size_t)2 * M + tok) * 8 + h];
        const float mx = fmaxf(l0, fmaxf(l1, l2)); float w0 = __expf(l0 - mx), w1 = __expf(l1 - mx), w2 = __expf(l2 - mx); const float iw = 1.0f / (w0 + w1 + w2); w0 *= iw; w1 *= iw; w2 *= iw;
        const f32x4* p0 = (const f32x4*)(oag + ((size_t)0 * M + tok) * 512 + lane * 8); const f32x4* p1 = (const f32x4*)(oag + ((size_t)1 * M + tok) * 512 + lane * 8); const f32x4* p2 = (const f32x4*)(oag + ((size_t)2 * M + tok) * 512 + lane * 8);
        const f32x4 x0 = w0 * p0[0] + w1 * p1[0] + w2 * p2[0], x1 = w0 * p0[1] + w1 * p1[1] + w2 * p2[1];
        u32x4 o; o.x = pk2(x0.x, x0.y); o.y = pk2(x0.z, x0.w); o.z = pk2(x1.x, x1.y); o.w = pk2(x1.z, x1.w);
        *(u32x4*)(oa + (size_t)tok * KCAT + lane * 8) = o;
    }
}


__device__ __forceinline__ void phase_compress_mfma(const PT a, int lyr, unsigned char* ldsb, int tid, int lane, int wave, int bid, int nblk) {
    unsigned char* ws = a.ws(); const bf16* proj = (const bf16*)(ws + WS_PROJ);
    unsigned char* cw = ws + WS_CW + (size_t)lyr * 4 * MiB;
    bf16* Ab = (bf16*)ldsb; float* RED = (float*)(ldsb + 17408);
    const int l32 = lane & 31, hi = lane >> 5;
    __syncthreads();
    for (int u = bid; u < 64; u += nblk) {
        const int kv = u >> 5, rg = u & 31;
        const bf16* W1t = (const bf16*)(cw + (size_t)kv * MiB); const bf16* W2t = (const bf16*)(cw + 2 * MiB + (size_t)kv * 65536);
        const float* pos = a.in(3 + kv) + (size_t)lyr * 2048; float* dst = (float*)(ws + (kv ? WS_VC : WS_KC));
        f32x16 acc;
#pragma unroll
        for (int i = 0; i < 16; ++i) acc[i] = 0.f;
        const bf16* wrow = W1t + (size_t)(32 * wave + l32) * 2048 + hi * 8;
#pragma unroll 1
        for (int kc = 0; kc < 8; ++kc) {
            bf16x8 af[16];
#pragma unroll
            for (int kk = 0; kk < 16; ++kk) af[kk] = *(const bf16x8*)(wrow + kc * 256 + kk * 16);
            __syncthreads();
#pragma unroll
            for (int r2 = 0; r2 < 2; ++r2) { const int idx = tid + 512 * r2, row = idx >> 5, ch = idx & 31; int r = rg * 32 + row; r = r < 1016 ? r : 1015;
                const int g = r & 1, bn = r >> 1, b = bn / NCMP, n = bn % NCMP, ll = kc * 4 + (ch >> 3), d = (ch & 7) * 8;
                const u32x4 w = *(const u32x4*)(proj + (size_t)(b * SEQ + 16 * n + ll) * NP + OFF_BKV + (kv * 2 + g) * 64 + d);
                const f32x4 p0 = *(const f32x4*)(pos + ll * 64 + d), p1 = *(const f32x4*)(pos + ll * 64 + d + 4);
                u32x4 o; o.x = pk2(bf_lo(w.x) + p0.x, bf_hi(w.x) + p0.y); o.y = pk2(bf_lo(w.y) + p0.z, bf_hi(w.y) + p0.w); o.z = pk2(bf_lo(w.z) + p1.x, bf_hi(w.z) + p1.y); o.w = pk2(bf_lo(w.w) + p1.z, bf_hi(w.w) + p1.w);
                *(u32x4*)(Ab + row * 264 + ch * 8) = o; }
            __syncthreads();
#pragma unroll
            for (int kk = 0; kk < 16; ++kk) { const bf16x8 bfr = *(const bf16x8*)(Ab + l32 * 264 + kk * 16 + hi * 8); acc = MFMA32(af[kk], bfr, acc); }
        }
#pragma unroll
        for (int i = 0; i < 16; ++i) { const float v = acc[i]; acc[i] = 0.5f * v * (1.0f + tanhf(0.7978845608028654f * (v + 0.044715f * v * v * v))); }
        f32x16 o2[2];
#pragma unroll
        for (int ds = 0; ds < 2; ++ds)
#pragma unroll
            for (int i = 0; i < 16; ++i) o2[ds][i] = 0.f;
#pragma unroll
        for (int c2 = 0; c2 < 2; ++c2) { u32x4 pw; pw.x = pk2(acc[8 * c2 + 0], acc[8 * c2 + 1]); pw.y = pk2(acc[8 * c2 + 2], acc[8 * c2 + 3]); pw.z = pk2(acc[8 * c2 + 4], acc[8 * c2 + 5]); pw.w = pk2(acc[8 * c2 + 6], acc[8 * c2 + 7]);
            const bf16x8 hb = __builtin_bit_cast(bf16x8, pw);
#pragma unroll
            for (int ds = 0; ds < 2; ++ds) { const bf16* wp = W2t + (size_t)(ds * 32 + l32) * 256 + 32 * wave + 16 * c2 + 4 * hi;
                const u32x2 lo = *(const u32x2*)wp, hi2 = *(const u32x2*)(wp + 8); u32x4 vw; vw.x = lo.x; vw.y = lo.y; vw.z = hi2.x; vw.w = hi2.y;
                o2[ds] = MFMA32(__builtin_bit_cast(bf16x8, vw), hb, o2[ds]); } }
#pragma unroll
        for (int ds = 0; ds < 2; ++ds)
#pragma unroll
            for (int i = 0; i < 16; ++i) RED[(wave * 64 + ds * 32 + (i >> 2) * 8 + 4 * hi + (i & 3)) * 33 + l32] = o2[ds][i];
        __syncthreads();
#pragma unroll
        for (int e = 0; e < 4; ++e) { const int idx = tid + 512 * e, d = idx & 63, row = idx >> 6; float s = 0.f;
#pragma unroll
            for (int w = 0; w < 8; ++w) s += RED[(w * 64 + d) * 33 + row];
            const int r = rg * 32 + row; if (r < 1016) dst[(size_t)r * 64 + d] = s; }
        __syncthreads();
    }
}

#define XB_TMO      128
#define XB_XCNT(j)  (256  + 64 * (j))
#define XB_XSUB(j)  (1280 + 64 * (j))
#define XB_XGEN(j)  (2304 + 64 * (j))
#define XB_TOP      3328
#define XB_TOPGEN   3392
#define XCD_BAR_WORDS 3456
#define XB_SPIN_CAP (1u << 18)

__device__ __forceinline__ unsigned xb_ld(unsigned* p)              { return __hip_atomic_load(p, __ATOMIC_RELAXED, __HIP_MEMORY_SCOPE_AGENT); }
__device__ __forceinline__ unsigned xb_add(unsigned* p, unsigned v) { return __hip_atomic_fetch_add(p, v, __ATOMIC_RELAXED, __HIP_MEMORY_SCOPE_AGENT); }
__device__ __forceinline__ unsigned xb_xcc_id() { return (unsigned)__builtin_amdgcn_s_getreg((3 << 11) | 20) & 0xFu; }
#define XB_SPIN(cond, bar) do { unsigned _sp = 0; while (cond) { __builtin_amdgcn_s_sleep(1); \
    if ((++_sp & 255u) == 0u) { if (xb_ld(&(bar)[XB_TMO])) break; if (_sp > XB_SPIN_CAP) { atomicAdd(&(bar)[XB_TMO], 1u); break; } } } } while (0)

struct XcdBarrier {
    unsigned* bar; unsigned x;
    volatile LAS unsigned* st;
};

__device__ __forceinline__ XcdBarrier xcd_barrier_post(unsigned* bar, volatile LAS unsigned* st) {
    XcdBarrier b; b.bar = bar; b.x = xb_xcc_id(); b.st = st;
    if (threadIdx.x == 0) (void)xb_add(&bar[XB_XCNT(b.x)], 1u);
    return b;
}
__device__ __forceinline__ void xcd_barrier_complete(unsigned* bar, unsigned x, unsigned& nloc, unsigned& nx) {
    const unsigned G = gridDim.x * gridDim.y * gridDim.z;
    unsigned sum, cnt, mine, sp = 0u;
    for (;;) {
        sum = 0u; cnt = 0u; mine = 0u;
#pragma unroll
        for (unsigned j = 0; j < 16; ++j) { const unsigned c = xb_ld(&bar[XB_XCNT(j)]); sum += c; cnt += (c > 0u) ? 1u : 0u; mine = (j == x) ? c : mine; }
        if (sum == G) break;
        __builtin_amdgcn_s_sleep(1);
        if ((++sp & 255u) == 0u) { if (xb_ld(&bar[XB_TMO])) break; if (sp > XB_SPIN_CAP) { atomicAdd(&bar[XB_TMO], 1u); break; } }
    }
    nloc = mine > 0u ? mine : 1u; nx = cnt > 0u ? cnt : 1u;
}

__device__ __forceinline__ void xcd_barrier(const XcdBarrier& b) {
    asm volatile("s_waitcnt vmcnt(0)" ::: "memory");
    __syncthreads();
    if (threadIdx.x == 0) {
        unsigned* bar = b.bar;
        __builtin_amdgcn_s_waitcnt(0);
        unsigned nloc = b.st[0], nx = b.st[1];
        if (nloc == 0u) { xcd_barrier_complete(bar, b.x, nloc, nx); b.st[0] = nloc; b.st[1] = nx; }
        const unsigned old = xb_add(&bar[XB_XSUB(b.x)], 1u);
        const unsigned gen = old / nloc;
        if (old + 1u == (gen + 1u) * nloc) {
            __builtin_amdgcn_fence(__ATOMIC_RELEASE, "agent");
            asm volatile("s_waitcnt vmcnt(0)" ::: "memory");
            const unsigned og = xb_add(&bar[XB_TOP], 1u);
            const unsigned tg = og / nx;
            if (og + 1u == (tg + 1u) * nx) xb_add(&bar[XB_TOPGEN], 1u);
            else XB_SPIN(xb_ld(&bar[XB_TOPGEN]) == tg, bar);
            __builtin_amdgcn_fence(__ATOMIC_ACQUIRE, "agent");
            xb_add(&bar[XB_XGEN(b.x)], 1u);
            asm volatile("s_waitcnt vmcnt(0)" ::: "memory");
        } else {
            XB_SPIN(xb_ld(&bar[XB_XGEN(b.x)]) == gen, bar);
            __builtin_amdgcn_fence(__ATOMIC_ACQUIRE, "agent");
            asm volatile("s_waitcnt vmcnt(0)" ::: "memory");
        }
    }
    __syncthreads();
}

__global__ void __launch_bounds__(512, 2) mega_fwd(Args ka) {
    extern __shared__ __attribute__((aligned(16))) unsigned char lds[];
    LAS unsigned char* ldsl = (LAS unsigned char*)lds;
    const int tid0 = threadIdx.x;
    {
        unsigned long long* pt = (unsigned long long*)(lds + PTAB_OFF);
        if (tid0 < 21) pt[tid0] = (unsigned long long)ka.in[tid0];
        if (tid0 == 21) pt[21] = (unsigned long long)ka.out;
        if (tid0 == 22) pt[22] = (unsigned long long)ka.ws;
        if (tid0 == 23) { pt[32] = 0ull; }
        __syncthreads();
    }
    const int ph_lo = ka.ph_lo, ph_hi = ka.ph_hi;
    cg::grid_group grid = cg::this_grid();
    (void)xcd_barrier_post((unsigned*)(__attribute__((address_space(1))) unsigned*)(ka.ws + WS_BAR), (volatile LAS unsigned*)(ldsl + PTAB_OFF + 256));
    for (int ph = ph_lo; ph < ph_hi; ++ph) {
        unsigned ldso0 = 0; asm volatile("" : "+s"(ldso0));
        const PT a{(const unsigned long long*)(lds + PTAB_OFF + ldso0)};
        if (ph == 0) { int tidp = tid0; asm volatile("" : "+v"(tidp)); const int lanep = tidp & 63, wavep = __builtin_amdgcn_readfirstlane(tidp >> 6);
            phase_prologue(a, (float*)(lds + ldso0), lanep, wavep, (int)blockIdx.x * 8 + wavep, (int)gridDim.x * 8); }
        else {
            const int l = (ph - 1) / PH_PER_LAYER; int k = (ph - 1) % PH_PER_LAYER; if (k >= 2) k += 1;
            unsigned char* ws = a.ws();
            unsigned char* wl = ws + WS_WT + (size_t)l * LAYER_W;
            bf16* H = (bf16*)(ws + WS_H); bf16* proj = (bf16*)(ws + WS_PROJ);
            int njobs = 0, mode0 = 0, N = 0, K = 0; const bf16* A0 = nullptr; const bf16* B0 = nullptr; bf16* ob = nullptr; float* of = nullptr;
            if (k == 0) { njobs = 1; mode0 = 0; A0 = H; B0 = (const bf16*)(wl + WO_IN); N = NP; K = DM; ob = proj; }
            else if (k == 4) { njobs = 1; mode0 = 6; A0 = (const bf16*)(ws + WS_OA); B0 = (const bf16*)(wl + WO_A); N = DM; K = KCAT; ob = (bf16*)(ws + WS_MIXB); }
            else if (k == 5) { njobs = 1; mode0 = 4; A0 = (const bf16*)(ws + WS_MIXB); B0 = (const bf16*)(wl + WO_OUT); N = DM; K = DM; ob = (bf16*)(ws + WS_Y); }
            else if (k == 7) { njobs = 1; mode0 = 5; A0 = H; B0 = (const bf16*)(wl + WO_UP); N = DFF; K = DM; ob = (bf16*)(ws + WS_U); }
            else if (k == 8) { njobs = 1; mode0 = 4; A0 = (const bf16*)(ws + WS_U); B0 = (const bf16*)(wl + WO_DOWN); N = DM; K = DFF; ob = (bf16*)(ws + WS_Y); }
            for (int j = 0; j < njobs; ++j) {
                const bf16* A = A0; const bf16* B = B0; int Kj = K;
                pg8::Gemm g{A, B, M, N, Kj}; pg8::StaticOrder S; S.init(M, N, (int)gridDim.x, (int)blockIdx.x);
                EpiAny E{mode0 + j, ob, of, proj};
                pg8::gemm_phase<EpiAny, pg8::StaticOrder, true, true>(ldsl, g, S, E);
            }
            int tid = tid0; asm volatile("" : "+v"(tid));
            int bid = (int)blockIdx.x, nblk = (int)gridDim.x; asm volatile("" : "+s"(bid), "+s"(nblk));
            unsigned ldso = 0; asm volatile("" : "+s"(ldso));
            float* ldsf = (float*)(lds + ldso);
            const int lane = tid & 63, wave = __builtin_amdgcn_readfirstlane(tid >> 6);
            const int gw = bid * 8 + wave, ngw = nblk * 8;
            if (k == 1) {
                for (int rep = 0; rep < ((PROBE_SUB & 1) ? 2 : 1); ++rep) { asm volatile("" : "+v"(tid), "+s"(bid)); phase_compress_mfma(a, l, (unsigned char*)ldsf, tid, tid & 63, __builtin_amdgcn_readfirstlane(tid >> 6), bid, nblk); }
                for (int rep = 0; rep < ((PROBE_SUB & 2) ? 2 : 1); ++rep) { asm volatile("" : "+v"(tid), "+s"(bid)); phase_dilated_mfma(a, (unsigned char*)ldsf, tid, tid & 63, __builtin_amdgcn_readfirstlane(tid >> 6), bid, nblk); }
                for (int rep = 0; rep < ((PROBE_SUB & 4) ? 2 : 1); ++rep) { asm volatile("" : "+v"(tid), "+s"(bid)); phase_diff_mfma(a, l, (unsigned char*)ldsf, tid, tid & 63, __builtin_amdgcn_readfirstlane(tid >> 6), bid, nblk); } }
            else if (k == 3) { phase_dil_combine(a, lane, gw, ngw); phase_nsa_mfma(a, (unsigned char*)ldsf, tid, lane, wave, bid, nblk); }
            else if (k == 6) { float* xo = a.out(); const float* xi = (l == 0) ? a.in(0) : xo;
                for (int m = gw; m < M; m += ngw) rowpass_row(xi + (size_t)m * DM, (const bf16*)(ws + WS_Y) + (size_t)m * DM, a.in(16) + (size_t)l * DM, a.in(17) + (size_t)l * DM, xo + (size_t)m * DM, H + (size_t)m * DM, lane); }
            else if (k == 9) { float* xo = a.out(); const float* gn = (l + 1 < DEPTH) ? a.in(15) + (size_t)(l + 1) * DM : nullptr;
                for (int m = gw; m < M; m += ngw) rowpass_row(xo + (size_t)m * DM, (const bf16*)(ws + WS_Y) + (size_t)m * DM, a.in(18) + (size_t)l * DM, gn, xo + (size_t)m * DM, H + (size_t)m * DM, lane); }
        }
        if (ph + 1 < ph_hi) { XcdBarrier xbar; xbar.bar = (unsigned*)(a.ws() + WS_BAR); xbar.x = xb_xcc_id(); xbar.st = (volatile LAS unsigned*)(ldsl + PTAB_OFF + 256); xcd_barrier(xbar); }
        if (ph_hi > 100000) grid.sync();
    }
}

#ifndef N_LAUNCH_SPLIT
#define N_LAUNCH_SPLIT 0
#endif
extern "C" void kernel_launch(void* const* d_in, const int* in_sizes, int n_in, void* d_out, int out_size, void* d_ws, size_t ws_size, hipStream_t stream) {
    static int grid = 0;
    if (grid == 0) {
        if (n_in != 21 || out_size != M * DM || ws_size < WS_END) { fprintf(stderr, "kernel_launch: unexpected shapes (n_in %d out %d ws %zu)\n", n_in, out_size, ws_size); grid = -1; return; }
        int dev = 0, cus = 0, per_cu = 0;
        (void)hipGetDevice(&dev); (void)hipDeviceGetAttribute(&cus, hipDeviceAttributeMultiprocessorCount, dev);
        if (hipFuncSetAttribute((const void*)mega_fwd, hipFuncAttributeMaxDynamicSharedMemorySize, LDS_BYTES) != hipSuccess) { fprintf(stderr, "hipFuncSetAttribute failed\n"); grid = -1; return; }
        if (hipOccupancyMaxActiveBlocksPerMultiprocessor(&per_cu, (const void*)mega_fwd, 512, LDS_BYTES) != hipSuccess || per_cu < 1) { fprintf(stderr, "occupancy query: %d\n", per_cu); per_cu = 1; }
        (void)hipGetLastError();
        grid = cus > 0 ? cus : 256;
    }
    if (grid < 0) return;
    if (hipMemsetAsync((char*)d_ws + WS_BAR, 0, 16384, stream) != hipSuccess) { fprintf(stderr, "kernel_launch: memset of the barrier words failed\n"); return; }
    Args a{};
    for (int i = 0; i < 21; ++i) a.in[i] = (const float*)d_in[i];
    a.out = (float*)d_out; a.ws = (unsigned char*)d_ws;
#if N_LAUNCH_SPLIT
    for (int ph = 0; ph < NPH; ++ph) { a.ph_lo = ph; a.ph_hi = ph + 1; hipLaunchKernelGGL(mega_fwd, dim3(grid), dim3(512), LDS_BYTES, stream, a); }
#else
    a.ph_lo = 0; a.ph_hi = NPH;
    void* args[] = {&a};
    hipError_t e = hipLaunchCooperativeKernel((const void*)mega_fwd, dim3(grid), dim3(512), args, LDS_BYTES, stream);
    if (e != hipSuccess) fprintf(stderr, "cooperative launch failed: %s (grid %d)\n", hipGetErrorString(e), grid);
#endif
}
```

```cpp
#include <hip/hip_runtime.h>
#include <hip/hip_cooperative_groups.h>
#include <cstdio>
#include <cstdint>
namespace cg = cooperative_groups;
namespace pg8 {
#define PG8_LAS __attribute__((address_space(3)))
typedef unsigned short bf16_t;
typedef short bf16x8 __attribute__((ext_vector_type(8)));
typedef float f32x4 __attribute__((ext_vector_type(4)));
typedef unsigned u32x4 __attribute__((ext_vector_type(4)));
constexpr int BM = 256, BK = 64, HALF = 128, HTB = HALF * BK * 2  , STAGE_BYTES = 8 * HTB, NXCD = 8, WGM = 8;

__host__ __device__ __forceinline__ int lds_byte(int r, int c) { const int st = (r >> 4) * 2 + (c >> 5), rr = r & 15, cc = c & 31, ob = rr * 64 + cc * 2; return st * 1024 + (ob ^ (((ob >> 9) & 1) << 5)); }
__host__ __device__ __forceinline__ void stage_rc(int b, int& R, int& C) { const int st = b / 1024, sb = b % 1024, swz = sb ^ (((sb >> 9) & 1) << 5); R = (st >> 1) * 16 + swz / 64; C = (st & 1) * 32 + (swz % 64) / 2; }
__host__ __device__ __forceinline__ int perm32(int rho) { const int n = rho >> 4, i = rho & 15; return 8 * (i >> 2) + 4 * n + (i & 3); }

struct Unit { int pm, pn; };
struct Gemm { const bf16_t* A; const bf16_t* Bt; int M, N, K; };

struct StaticOrder {
    int nM, nN, nwg, G, c;
    __host__ __device__ void init(int M, int N, int G_, int c_) { nM = M / BM; nN = N / BM; nwg = nM * nN; G = G_; c = c_; }
    __host__ __device__ bool next(int i, Unit& u) const {
        const long L = (long)i * G + c; if (L >= nwg) return false;
        int wgid = (int)L; { const int q = nwg / NXCD, r = nwg % NXCD, xcd = wgid % NXCD, off = wgid / NXCD; wgid = (xcd < r ? xcd * (q + 1) : r * (q + 1) + (xcd - r) * q) + off; }
        const int nig = WGM * nN, gid = wgid / nig, fm = gid * WGM, gsz = (nM - fm) < WGM ? (nM - fm) : WGM;
        u.pm = fm + ((wgid % nig) % gsz); u.pn = (wgid % nig) / gsz; return true;
    }
    __device__ __forceinline__ void a_ready(const Unit&) const {}
    __device__ __forceinline__ void done(const Unit&) const {}
};

__device__ __forceinline__ unsigned cvt_pk_bf16(float lo, float hi) { unsigned r; asm volatile("v_cvt_pk_bf16_f32 %0, %1, %2" : "=v"(r) : "v"(lo), "v"(hi)); return r; }
typedef float f32x2 __attribute__((ext_vector_type(2)));
template <class Epi, class Sched, bool ALIGN_EPI = false, bool SP2 = false>
__device__ __forceinline__ void gemm_phase(PG8_LAS unsigned char* lds, const Gemm g, const Sched& S, const Epi& E) {
    const int tid = threadIdx.x, wid = __builtin_amdgcn_readfirstlane(tid >> 6), lane = tid & 63, wr = wid >> 2, wc = wid & 3, fr = lane & 15, fq = lane >> 4;
    const int K = g.K, nt = K / BK;
    unsigned voffA[2], voffB[2];
#pragma unroll
    for (int i = 0; i < 2; ++i) { int R, C; stage_rc(tid * 16 + i * 8192, R, C); const int Rb = Epi::PERM ? ((R & ~31) + perm32(R & 31)) : R;
        voffA[i] = (unsigned)(R * K + C) * 2u; voffB[i] = (unsigned)(Rb * K + C) * 2u; }
    const size_t kstep = (size_t)(BK * 2);
    const size_t hstep = (size_t)HALF * K * 2;
    const size_t tstep = 2 * hstep;
    const unsigned ldsw = (unsigned)wid * 1024u;
    const int aoff = lds_byte(wr * 64 + fr, fq * 8), boff = lds_byte(wc * 32 + fr, fq * 8);
#define PG8_SA(b, h) (((b) * 2 + (h)) * HTB)
#define PG8_SB(b, h) ((4 + (b) * 2 + (h)) * HTB)
#define PG8_STAGE(bufoff, gbase, voff) do { _Pragma("unroll") for (int _i = 0; _i < 2; ++_i) \
        __builtin_amdgcn_global_load_lds((const unsigned*)((const char*)(gbase) + (voff)[_i]), (PG8_LAS unsigned*)(lds + (bufoff) + ldsw + _i * 8192), 16, 0, 0); } while (0)
#define PG8_LDA(dst, b, h) do { _Pragma("unroll") for (int m = 0; m < 4; ++m) _Pragma("unroll") for (int k = 0; k < 2; ++k) dst[m][k] = *(const PG8_LAS bf16x8*)(lds + PG8_SA(b, h) + aoff + m * 2048 + k * 1024); } while (0)
#define PG8_LDB(dst, b, h) do { _Pragma("unroll") for (int n = 0; n < 2; ++n) _Pragma("unroll") for (int k = 0; k < 2; ++k) dst[n][k] = *(const PG8_LAS bf16x8*)(lds + PG8_SB(b, h) + boff + n * 2048 + k * 1024); } while (0)
#define PG8_MMA(ai, bj, At, Bt) do { __builtin_amdgcn_s_setprio(1); _Pragma("unroll") for (int m = 0; m < 4; ++m) _Pragma("unroll") for (int n = 0; n < 2; ++n) _Pragma("unroll") for (int k = 0; k < 2; ++k) \
        acc[ai][bj][m][n] = __builtin_amdgcn_mfma_f32_16x16x32_bf16(Bt[n][k], At[m][k], acc[ai][bj][m][n], 0, 0, 0); __builtin_amdgcn_s_setprio(0); } while (0)
#define PG8_WAIT_V(n) asm volatile("s_waitcnt vmcnt(" #n ")" ::: "memory")
#define PG8_WAIT_L(n) asm volatile("s_waitcnt lgkmcnt(" #n ")" ::: "memory")
#define PG8_BAR __builtin_amdgcn_s_barrier()
#define PG8_SCHED __builtin_amdgcn_sched_barrier(0)
    Unit cur, nxt; int ui = 0;
    if (!S.next(0, cur)) return;
    f32x4 acc[2][2][4][2];
#pragma unroll
    for (int a = 0; a < 2; ++a)
#pragma unroll
        for (int b = 0; b < 2; ++b)
#pragma unroll
            for (int m = 0; m < 4; ++m)
#pragma unroll
                for (int n = 0; n < 2; ++n) acc[a][b][m][n] = (f32x4){0.f, 0.f, 0.f, 0.f};
    bf16x8 At[4][2], B0[2][2], B1[2][2];
    const char* cA = (const char*)g.A + (size_t)cur.pm * tstep; const char* cB = (const char*)g.Bt + (size_t)cur.pn * tstep;
    S.a_ready(cur);
    if constexpr (SP2) {
        PG8_STAGE(PG8_SB(0, 0), cB, voffB); PG8_STAGE(PG8_SB(0, 1), cB + hstep, voffB); PG8_STAGE(PG8_SA(0, 0), cA, voffA); PG8_STAGE(PG8_SA(0, 1), cA + hstep, voffA);
        if (wr == 1) PG8_BAR;
        PG8_WAIT_V(2); PG8_BAR;
        PG8_STAGE(PG8_SB(1, 0), cB + kstep, voffB); PG8_STAGE(PG8_SA(1, 0), cA + kstep, voffA); PG8_STAGE(PG8_SB(1, 1), cB + hstep + kstep, voffB);
        PG8_WAIT_V(6); PG8_BAR;
    } else {
        PG8_STAGE(PG8_SB(0, 0), cB, voffB); PG8_STAGE(PG8_SA(0, 0), cA, voffA); PG8_STAGE(PG8_SB(0, 1), cB + hstep, voffB); PG8_STAGE(PG8_SA(0, 1), cA + hstep, voffA);
        if (wr == 1) PG8_BAR;
        PG8_WAIT_V(4); PG8_BAR;
        PG8_STAGE(PG8_SB(1, 0), cB + kstep, voffB); PG8_STAGE(PG8_SA(1, 0), cA + kstep, voffA); PG8_STAGE(PG8_SB(1, 1), cB + hstep + kstep, voffB);
        PG8_WAIT_V(6); PG8_BAR;
    }
    for (;;) {
        const bool has_next = S.next(ui + 1, nxt);
        const char* nA = has_next ? (const char*)g.A + (size_t)nxt.pm * tstep : cA; const char* nB = has_next ? (const char*)g.Bt + (size_t)nxt.pn * tstep : cB;
        for (int t = 0; t < nt; t += 2) {
            if constexpr (Epi::KHOOK) { if (E.khook_at(t)) E.khook(acc, cur, t, wr, wc, fr, fq); }
            const bool last = (t == nt - 2);
            const char* a1 = cA + (size_t)(t + 1) * kstep;
            const char* a2 = last ? nA : cA + (size_t)(t + 2) * kstep; const char* b2 = last ? nB : cB + (size_t)(t + 2) * kstep;
            const char* a3 = a2 + kstep; const char* b3 = b2 + kstep;
            if (last && has_next) S.a_ready(nxt);
            if constexpr (SP2) {
            PG8_LDB(B0, 0, 0); PG8_LDB(B1, 0, 1); PG8_SCHED; PG8_LDA(At, 0, 0); PG8_STAGE(PG8_SA(1, 1), a1 + hstep, voffA);
            PG8_WAIT_V(8); PG8_WAIT_L(0); PG8_BAR; PG8_MMA(0, 0, At, B0); PG8_MMA(0, 1, At, B1); PG8_BAR; PG8_SCHED;
            PG8_LDA(At, 0, 1); PG8_STAGE(PG8_SB(0, 0), b2, voffB); PG8_STAGE(PG8_SB(0, 1), b2 + hstep, voffB); PG8_STAGE(PG8_SA(0, 0), a2, voffA);
            PG8_WAIT_V(8); PG8_WAIT_L(0); PG8_BAR; PG8_MMA(1, 0, At, B0); PG8_MMA(1, 1, At, B1); PG8_BAR; PG8_SCHED;
            PG8_LDB(B0, 1, 0); PG8_LDB(B1, 1, 1); PG8_SCHED; PG8_LDA(At, 1, 0); PG8_STAGE(PG8_SA(0, 1), a2 + hstep, voffA);
            PG8_WAIT_V(8); PG8_WAIT_L(0); PG8_BAR; PG8_MMA(0, 0, At, B0); PG8_MMA(0, 1, At, B1); PG8_BAR; PG8_SCHED;
            PG8_LDA(At, 1, 1); PG8_STAGE(PG8_SB(1, 0), b3, voffB); PG8_STAGE(PG8_SB(1, 1), b3 + hstep, voffB); PG8_STAGE(PG8_SA(1, 0), a3, voffA);
            PG8_WAIT_V(8); PG8_WAIT_L(0); PG8_BAR; PG8_MMA(1, 0, At, B0); PG8_MMA(1, 1, At, B1); PG8_BAR; PG8_SCHED;
            } else {
            PG8_LDB(B0, 0, 0); PG8_SCHED; PG8_LDA(At, 0, 0); PG8_STAGE(PG8_SA(1, 1), a1 + hstep, voffA);
            PG8_WAIT_L(8); PG8_BAR; PG8_WAIT_L(0); PG8_MMA(0, 0, At, B0); PG8_BAR; PG8_SCHED;
            PG8_LDB(B1, 0, 1); PG8_STAGE(PG8_SB(0, 0), b2, voffB);
            PG8_BAR; PG8_WAIT_L(0); PG8_MMA(0, 1, At, B1); PG8_BAR;
            PG8_LDA(At, 0, 1); PG8_STAGE(PG8_SA(0, 0), a2, voffA);
            PG8_BAR; PG8_WAIT_L(0); PG8_MMA(1, 0, At, B0); PG8_BAR; PG8_SCHED;
            PG8_STAGE(PG8_SB(0, 1), b2 + hstep, voffB);
            PG8_WAIT_V(6); PG8_BAR; PG8_MMA(1, 1, At, B1); PG8_BAR;
            PG8_LDB(B0, 1, 0); PG8_SCHED; PG8_LDA(At, 1, 0); PG8_STAGE(PG8_SA(0, 1), a2 + hstep, voffA);
            PG8_WAIT_L(8); PG8_BAR; PG8_WAIT_L(0); PG8_MMA(0, 0, At, B0); PG8_BAR; PG8_SCHED;
            PG8_LDB(B1, 1, 1); PG8_STAGE(PG8_SB(1, 0), b3, voffB);
            PG8_BAR; PG8_WAIT_L(0); PG8_MMA(0, 1, At, B1); PG8_BAR;
            PG8_LDA(At, 1, 1); PG8_STAGE(PG8_SA(1, 0), a3, voffA);
            PG8_BAR; PG8_WAIT_L(0); PG8_MMA(1, 0, At, B0); PG8_BAR; PG8_SCHED;
            PG8_STAGE(PG8_SB(1, 1), b3 + hstep, voffB);
            PG8_WAIT_V(6); PG8_BAR; PG8_MMA(1, 1, At, B1); PG8_BAR;
            }
        }
        if constexpr (ALIGN_EPI) { if (wr == 0) PG8_BAR; }
        if constexpr (!Epi::AFTER_DRAIN) { E(acc, cur, wr, wc, fr, fq); S.done(cur); }
        if (!has_next) break;
#pragma unroll
        for (int a = 0; a < 2; ++a)
#pragma unroll
            for (int b = 0; b < 2; ++b)
#pragma unroll
                for (int m = 0; m < 4; ++m)
#pragma unroll
                    for (int n = 0; n < 2; ++n) acc[a][b][m][n] = (f32x4){0.f, 0.f, 0.f, 0.f};
        cur = nxt; cA = nA; cB = nB; ++ui;
        if constexpr (ALIGN_EPI) { if (wr == 1) PG8_BAR; }
    }
    PG8_WAIT_V(0);
    if constexpr (!ALIGN_EPI) { if (wr == 0) PG8_BAR; }
    PG8_BAR;
    if constexpr (Epi::AFTER_DRAIN) { E.fused(acc, cur, wr, wc, fr, fq, lds, wid, lane); S.done(cur); }
#undef PG8_SA
#undef PG8_SB
#undef PG8_STAGE
#undef PG8_LDA
#undef PG8_LDB
#undef PG8_MMA
#undef PG8_WAIT_V
#undef PG8_WAIT_L
#undef PG8_BAR
#undef PG8_SCHED
}
}
#ifndef PROBE_SUB
#define PROBE_SUB 0
#endif
#ifndef PROBE_DUP
#define PROBE_DUP 0
#endif
#ifndef PROBE_DUPK
#define PROBE_DUPK -1
#endif
#ifndef PROBE_PRO
#define PROBE_PRO 0
#endif
#define LAS __attribute__((address_space(3)))
typedef unsigned short bf16;
typedef float f32x4 __attribute__((ext_vector_type(4)));
typedef unsigned u32x4 __attribute__((ext_vector_type(4)));
typedef unsigned u32x2 __attribute__((ext_vector_type(2)));

constexpr int BATCH = 4, SEQ = 2048, DM = 2048, M = BATCH * SEQ, DEPTH = 2;
constexpr int NIN = 15664, NP = 15872, DFF = 8192;
constexpr int OFF_BQ = 4608, OFF_BKV = 5632, OFF_BG = 6400, OFF_CQ = 6448, OFF_CK = 7472, OFF_CV = 8496, OFF_MG = 9520;
constexpr int BT = 2112;
constexpr int NCMP = 127;
constexpr size_t MiB = 1u << 20;
constexpr size_t WS_WT = 0, LAYER_W = 144 * MiB;
constexpr size_t WO_IN = 0, WO_A = 62 * MiB, WO_B = 64 * MiB, WO_C = 68 * MiB, WO_OUT = 72 * MiB, WO_UP = 80 * MiB, WO_DOWN = 112 * MiB;
constexpr size_t WS_H = 288 * MiB, WS_PROJ = 320 * MiB, WS_U = WS_PROJ;
constexpr size_t WS_OA = 568 * MiB, WS_OB = 576 * MiB, WS_OC = 592 * MiB, WS_OCMP = 608 * MiB;
constexpr size_t WS_MIXF = 640 * MiB, WS_MIXB = 704 * MiB, WS_Y = 736 * MiB;
constexpr size_t WS_KC = 800 * MiB, WS_VC = 801 * MiB, WS_SELM = 802 * MiB, WS_BIAST = 803 * MiB, WS_CW = 804 * MiB, WS_BAR = 812 * MiB, WS_END = 813 * MiB;
constexpr int LDS_BYTES = 147456;
constexpr int PH_PER_LAYER = 9;
constexpr int NPH = 1 + DEPTH * PH_PER_LAYER;

struct Args { const float* in[21]; float* out; unsigned char* ws; int ph_lo, ph_hi; };
constexpr int PTAB_OFF = 131072 + 1024;
struct PT { const unsigned long long* t;
    __device__ __forceinline__ unsigned long long get(int i) const { const unsigned long long v = t[i]; const unsigned lo = __builtin_amdgcn_readfirstlane((unsigned)v), hi = __builtin_amdgcn_readfirstlane((unsigned)(v >> 32)); return ((unsigned long long)hi << 32) | lo; }
    __device__ __forceinline__ const float* in(int i) const { return (const float*)(const __attribute__((address_space(1))) float*)get(i); }
    __device__ __forceinline__ float* out() const { return (float*)(__attribute__((address_space(1))) float*)get(21); }
    __device__ __forceinline__ unsigned char* ws() const { return (unsigned char*)(__attribute__((address_space(1))) unsigned char*)get(22); } };

#define LDS_FENCE() asm volatile("s_waitcnt vmcnt(0) lgkmcnt(0)" ::: "memory")

__device__ __forceinline__ unsigned f2bf(float f) { unsigned u = __builtin_bit_cast(unsigned, f); return (u + 0x7fffu + ((u >> 16) & 1u)) >> 16; }
__device__ __forceinline__ unsigned pk2(float lo, float hi) { return f2bf(lo) | (f2bf(hi) << 16); }
typedef __bf16 bf16v2_t __attribute__((ext_vector_type(2)));
typedef float f32v2_t __attribute__((ext_vector_type(2)));
__device__ __forceinline__ unsigned pkh(float lo, float hi) { f32v2_t v; v.x = lo; v.y = hi; return __builtin_bit_cast(unsigned, __builtin_convertvector(v, bf16v2_t)); }
__device__ __forceinline__ float bf_lo(unsigned w) { return __uint_as_float(w << 16); }
__device__ __forceinline__ float bf_hi(unsigned w) { return __uint_as_float(w & 0xffff0000u); }
__device__ __forceinline__ float bf2f(bf16 h) { return __uint_as_float(((unsigned)h) << 16); }
__device__ __forceinline__ float wave_sum(float v) {
#pragma unroll
    for (int o = 32; o >= 1; o >>= 1) v += __shfl_xor(v, o);
    return v;
}
__device__ __forceinline__ float wave_max(float v) {
#pragma unroll
    for (int o = 32; o >= 1; o >>= 1) v = fmaxf(v, __shfl_xor(v, o));
    return v;
}
__device__ __forceinline__ float sigmoidf_(float x) { return 1.0f / (1.0f + __expf(-x)); }

__device__ __forceinline__ void load64(const bf16* p, float (&q)[64]) {
    const u32x4* p4 = (const u32x4*)p;
#pragma unroll
    for (int i = 0; i < 8; ++i) { const u32x4 w = p4[i];
        q[8 * i + 0] = bf_lo(w.x); q[8 * i + 1] = bf_hi(w.x); q[8 * i + 2] = bf_lo(w.y); q[8 * i + 3] = bf_hi(w.y);
        q[8 * i + 4] = bf_lo(w.z); q[8 * i + 5] = bf_hi(w.z); q[8 * i + 6] = bf_lo(w.w); q[8 * i + 7] = bf_hi(w.w); }
}
__device__ __forceinline__ float dot64(const float (&q)[64], const bf16* k) {
    const u32x4* k4 = (const u32x4*)k; float a0 = 0.f, a1 = 0.f;
#pragma unroll
    for (int i = 0; i < 8; ++i) { const u32x4 w = k4[i];
        a0 += q[8 * i + 0] * bf_lo(w.x); a1 += q[8 * i + 1] * bf_hi(w.x); a0 += q[8 * i + 2] * bf_lo(w.y); a1 += q[8 * i + 3] * bf_hi(w.y);
        a0 += q[8 * i + 4] * bf_lo(w.z); a1 += q[8 * i + 5] * bf_hi(w.z); a0 += q[8 * i + 6] * bf_lo(w.w); a1 += q[8 * i + 7] * bf_hi(w.w); }
    return a0 + a1;
}
__device__ __forceinline__ float wave_softmax(float* S, int n, int lane, float& mout) {
    float m = -3.0e38f;
    for (int i = lane; i < n; i += 64) m = fmaxf(m, S[i]);
    m = wave_max(m);
    float s = 0.f;
    for (int i = lane; i < n; i += 64) { const float e = __expf(S[i] - m); S[i] = e; s += e; }
    s = wave_sum(s); mout = m; return s;
}

struct TItem { const float* W; bf16* WT; int K, N, item, pitch; };
struct TRegs { f32x4 v0[8], v1[8]; };
__device__ __forceinline__ void titem_load(const TItem& t, TRegs& R, int lane) {
    const int nblk = (t.N + 63) / 64, kb = t.item / nblk, nb = t.item % nblk, k0 = 64 * kb, n0 = 64 * nb;
    const int rg = lane >> 4, c4 = lane & 15, nn = n0 + 4 * c4; const bool ok = nn < t.N;
#pragma unroll
    for (int i = 0; i < 8; ++i) { const float* p = t.W + (size_t)(k0 + 8 * i + 2 * rg) * t.N + nn;
        R.v0[i] = ok ? *(const f32x4*)p : (f32x4){0.f, 0.f, 0.f, 0.f}; R.v1[i] = ok ? *(const f32x4*)(p + t.N) : (f32x4){0.f, 0.f, 0.f, 0.f}; }
}
__device__ __forceinline__ void titem_store(const TItem& t, const TRegs& R, float* scrf, int lane) {
    unsigned* scr = (unsigned*)scrf;
    const int nblk = (t.N + 63) / 64, kb = t.item / nblk, nb = t.item % nblk, k0 = 64 * kb, n0 = 64 * nb;
    const int rg = lane >> 4, c4 = lane & 15;
#pragma unroll
    for (int i = 0; i < 8; ++i) { unsigned* q = scr + (4 * i + rg) * 66 + 4 * c4;
        q[0] = pkh(R.v0[i].x, R.v1[i].x); q[1] = pkh(R.v0[i].y, R.v1[i].y); q[2] = pkh(R.v0[i].z, R.v1[i].z); q[3] = pkh(R.v0[i].w, R.v1[i].w); }
    LDS_FENCE();
    const int c = lane & 7;
#pragma unroll
    for (int j = 0; j < 8; ++j) { const int n = (lane >> 3) + 8 * j; const unsigned* s = scr + (4 * c) * 66 + n;
        u32x4 o; o.x = s[0]; o.y = s[66]; o.z = s[132]; o.w = s[198];
        *(u32x4*)(t.WT + (size_t)(n0 + n) * t.pitch + k0 + 8 * c) = o; }
    LDS_FENCE();
}
__device__ __forceinline__ int t5_bucket(int d) {
    if (d < 16) return d;
    const float logd = logf((float)d / 16.0f);
    int far = 16 + (int)(logd / 4.852030263919617f * 16.0f);
    return far < 31 ? far : 31;
}
__device__ __forceinline__ void rms_row_to_bf16(const float* xrow, const float* gain, bf16* orow, int lane) {
    const f32x4* xr = (const f32x4*)xrow + lane; const f32x4* gr = (const f32x4*)gain + lane;
    f32x4 v[8]; float s = 0.f;
#pragma unroll
    for (int j = 0; j < 8; ++j) { v[j] = xr[64 * j]; s += (v[j].x * v[j].x + v[j].y * v[j].y) + (v[j].z * v[j].z + v[j].w * v[j].w); }
    const float r = 1.0f / sqrtf(wave_sum(s) * (1.0f / DM) + 1e-6f);
    u32x2* o8 = (u32x2*)orow + lane;
#pragma unroll
    for (int j = 0; j < 8; ++j) { const f32x4 g = gr[64 * j]; u32x2 w; w.x = pk2(v[j].x * r * g.x, v[j].y * r * g.y); w.y = pk2(v[j].z * r * g.z, v[j].w * r * g.w); o8[64 * j] = w; }
}
__device__ __forceinline__ void rowpass_row(const float* xi, const bf16* y, const float* gp, const float* gn, float* xo, bf16* h, int lane) {
    const u32x2* yr = (const u32x2*)y + lane; const f32x4* xr = (const f32x4*)xi + lane; const f32x4* gpr = (const f32x4*)gp + lane;
    f32x4 v[8]; float s = 0.f;
#pragma unroll
    for (int j = 0; j < 8; ++j) { const u32x2 w = yr[64 * j]; v[j].x = bf_lo(w.x); v[j].y = bf_hi(w.x); v[j].z = bf_lo(w.y); v[j].w = bf_hi(w.y); s += (v[j].x * v[j].x + v[j].y * v[j].y) + (v[j].z * v[j].z + v[j].w * v[j].w); }
    const float r = 1.0f / sqrtf(wave_sum(s) * (1.0f / DM) + 1e-6f);
    float s2 = 0.f;
#pragma unroll
    for (int j = 0; j < 8; ++j) { const f32x4 g = gpr[64 * j]; const f32x4 x = xr[64 * j]; v[j] = x + v[j] * r * g; s2 += (v[j].x * v[j].x + v[j].y * v[j].y) + (v[j].z * v[j].z + v[j].w * v[j].w); }
    f32x4* xw = (f32x4*)xo + lane;
#pragma unroll
    for (int j = 0; j < 8; ++j) xw[64 * j] = v[j];
    if (gn) {
        const float r2 = 1.0f / sqrtf(wave_sum(s2) * (1.0f / DM) + 1e-6f);
        const f32x4* gnr = (const f32x4*)gn + lane; u32x2* o8 = (u32x2*)h + lane;
#pragma unroll
        for (int j = 0; j < 8; ++j) { const f32x4 g = gnr[64 * j]; u32x2 w; w.x = pk2(v[j].x * r2 * g.x, v[j].y * r2 * g.y); w.y = pk2(v[j].z * r2 * g.z, v[j].w * r2 * g.w); o8[64 * j] = w; }
    }
}

constexpr int IT_IN = 32 * 245, IT_A = 8 * 32, IT_B = 16 * 32, IT_C = 16 * 32, IT_OUT = 32 * 32, IT_UP = 32 * 128, IT_DOWN = 128 * 32;
constexpr int IT_W1 = 32 * 4, IT_W2 = 4 * 1;
constexpr int IT_LAYER = IT_IN + IT_A + IT_B + IT_C + IT_OUT + IT_UP + IT_DOWN + 2 * IT_W1 + 2 * IT_W2;

__device__ __forceinline__ TItem decode_item(const PT a, unsigned char* ws, int it) {
    const int l = it / IT_LAYER; int r = it % IT_LAYER;
    unsigned char* wl = ws + WS_WT + (size_t)l * LAYER_W; unsigned char* cw = ws + WS_CW + (size_t)l * 4 * MiB;
    TItem t;
    if (r < IT_IN) { t.W = a.in(2) + (size_t)l * DM * NIN; t.K = DM; t.N = NIN; t.WT = (bf16*)(wl + WO_IN); t.item = r; t.pitch = t.K; return t; } r -= IT_IN;
    if (r < IT_A) { t.W = a.in(11) + (size_t)l * 512 * DM; t.K = 512; t.N = DM; t.WT = (bf16*)(wl + WO_A); t.item = r; t.pitch = 2560; return t; } r -= IT_A;
    if (r < IT_B) { t.W = a.in(12) + (size_t)l * 1024 * DM; t.K = 1024; t.N = DM; t.WT = (bf16*)(wl + WO_A) + 512; t.item = r; t.pitch = 2560; return t; } r -= IT_B;
    if (r < IT_C) { t.W = a.in(13) + (size_t)l * 1024 * DM; t.K = 1024; t.N = DM; t.WT = (bf16*)(wl + WO_A) + 1536; t.item = r; t.pitch = 2560; return t; } r -= IT_C;
    if (r < IT_OUT) { t.W = a.in(14) + (size_t)l * DM * DM; t.K = DM; t.N = DM; t.WT = (bf16*)(wl + WO_OUT); t.item = r; t.pitch = t.K; return t; } r -= IT_OUT;
    if (r < IT_UP) { t.W = a.in(19) + (size_t)l * DM * DFF; t.K = DM; t.N = DFF; t.WT = (bf16*)(wl + WO_UP); t.item = r; t.pitch = t.K; return t; } r -= IT_UP;
    if (r < IT_DOWN) { t.W = a.in(20) + (size_t)l * DFF * DM; t.K = DFF; t.N = DM; t.WT = (bf16*)(wl + WO_DOWN); t.item = r; t.pitch = t.K; return t; } r -= IT_DOWN;
    if (r < IT_W1) { t.W = a.in(5) + (size_t)l * 2048 * 256; t.K = 2048; t.N = 256; t.WT = (bf16*)cw; t.item = r; t.pitch = t.K; return t; } r -= IT_W1;
    if (r < IT_W1) { t.W = a.in(7) + (size_t)l * 2048 * 256; t.K = 2048; t.N = 256; t.WT = (bf16*)(cw + MiB); t.item = r; t.pitch = t.K; return t; } r -= IT_W1;
    if (r < IT_W2) { t.W = a.in(6) + (size_t)l * 256 * 64; t.K = 256; t.N = 64; t.WT = (bf16*)(cw + 2 * MiB); t.item = r; t.pitch = t.K; return t; } r -= IT_W2;
    t.W = a.in(8) + (size_t)l * 256 * 64; t.K = 256; t.N = 64; t.WT = (bf16*)(cw + 2 * MiB + 65536); t.item = r; t.pitch = t.K; return t;
}
__device__ __forceinline__ void phase_prologue(const PT a, float* ldsf, int lane, int wave, int gw, int ngw) {
    float* scr = ldsf + wave * 4096;
    unsigned char* ws = a.ws();
    constexpr int NIT = DEPTH * IT_LAYER;
    if (gw < NIT) {
        int it = gw; TItem cur = decode_item(a, ws, it); TRegs R; titem_load(cur, R, lane);
        for (;;) {
            const int nx = it + ngw; const bool more = nx < NIT;
            TItem nxt = cur; TRegs R2 = R;
            if (more) { nxt = decode_item(a, ws, nx); titem_load(nxt, R2, lane); }
            titem_store(cur, R, scr, lane);
            if (!more) break;
            cur = nxt; R = R2; it = nx;
        }
    }
    float* biasT = (float*)(ws + WS_BIAST);
    for (int i = gw * 64 + lane; i < 48 * BT; i += ngw * 64) { const int col = i / BT, d = i % BT; biasT[i] = a.in(1)[t5_bucket(d) * 48 + col]; }
    for (int m = gw; m < M; m += ngw) rms_row_to_bf16(a.in(0) + (size_t)m * DM, a.in(15), (bf16*)(ws + WS_H) + (size_t)m * DM, lane);
}

struct EpiAny { static constexpr bool PERM = true, AFTER_DRAIN = false, KHOOK = true;
    int mode; bf16* ob; float* of; const bf16* proj;
    __device__ __forceinline__ bool khook_at(int t) const { return mode == 6 && (t == 8 || t == 24); }
    __device__ __forceinline__ void khook(pg8::f32x4 (&acc)[2][2][4][2], const pg8::Unit& u, int t, int wr, int wc, int fr, int fq) const {
        const int step = (t == 8) ? 0 : 1;
        { int tl = (int)threadIdx.x; asm volatile("" : "+v"(tl)); fr = tl & 15; fq = (tl >> 4) & 3; }
#pragma unroll
        for (int ai = 0; ai < 2; ++ai) {
                u32x2 zc[16], zn[16];
#pragma unroll
                for (int q = 0; q < 16; ++q) { const int m = q >> 2, bj = (q >> 1) & 1, n = q & 1;
                    const int row = u.pm * 256 + ai * 128 + wr * 64 + m * 16 + fr, col = u.pn * 256 + bj * 128 + wc * 32 + 8 * fq + 4 * n;
                    const bf16* gp = proj + (size_t)row * NP + OFF_MG + step * DM + col; zc[q] = *(const u32x2*)gp; zn[q] = *(const u32x2*)(gp + DM); }
#pragma unroll
                for (int q = 0; q < 16; ++q) { const int m = q >> 2, bj = (q >> 1) & 1, n = q & 1;
                    pg8::f32x4 t0 = acc[ai][bj][m][n];
                    t0[0] *= (1.f + __expf(-bf_lo(zn[q].x))) * __builtin_amdgcn_rcpf(1.f + __expf(-bf_lo(zc[q].x))); t0[1] *= (1.f + __expf(-bf_hi(zn[q].x))) * __builtin_amdgcn_rcpf(1.f + __expf(-bf_hi(zc[q].x)));
                    t0[2] *= (1.f + __expf(-bf_lo(zn[q].y))) * __builtin_amdgcn_rcpf(1.f + __expf(-bf_lo(zc[q].y))); t0[3] *= (1.f + __expf(-bf_hi(zn[q].y))) * __builtin_amdgcn_rcpf(1.f + __expf(-bf_hi(zc[q].y)));
                    acc[ai][bj][m][n] = t0; }
                asm volatile("" ::: "memory"); }
    }
    template <int MODE> __device__ __forceinline__ void run(const pg8::f32x4 (&acc)[2][2][4][2], const pg8::Unit& u, int wr, int wc, int fr, int fq) const {
        constexpr int LDC = (MODE == 0) ? NP : (MODE == 5 ? DFF : DM);
        { int tl = (int)threadIdx.x; asm volatile("" : "+v"(tl)); fr = tl & 15; fq = (tl >> 4) & 3; }
#pragma unroll
        for (int ai = 0; ai < 2; ++ai)
#pragma unroll
            for (int mp = 0; mp < 2; ++mp) {
                u32x4 gpre[4];
                if constexpr (MODE == 6) {
#pragma unroll
                    for (int q = 0; q < 4; ++q) { const int m = 2 * mp + (q >> 1), bj = q & 1; const int row = u.pm * 256 + ai * 128 + wr * 64 + m * 16 + fr, col = u.pn * 256 + bj * 128 + wc * 32 + 8 * fq;
                        gpre[q] = *(const u32x4*)(proj + (size_t)row * NP + OFF_MG + 2 * DM + col); }
                }
#pragma unroll
                for (int q = 0; q < 4; ++q) { const int m = 2 * mp + (q >> 1), bj = q & 1; const int row = u.pm * 256 + ai * 128 + wr * 64 + m * 16 + fr, col = u.pn * 256 + bj * 128 + wc * 32 + 8 * fq;
                    const pg8::f32x4 t0 = acc[ai][bj][m][0], t1 = acc[ai][bj][m][1];
                    float v[8] = {t0[0], t0[1], t0[2], t0[3], t1[0], t1[1], t1[2], t1[3]};
                    if constexpr (MODE == 5) {
#pragma unroll
                        for (int e = 0; e < 8; ++e) { const float r = fmaxf(v[e], 0.f); v[e] = r * r; }
                    }
                    if constexpr (MODE == 6) { const u32x4 g = gpre[q];
                        v[0] *= sigmoidf_(bf_lo(g.x)); v[1] *= sigmoidf_(bf_hi(g.x)); v[2] *= sigmoidf_(bf_lo(g.y)); v[3] *= sigmoidf_(bf_hi(g.y));
                        v[4] *= sigmoidf_(bf_lo(g.z)); v[5] *= sigmoidf_(bf_hi(g.z)); v[6] *= sigmoidf_(bf_lo(g.w)); v[7] *= sigmoidf_(bf_hi(g.w)); }
                    u32x4 w; w.x = pkh(v[0], v[1]); w.y = pkh(v[2], v[3]); w.z = pkh(v[4], v[5]); w.w = pkh(v[6], v[7]);
                    *(u32x4*)(ob + (size_t)row * LDC + col) = w; }
                asm volatile("" ::: "memory"); }
    }
    __device__ __forceinline__ void operator()(const pg8::f32x4 (&acc)[2][2][4][2], const pg8::Unit& u, int wr, int wc, int fr, int fq) const {
        if (mode == 0) run<0>(acc, u, wr, wc, fr, fq);
        else if (mode == 4) run<4>(acc, u, wr, wc, fr, fq);
        else if (mode == 5) run<5>(acc, u, wr, wc, fr, fq);
        else run<6>(acc, u, wr, wc, fr, fq);
    } };


constexpr int KCAT = 2560;
typedef short bf16x8 __attribute__((ext_vector_type(8)));
typedef short bf16x4 __attribute__((ext_vector_type(4)));
typedef float f32x16 __attribute__((ext_vector_type(16)));
#define MFMA32(a, b, c) __builtin_amdgcn_mfma_f32_32x32x16_bf16(a, b, c, 0, 0, 0)

template <int KW, int NDS> struct KVRegs { u32x4 k[KW / 64]; u32x4 v[NDS / 2]; };

template <int KW, int NDS> __device__ __forceinline__ void load_tile(KVRegs<KW, NDS>& R, const bf16* base_b, int tok0, int tstride, int kcol, int vcol, int tid) {
#pragma unroll
    for (int r = 0; r < KW / 64; ++r) { const int idx = tid + 512 * r, key = idx / (KW / 8), ch = idx % (KW / 8);
        R.k[r] = *(const u32x4*)(base_b + (size_t)(tok0 + key * tstride) * NP + kcol + ch * 8); }
#pragma unroll
    for (int r = 0; r < NDS / 2; ++r) { const int idx = tid + 512 * r, key = idx & 63, ch = idx >> 6;
        R.v[r] = *(const u32x4*)(base_b + (size_t)(tok0 + key * tstride) * NP + vcol + ch * 8); }
}
template <int KW, int NDS> __device__ __forceinline__ void store_tile(const KVRegs<KW, NDS>& R, bf16* Ks, bf16* Vt, int tid) {
#pragma unroll
    for (int r = 0; r < KW / 64; ++r) { const int idx = tid + 512 * r, key = idx / (KW / 8), ch = idx % (KW / 8);
        *(u32x4*)(Ks + key * (KW + 8) + ch * 8) = R.k[r]; }
#pragma unroll
    for (int r = 0; r < NDS / 2; ++r) { const int idx = tid + 512 * r, key = idx & 63, ch = idx >> 6; const u32x4 w = R.v[r]; bf16* p = Vt + (ch * 8) * 68 + key;
        p[0 * 68] = (bf16)(w.x & 0xffffu); p[1 * 68] = (bf16)(w.x >> 16); p[2 * 68] = (bf16)(w.y & 0xffffu); p[3 * 68] = (bf16)(w.y >> 16);
        p[4 * 68] = (bf16)(w.z & 0xffffu); p[5 * 68] = (bf16)(w.z >> 16); p[6 * 68] = (bf16)(w.w & 0xffffu); p[7 * 68] = (bf16)(w.w >> 16); }
}
constexpr float LOG2E = 1.4426950408889634f;
constexpr float QSCALE2 = 0.125f * LOG2E;
__device__ __forceinline__ void load_qfrag(const bf16* qrow, int hi, bf16x8 (&qf)[4], float sc) {
    u32x4 w0 = *(const u32x4*)(qrow + 0 * 16 + hi * 8), w1 = *(const u32x4*)(qrow + 1 * 16 + hi * 8), w2 = *(const u32x4*)(qrow + 2 * 16 + hi * 8), w3 = *(const u32x4*)(qrow + 3 * 16 + hi * 8);
    asm volatile("" : "+v"(w0), "+v"(w1), "+v"(w2), "+v"(w3));
    const u32x4 wv[4] = {w0, w1, w2, w3};
#pragma unroll
    for (int c = 0; c < 4; ++c) { const u32x4 w = wv[c]; u32x4 o;
        o.x = pkh(bf_lo(w.x) * sc, bf_hi(w.x) * sc); o.y = pkh(bf_lo(w.y) * sc, bf_hi(w.y) * sc);
        o.z = pkh(bf_lo(w.z) * sc, bf_hi(w.z) * sc); o.w = pkh(bf_lo(w.w) * sc, bf_hi(w.w) * sc);
        qf[c] = __builtin_bit_cast(bf16x8, o); }
}
template <int KP, int NDS> __device__ __forceinline__ void attn_tile(const bf16x8 (&qf)[4], const bf16* Ks, const bf16* Vt, float& m, float& l, f32x16 (&O)[NDS],
                                                                       const float* tab, int dq, int maxd, bool tile_ok, int pmode, float cb, int l32, int hi) {
    f32x16 s0, s1;
#pragma unroll
    for (int i = 0; i < 16; ++i) { s0[i] = 0.f; s1[i] = 0.f; }
#pragma unroll
    for (int c = 0; c < 4; ++c) { const bf16x8 a0 = *(const bf16x8*)(Ks + l32 * KP + c * 16 + hi * 8); const bf16x8 a1 = *(const bf16x8*)(Ks + (32 + l32) * KP + c * 16 + hi * 8);
        s0 = MFMA32(a0, qf[c], s0); s1 = MFMA32(a1, qf[c], s1); }
    float mx = -1e30f, sub;
    if (pmode == 2) {
#pragma unroll
        for (int i = 0; i < 16; ++i) mx = fmaxf(mx, fmaxf(s0[i], s1[i]));
        mx = fmaxf(mx, __shfl_xor(mx, 32)) + cb;
    } else if (pmode == 1) {
        const float* tp = tab + (dq - 4 * hi);
#pragma unroll
        for (int h4 = 0; h4 < 4; ++h4) { float bb[4];
#pragma unroll
            for (int j = 0; j < 4; ++j) bb[j] = tp[-(h4 * 8 + j)];
#pragma unroll
            for (int j = 0; j < 4; ++j) { const int i = 4 * h4 + j; s0[i] = tile_ok ? s0[i] + bb[j] : -INFINITY; mx = fmaxf(mx, s0[i]); } }
#pragma unroll
        for (int h4 = 0; h4 < 4; ++h4) { float bb[4];
#pragma unroll
            for (int j = 0; j < 4; ++j) bb[j] = tp[-(32 + h4 * 8 + j)];
#pragma unroll
            for (int j = 0; j < 4; ++j) { const int i = 4 * h4 + j; s1[i] = tile_ok ? s1[i] + bb[j] : -INFINITY; mx = fmaxf(mx, s1[i]); } }
        mx = fmaxf(mx, __shfl_xor(mx, 32));
    } else {
        const int dq4 = dq - 4 * hi, cl = maxd < 2047 ? maxd : 2047;
#pragma unroll
        for (int h4 = 0; h4 < 4; ++h4) { float bb[4];
#pragma unroll
            for (int j = 0; j < 4; ++j) { const int d0 = dq4 - (h4 * 8 + j); bb[j] = tab[d0 < 0 ? 0 : (d0 > cl ? cl : d0)]; }
#pragma unroll
            for (int j = 0; j < 4; ++j) { const int i = 4 * h4 + j; const int d0 = dq4 - (h4 * 8 + j); const bool v0 = tile_ok && (unsigned)d0 <= (unsigned)maxd;
                s0[i] = v0 ? s0[i] + bb[j] : -INFINITY; mx = fmaxf(mx, s0[i]); } }
#pragma unroll
        for (int h4 = 0; h4 < 4; ++h4) { float bb[4];
#pragma unroll
            for (int j = 0; j < 4; ++j) { const int d1 = dq4 - 32 - (h4 * 8 + j); bb[j] = tab[d1 < 0 ? 0 : (d1 > cl ? cl : d1)]; }
#pragma unroll
            for (int j = 0; j < 4; ++j) { const int i = 4 * h4 + j; const int d1 = dq4 - 32 - (h4 * 8 + j); const bool v1 = tile_ok && (unsigned)d1 <= (unsigned)maxd;
                s1[i] = v1 ? s1[i] + bb[j] : -INFINITY; mx = fmaxf(mx, s1[i]); } }
        mx = fmaxf(mx, __shfl_xor(mx, 32));
    }
    const float mn = fmaxf(m, mx), alpha = __builtin_amdgcn_exp2f(m - mn);
    const bool resc = __any(mn != m);
    m = mn; sub = (pmode == 2) ? mn - cb : mn;
    s0 = s0 - sub; s1 = s1 - sub;
#pragma unroll
    for (int i = 0; i < 16; ++i) { s0[i] = __builtin_amdgcn_exp2f(s0[i]); s1[i] = __builtin_amdgcn_exp2f(s1[i]); }
    const f32x16 ss = s0 + s1;
    const float rs = ((ss[0] + ss[1]) + (ss[2] + ss[3])) + ((ss[4] + ss[5]) + (ss[6] + ss[7])) + (((ss[8] + ss[9]) + (ss[10] + ss[11])) + ((ss[12] + ss[13]) + (ss[14] + ss[15])));
    l = l * alpha + rs;
    if (resc) {
#pragma unroll
        for (int ds = 0; ds < NDS; ++ds)
#pragma unroll
            for (int i = 0; i < 16; ++i) O[ds][i] *= alpha;
    }
#pragma unroll
    for (int c = 0; c < 4; ++c) {
        u32x4 pw;
        if (c == 0) { pw.x = pkh(s0[0], s0[1]); pw.y = pkh(s0[2], s0[3]); pw.z = pkh(s0[4], s0[5]); pw.w = pkh(s0[6], s0[7]); }
        else if (c == 1) { pw.x = pkh(s0[8], s0[9]); pw.y = pkh(s0[10], s0[11]); pw.z = pkh(s0[12], s0[13]); pw.w = pkh(s0[14], s0[15]); }
        else if (c == 2) { pw.x = pkh(s1[0], s1[1]); pw.y = pkh(s1[2], s1[3]); pw.z = pkh(s1[4], s1[5]); pw.w = pkh(s1[6], s1[7]); }
        else { pw.x = pkh(s1[8], s1[9]); pw.y = pkh(s1[10], s1[11]); pw.z = pkh(s1[12], s1[13]); pw.w = pkh(s1[14], s1[15]); }
        const bf16x8 pb = __builtin_bit_cast(bf16x8, pw);
#pragma unroll
        for (int ds = 0; ds < NDS; ++ds) { const bf16* vp = Vt + (ds * 32 + l32) * 68 + 16 * c + 4 * hi;
            const u32x2 lo = *(const u32x2*)vp, hi2 = *(const u32x2*)(vp + 8); u32x4 vw; vw.x = lo.x; vw.y = lo.y; vw.z = hi2.x; vw.w = hi2.y;
            O[ds] = MFMA32(__builtin_bit_cast(bf16x8, vw), pb, O[ds]); }
    }
}
template <int KW, int NDS, int SLOT, bool TWO> __device__ __forceinline__ void attn_pass(unsigned tmask, const bf16* base_b, int tok_base, int tstride, int kcol, int vcol, bf16* Ks, bf16* Vt, int kofs,
        const bf16x8 (&qf)[4], float& m, float& l, f32x16 (&O)[NDS], const float* tab, const unsigned char* bk, int iq, int maxd, unsigned okbits, int wave_maxq, int wave_lo, int tid, int l32, int hi) {
    if (!tmask) return;
    KVRegs<KW, NDS> Ra, Rb; int ja = __builtin_ctz(tmask), jb = -1; tmask &= tmask - 1;
    if (TWO && tmask) { jb = __builtin_ctz(tmask); tmask &= tmask - 1; }
    load_tile<KW, NDS>(Ra, base_b, tok_base + ja * 64 * tstride, tstride, kcol, vcol, tid);
    if (TWO && jb >= 0) load_tile<KW, NDS>(Rb, base_b, tok_base + jb * 64 * tstride, tstride, kcol, vcol, tid);
    for (;;) {
        __syncthreads(); store_tile<KW, NDS>(Ra, Ks, Vt, tid); if (TWO && jb >= 0) store_tile<KW, NDS>(Rb, Ks + SLOT, Vt + SLOT, tid); __syncthreads();
        const int ca = ja, cb = jb; const bool more = tmask != 0u;
        if (more) { ja = __builtin_ctz(tmask); tmask &= tmask - 1; jb = -1; if (TWO && tmask) { jb = __builtin_ctz(tmask); tmask &= tmask - 1; }
            load_tile<KW, NDS>(Ra, base_b, tok_base + ja * 64 * tstride, tstride, kcol, vcol, tid);
            if (TWO && jb >= 0) load_tile<KW, NDS>(Rb, base_b, tok_base + jb * 64 * tstride, tstride, kcol, vcol, tid); }
#pragma unroll 1
        for (int s = 0; s < (TWO ? 2 : 1); ++s) { const int c = s ? cb : ca;
            if (c >= 0 && c * 64 <= wave_maxq && c * 64 + 63 >= wave_lo) {
                const bool tok = ((okbits >> c) & 1u) != 0u;
                int pmode = 0; float cbias = 0.f;
                if (bk) { const int dmin = wave_maxq - 31 - c * 64 - 63, dmax = wave_maxq - c * 64;
                    if (dmin >= 0 && dmax <= maxd && dmax <= 2047) { pmode = 1; if (__all(tok) && bk[dmin] == bk[dmax]) { pmode = 2; cbias = tab[dmin]; } } }
                attn_tile<KW + 8, NDS>(qf, Ks + s * SLOT + kofs, Vt + s * SLOT, m, l, O, tab, iq - c * 64, maxd, tok, pmode, cbias, l32, hi); } }
        if (!more) break;
    }
}
__device__ __forceinline__ unsigned range_mask(int lo, int hi_incl) { const unsigned up = (hi_incl >= 31) ? 0xffffffffu : ((1u << (hi_incl + 1)) - 1u); return up & ~((1u << lo) - 1u); }

__device__ __forceinline__ void cmp_unit(const PT a, unsigned char* ldsb, unsigned* selL, int b, int g, int qt, int tid, int lane, int wave) {
    unsigned char* ws = a.ws(); const bf16* proj = (const bf16*)(ws + WS_PROJ);
    const float* kc = (const float*)(ws + WS_KC); const float* vc = (const float*)(ws + WS_VC); float* ocmp = (float*)(ws + WS_OCMP);
    bf16* Khi = (bf16*)ldsb; bf16* Klo = (bf16*)(ldsb + 18432); bf16* Vt = (bf16*)(ldsb + 104448); float* SC = (float*)ldsb;
    const int l32 = lane & 31, hi = lane >> 5;
    __syncthreads();
    {
        const int hh = g * 8 + wave, t0 = qt * 32, tq = t0 + l32, tok = b * SEQ + tq;
        {
            const int n = tid >> 2, seg = tid & 3;
            const f32x4* kp = (const f32x4*)(kc + (size_t)((b * NCMP + (n < NCMP ? n : 0)) * 2 + g) * 64 + seg * 16);
            u32x4 h0, h1, l0, l1; f32x4 x[4];
#pragma unroll
            for (int e = 0; e < 4; ++e) { x[e] = kp[e]; if (n >= NCMP) x[e] = (f32x4){0.f, 0.f, 0.f, 0.f}; }
            unsigned hw[8], lw[8];
#pragma unroll
            for (int e = 0; e < 4; ++e) { const unsigned a0 = f2bf(x[e].x), a1 = f2bf(x[e].y), a2 = f2bf(x[e].z), a3 = f2bf(x[e].w);
                hw[2 * e] = a0 | (a1 << 16); hw[2 * e + 1] = a2 | (a3 << 16);
                lw[2 * e] = pk2(x[e].x - __uint_as_float(a0 << 16), x[e].y - __uint_as_float(a1 << 16)); lw[2 * e + 1] = pk2(x[e].z - __uint_as_float(a2 << 16), x[e].w - __uint_as_float(a3 << 16)); }
            h0.x = hw[0]; h0.y = hw[1]; h0.z = hw[2]; h0.w = hw[3]; h1.x = hw[4]; h1.y = hw[5]; h1.z = hw[6]; h1.w = hw[7];
            l0.x = lw[0]; l0.y = lw[1]; l0.z = lw[2]; l0.w = lw[3]; l1.x = lw[4]; l1.y = lw[5]; l1.z = lw[6]; l1.w = lw[7];
            *(u32x4*)(Khi + n * 72 + seg * 16) = h0; *(u32x4*)(Khi + n * 72 + seg * 16 + 8) = h1;
            *(u32x4*)(Klo + n * 72 + seg * 16) = l0; *(u32x4*)(Klo + n * 72 + seg * 16 + 8) = l1;
            const int nv_ = tid & 127, dseg = tid >> 7;
            const f32x4* vp = (const f32x4*)(vc + (size_t)((b * NCMP + (nv_ < NCMP ? nv_ : 0)) * 2 + g) * 64 + dseg * 16);
#pragma unroll
            for (int e = 0; e < 4; ++e) { f32x4 v = vp[e]; if (nv_ >= NCMP) v = (f32x4){0.f, 0.f, 0.f, 0.f}; bf16* p = Vt + (dseg * 16 + e * 4) * 136 + nv_;
                p[0] = (bf16)f2bf(v.x); p[136] = (bf16)f2bf(v.y); p[272] = (bf16)f2bf(v.z); p[408] = (bf16)f2bf(v.w); }
        }
        bf16x8 qf[4]; load_qfrag(proj + (size_t)tok * NP + OFF_BQ + hh * 64, hi, qf, 0.125f);
        __syncthreads();
        f32x16 s[4];
#pragma unroll
        for (int st = 0; st < 4; ++st) {
#pragma unroll
            for (int i = 0; i < 16; ++i) s[st][i] = 0.f;
#pragma unroll
            for (int c = 0; c < 4; ++c) { const bf16x8 ah = *(const bf16x8*)(Khi + (st * 32 + l32) * 72 + c * 16 + hi * 8); const bf16x8 al = *(const bf16x8*)(Klo + (st * 32 + l32) * 72 + c * 16 + hi * 8);
                s[st] = MFMA32(ah, qf[c], s[st]); s[st] = MFMA32(al, qf[c], s[st]); }
        }
        int nvq = tq >= 31 ? (tq - 31) / 16 + 1 : 0; nvq = nvq < NCMP ? nvq : NCMP;
        float mx = -1e30f;
#pragma unroll
        for (int st = 0; st < 4; ++st)
#pragma unroll
            for (int i = 0; i < 16; ++i) { const int n = 32 * st + (i >> 2) * 8 + 4 * hi + (i & 3); if (n < nvq) mx = fmaxf(mx, s[st][i]); }
        mx = fmaxf(mx, __shfl_xor(mx, 32));
        float rs = 0.f;
#pragma unroll
        for (int st = 0; st < 4; ++st)
#pragma unroll
            for (int i = 0; i < 16; ++i) { const int n = 32 * st + (i >> 2) * 8 + 4 * hi + (i & 3); const float e = (n < nvq) ? __expf(s[st][i] - mx) : 0.f; s[st][i] = e; rs += e; }
        rs += __shfl_xor(rs, 32);
        const float inv = nvq > 0 ? 1.0f / rs : 0.f;
#pragma unroll
        for (int st = 0; st < 4; ++st)
#pragma unroll
            for (int i = 0; i < 16; ++i) s[st][i] *= inv;
        f32x16 O[2];
#pragma unroll
        for (int ds = 0; ds < 2; ++ds)
#pragma unroll
            for (int i = 0; i < 16; ++i) O[ds][i] = 0.f;
#pragma unroll
        for (int st = 0; st < 4; ++st)
#pragma unroll
            for (int c2 = 0; c2 < 2; ++c2) { const int c = 2 * st + c2; u32x4 pw;
                pw.x = pk2(s[st][8 * c2 + 0], s[st][8 * c2 + 1]); pw.y = pk2(s[st][8 * c2 + 2], s[st][8 * c2 + 3]); pw.z = pk2(s[st][8 * c2 + 4], s[st][8 * c2 + 5]); pw.w = pk2(s[st][8 * c2 + 6], s[st][8 * c2 + 7]);
                const bf16x8 pb = __builtin_bit_cast(bf16x8, pw);
#pragma unroll
                for (int ds = 0; ds < 2; ++ds) { const bf16* vp = Vt + (ds * 32 + l32) * 136 + 16 * c + 4 * hi;
                    const u32x2 lo = *(const u32x2*)vp, hi2 = *(const u32x2*)(vp + 8); u32x4 vw; vw.x = lo.x; vw.y = lo.y; vw.z = hi2.x; vw.w = hi2.y;
                    O[ds] = MFMA32(__builtin_bit_cast(bf16x8, vw), pb, O[ds]); } }
#pragma unroll
        for (int ds = 0; ds < 2; ++ds)
#pragma unroll
            for (int i4 = 0; i4 < 4; ++i4) { f32x4 v; v.x = O[ds][i4 * 4 + 0]; v.y = O[ds][i4 * 4 + 1]; v.z = O[ds][i4 * 4 + 2]; v.w = O[ds][i4 * 4 + 3];
                *(f32x4*)(ocmp + (size_t)tok * 1024 + hh * 64 + ds * 32 + i4 * 8 + 4 * hi) = v; }
        __syncthreads();
        {
            float prev_other = 0.f;
#pragma unroll
            for (int st = 0; st < 4; ++st)
#pragma unroll
                for (int i4 = 0; i4 < 4; ++i4) {
                    const float gs = (s[st][4 * i4] + s[st][4 * i4 + 1]) + (s[st][4 * i4 + 2] + s[st][4 * i4 + 3]);
                    const float other = __shfl_xor(s[st][4 * i4 + 3], 32);
                    const float c = gs + (hi ? other : prev_other);
                    prev_other = other;
                    SC[(wave * 32 + l32) * 33 + 8 * st + 2 * i4 + hi] = c;
                }
        }
        __syncthreads();
#pragma unroll 1
        for (int ps = 0; ps < 2; ++ps) {
            const int q = 4 * wave + 2 * ps + hi, j = l32, t = t0 + q, cur = t >> 6;
            float sc = 0.f;
#pragma unroll
            for (int w = 0; w < 8; ++w) sc += SC[(w * 32 + q) * 33 + j];
            if (j == 0 || cur - j == 0 || cur - j == 1) sc = 1e6f;
            if (j > cur) sc = -1e30f;
            int rank = 0;
#pragma unroll 1
            for (int i = 0; i < 32; ++i) { const float si = __shfl(sc, (lane & 32) + i); rank += (si > sc || (si == sc && i < j)) ? 1 : 0; }
            const bool sel = (rank < 16) && (j <= cur);
            const unsigned long long bal = __ballot(sel);
            if (l32 == 0) selL[q] = hi ? (unsigned)(bal >> 32) : (unsigned)bal;
        }
        __syncthreads();
    }
}


__device__ __forceinline__ void phase_nsa_mfma(const PT a, unsigned char* ldsb, int tid, int lane, int wave, int bid, int nblk) {
    unsigned char* ws = a.ws(); const bf16* proj = (const bf16*)(ws + WS_PROJ); const float* biasT = (const float*)(ws + WS_BIAST);
    const float* ocmp = (const float*)(ws + WS_OCMP); bf16* ob = (bf16*)(ws + WS_OA);
    bf16* Ks = (bf16*)ldsb; bf16* Vt = (bf16*)(ldsb + 9216); float* tabs = (float*)(ldsb + 36864); unsigned char* bk = ldsb + 102400; unsigned* selL = (unsigned*)(ldsb + 121856);
    int gcur = -1;
    __syncthreads();
    for (int u = bid; u < 512; u += nblk) {
        const int bg = u & 7, b = bg >> 1, g = bg & 1, qt = u < 256 ? 63 - (u >> 3) : ((u - 256) >> 3);
        if (g != gcur) { __syncthreads();
            for (int i = tid; i < 8 * 2048; i += 512) tabs[i] = biasT[(24 + g * 8 + (i >> 11)) * BT + (i & 2047)] * LOG2E; for (int i = tid; i < 2048; i += 512) bk[i] = (unsigned char)t5_bucket(i); gcur = g; }
        const int hh = g * 8 + wave, t0 = qt * 32;
        const bf16* base_b = proj + (size_t)b * SEQ * NP;
        cmp_unit(a, ldsb, selL, b, g, qt, tid, lane, wave);
        asm volatile("" : "+v"(lane), "+v"(tid) :: "memory");
        const int l32 = lane & 31, hi = lane >> 5, tq = t0 + l32, tok = b * SEQ + tq;
        bf16x8 qf[4]; load_qfrag(proj + (size_t)tok * NP + OFF_BQ + hh * 64, hi, qf, QSCALE2);
        const unsigned mq = selL[l32];
        unsigned un = mq;
#pragma unroll
        for (int o = 1; o < 32; o <<= 1) un |= (unsigned)__shfl_xor((int)un, o);
        un = (unsigned)__builtin_amdgcn_readfirstlane((int)un);
        const float* tab = tabs + wave * 2048;
        f32x16 Os[2], Ow[2]; float m = -1e30f, l = 0.f;
#pragma unroll
        for (int ds = 0; ds < 2; ++ds)
#pragma unroll
            for (int i = 0; i < 16; ++i) { Os[ds][i] = 0.f; Ow[ds][i] = 0.f; }
        attn_pass<64, 2, 8960, true>(un, base_b, 0, 1, OFF_BKV + (4 + g) * 64, OFF_BKV + (6 + g) * 64, Ks, Vt, 0, qf, m, l, Os, tab, bk, tq, 1 << 20, mq, t0 + 31, -(1 << 20), tid, l32, hi);
        const float isel = 1.0f / (l + __shfl_xor(l, 32));
        m = -1e30f; l = 0.f;
        const int wlo = (t0 - 511 > 0 ? t0 - 511 : 0) >> 6, whi = (t0 + 31) >> 6;
        attn_pass<64, 2, 8960, true>(range_mask(wlo, whi), base_b, 0, 1, OFF_BKV + (8 + g) * 64, OFF_BKV + (10 + g) * 64, Ks, Vt, 0, qf, m, l, Ow, tab, bk, tq, 511, 0xffffffffu, t0 + 31, -(1 << 20), tid, l32, hi);
        const float iwin = 1.0f / (l + __shfl_xor(l, 32));
        const bf16* gp = proj + (size_t)tok * NP + OFF_BG + hh * 3;
        const float g0 = sigmoidf_(bf2f(gp[0])), g1 = sigmoidf_(bf2f(gp[1])) * isel, g2 = sigmoidf_(bf2f(gp[2])) * iwin;
#pragma unroll
        for (int ds = 0; ds < 2; ++ds)
#pragma unroll
            for (int i4 = 0; i4 < 4; ++i4) { const int d = ds * 32 + i4 * 8 + 4 * hi; const size_t off = (size_t)tok * 1024 + hh * 64 + d;
                const f32x4 oc = *(const f32x4*)(ocmp + off);
                const float r0 = g0 * oc.x + g1 * Os[ds][i4 * 4 + 0] + g2 * Ow[ds][i4 * 4 + 0], r1 = g0 * oc.y + g1 * Os[ds][i4 * 4 + 1] + g2 * Ow[ds][i4 * 4 + 1];
                const float r2 = g0 * oc.z + g1 * Os[ds][i4 * 4 + 2] + g2 * Ow[ds][i4 * 4 + 2], r3 = g0 * oc.w + g1 * Os[ds][i4 * 4 + 3] + g2 * Ow[ds][i4 * 4 + 3];
                u32x2 w; w.x = pk2(r0, r1); w.y = pk2(r2, r3); *(u32x2*)(ob + (size_t)tok * KCAT + 512 + hh * 64 + d) = w; }
    }
    __syncthreads();
}

__device__ __forceinline__ void phase_diff_mfma(const PT a, int lyr, unsigned char* ldsb, int tid, int lane, int wave, int bid, int nblk) {
    unsigned char* ws = a.ws(); const bf16* proj = (const bf16*)(ws + WS_PROJ); const float* biasT = (const float*)(ws + WS_BIAST); bf16* oc = (bf16*)(ws + WS_OA);
    const float* lv = a.in(9) + (size_t)lyr * 256; const float* sg = a.in(10) + (size_t)lyr * 128;
    const float lam_init = 0.8f - 0.6f * expf(-0.3f * (float)lyr);
    const float lam = expf(wave_sum(lv[lane] * lv[64 + lane])) - expf(wave_sum(lv[128 + lane] * lv[192 + lane])) + lam_init;
    bf16* Ks = (bf16*)ldsb; bf16* Vt = (bf16*)(ldsb + 17408); float* tab = (float*)(ldsb + 69632); unsigned char* bk = ldsb + 77824; float* O2 = (float*)ldsb;
    const int l32 = lane & 31, hi = lane >> 5, mp = wave >> 2, wq = wave & 3;
    int hcur = -1;
    __syncthreads();
    for (int u = bid; u < 512; u += nblk) {
        const int bh = u & 31, b = bh >> 3, h = bh & 7, qt = u < 256 ? 15 - (u >> 5) : ((u - 256) >> 5);
        if (h != hcur) { __syncthreads(); for (int i = tid; i < 2048; i += 512) { tab[i] = biasT[(40 + h) * BT + i] * LOG2E; bk[i] = (unsigned char)t5_bucket(i); } hcur = h; }
        const int t0 = qt * 128, tq = t0 + wq * 32 + l32, tok = b * SEQ + tq;
        const bf16* base_b = proj + (size_t)b * SEQ * NP;
        bf16x8 qf[4]; load_qfrag(proj + (size_t)tok * NP + OFF_CQ + (h * 2 + mp) * 64, hi, qf, QSCALE2);
        f32x16 O[4]; float m = -1e30f, l = 0.f;
#pragma unroll
        for (int ds = 0; ds < 4; ++ds)
#pragma unroll
            for (int i = 0; i < 16; ++i) O[ds][i] = 0.f;
        attn_pass<128, 4, 17408, false>(range_mask(0, (t0 + 127) >> 6), base_b, 0, 1, OFF_CK + h * 128, OFF_CV + h * 128, Ks, Vt, mp * 64, qf, m, l, O, tab, bk, tq, 1 << 20, 0xffffffffu, t0 + wq * 32 + 31, -(1 << 20), tid, l32, hi);
        const float inv = 1.0f / (l + __shfl_xor(l, 32));
        __syncthreads();
        if (mp == 1) {
#pragma unroll
            for (int ds = 0; ds < 4; ++ds)
#pragma unroll
                for (int i = 0; i < 16; ++i) O2[(ds * 16 + i) * 256 + wq * 64 + lane] = O[ds][i] * inv;
        }
        __syncthreads();
        if (mp == 0) {
            float ss = 0.f;
#pragma unroll
            for (int ds = 0; ds < 4; ++ds)
#pragma unroll
                for (int i = 0; i < 16; ++i) { const float o = O[ds][i] * inv - lam * O2[(ds * 16 + i) * 256 + wq * 64 + lane]; O[ds][i] = o; ss += o * o; }
            ss += __shfl_xor(ss, 32);
            const float r = (1.0f - lam_init) / sqrtf(ss * (1.0f / 128.0f) + 1e-6f);
#pragma unroll
            for (int ds = 0; ds < 4; ++ds)
#pragma unroll
                for (int i4 = 0; i4 < 4; ++i4) { const int d = ds * 32 + i4 * 8 + 4 * hi; const f32x4 gn = *(const f32x4*)(sg + d);
                    u32x2 w; w.x = pk2(O[ds][i4 * 4 + 0] * r * gn.x, O[ds][i4 * 4 + 1] * r * gn.y); w.y = pk2(O[ds][i4 * 4 + 2] * r * gn.z, O[ds][i4 * 4 + 3] * r * gn.w);
                    *(u32x2*)(oc + (size_t)tok * KCAT + 1536 + h * 128 + d) = w; }
        }
        __syncthreads();
    }
}


constexpr size_t WS_OAG = WS_MIXF, WS_LSE = WS_MIXB;
__device__ __forceinline__ void phase_dilated_mfma(const PT a, unsigned char* ldsb, int tid, int lane, int wave, int bid, int nblk) {
    unsigned char* ws = a.ws(); const bf16* proj = (const bf16*)(ws + WS_PROJ); const float* biasT = (const float*)(ws + WS_BIAST);
    float* oag = (float*)(ws + WS_OAG); float* lseb = (float*)(ws + WS_LSE);
    bf16* Ks = (bf16*)ldsb; bf16* Vt = (bf16*)(ldsb + 9216); float* tab = (float*)(ldsb + 36864);
    const int l32 = lane & 31, hi = lane >> 5;
    const int nh = (nblk > 64) ? nblk - 64 : nblk, hb = (nblk > 64) ? bid - 64 : bid;
    const int n_heavy_mine = (hb >= 0) ? (512 - hb + nh - 1) / nh : 0;
    const int n_light_mine = (512 - bid + nblk - 1) / nblk;
    for (int it = 0; it < n_heavy_mine + n_light_mine; ++it) {
        const int u = it < n_heavy_mine ? hb + it * nh : 512 + bid + (it - n_heavy_mine) * nblk;
        int g, b, h, r, i0, nq;
        if (u < 256) { g = 0; b = u >> 6; h = (u >> 3) & 7; r = 0; i0 = (u & 7) * 256; nq = 256; }
        else if (u < 512) { const int v = u - 256; g = 1; b = v >> 6; h = (v >> 3) & 7; r = (v >> 1) & 3; i0 = (v & 1) * 256; nq = 256; }
        else { const int v = u - 512; g = 2; b = v >> 7; h = (v >> 4) & 7; r = v & 15; i0 = 0; nq = 128; }
        const int dil = 1 << (2 * g);
        __syncthreads();
        if (tid < 129) tab[tid] = biasT[(g * 8 + h) * BT + tid * dil] * LOG2E;
        const bool act = wave * 32 < nq;
        const int iq = i0 + ((wave * 32) % nq) + l32, tok = b * SEQ + r + dil * iq;
        const bf16* base_b = proj + (size_t)b * SEQ * NP;
        bf16x8 qf[4]; load_qfrag(proj + (size_t)tok * NP + (g * 8 + h) * 64, hi, qf, QSCALE2);
        f32x16 O[2]; float m = -1e30f, l = 0.f;
#pragma unroll
        for (int ds = 0; ds < 2; ++ds)
#pragma unroll
            for (int i = 0; i < 16; ++i) O[ds][i] = 0.f;
        const int wq0 = i0 + wave * 32;
        attn_pass<64, 2, 8960, true>(range_mask((i0 - 128 > 0 ? i0 - 128 : 0) >> 6, (i0 + nq - 1) >> 6), base_b, r, dil, ((3 + g) * 8 + h) * 64, ((6 + g) * 8 + h) * 64, Ks, Vt, 0, qf, m, l, O, tab, (const unsigned char*)nullptr, iq, 128, 0xffffffffu,
                         act ? wq0 + 31 : -1, wq0 - 128, tid, l32, hi);
        if (act) {
            const float lt = l + __shfl_xor(l, 32), inv = 1.0f / lt;
            float* op = oag + ((size_t)g * M + tok) * 512 + h * 64;
#pragma unroll
            for (int ds = 0; ds < 2; ++ds)
#pragma unroll
                for (int i4 = 0; i4 < 4; ++i4) { f32x4 v; v.x = O[ds][i4 * 4 + 0] * inv; v.y = O[ds][i4 * 4 + 1] * inv; v.z = O[ds][i4 * 4 + 2] * inv; v.w = O[ds][i4 * 4 + 3] * inv;
                    *(f32x4*)(op + ds * 32 + i4 * 8 + 4 * hi) = v; }
            if (hi == 0) lseb[((size_t)g * M + tok) * 8 + h] = (m + __log2f(lt)) * 0.6931471805599453f;
        }
    }
    __syncthreads();
}
__device__ __forceinline__ void phase_dil_combine(const PT a, int lane, int gw, int ngw) {
    unsigned char* ws = a.ws(); const float* oag = (const float*)(ws + WS_OAG); const float* lseb = (const float*)(ws + WS_LSE); bf16* oa = (bf16*)(ws + WS_OA);
    for (int tok = gw; tok < M; tok += ngw) {
        const int h = lane >> 3;
        const float l0 = lseb[((size_t)0 * M + tok) * 8 + h], l1 = lseb[((size_t)1 * M + tok) * 8 + h], l2 = lseb[((size_t)2 * M + tok) * 8 + h];
        const float mx = fmaxf(l0, fmaxf(l1, l2)); float w0 = __expf(l0 - mx), w1 = __expf(l1 - mx), w2 = __expf(l2 - mx); const float iw = 1.0f / (w0 + w1 + w2); w0 *= iw; w1 *= iw; w2 *= iw;
        const f32x4* p0 = (const f32x4*)(oag + ((size_t)0 * M + tok) * 512 + lane * 8); const f32x4* p1 = (const f32x4*)(oag + ((size_t)1 * M + tok) * 512 + lane * 8); const f32x4* p2 = (const f32x4*)(oag + ((size_t)2 * M + tok) * 512 + lane * 8);
        const f32x4 x0 = w0 * p0[0] + w1 * p1[0] + w2 * p2[0], x1 = w0 * p0[1] + w1 * p1[1] + w2 * p2[1];
        u32x4 o; o.x = pk2(x0.x, x0.y); o.y = pk2(x0.z, x0.w); o.z = pk2(x1.x, x1.y); o.w = pk2(x1.z, x1.w);
        *(u32x4*)(oa + (size_t)tok * KCAT + lane * 8) = o;
    }
}


__device__ __forceinline__ void phase_compress_mfma(const PT a, int lyr, unsigned char* ldsb, int tid, int lane, int wave, int bid, int nblk) {
    unsigned char* ws = a.ws(); const bf16* proj = (const bf16*)(ws + WS_PROJ);
    unsigned char* cw = ws + WS_CW + (size_t)lyr * 4 * MiB;
    bf16* Ab = (bf16*)ldsb; float* RED = (float*)(ldsb + 17408);
    const int l32 = lane & 31, hi = lane >> 5;
    __syncthreads();
    for (int u = bid; u < 64; u += nblk) {
        const int kv = u >> 5, rg = u & 31;
        const bf16* W1t = (const bf16*)(cw + (size_t)kv * MiB); const bf16* W2t = (const bf16*)(cw + 2 * MiB + (size_t)kv * 65536);
        const float* pos = a.in(3 + kv) + (size_t)lyr * 2048; float* dst = (float*)(ws + (kv ? WS_VC : WS_KC));
        f32x16 acc;
#pragma unroll
        for (int i = 0; i < 16; ++i) acc[i] = 0.f;
        const bf16* wrow = W1t + (size_t)(32 * wave + l32) * 2048 + hi * 8;
#pragma unroll 1
        for (int kc = 0; kc < 8; ++kc) {
            bf16x8 af[16];
#pragma unroll
            for (int kk = 0; kk < 16; ++kk) af[kk] = *(const bf16x8*)(wrow + kc * 256 + kk * 16);
            __syncthreads();
#pragma unroll
            for (int r2 = 0; r2 < 2; ++r2) { const int idx = tid + 512 * r2, row = idx >> 5, ch = idx & 31; int r = rg * 32 + row; r = r < 1016 ? r : 1015;
                const int g = r & 1, bn = r >> 1, b = bn / NCMP, n = bn % NCMP, ll = kc * 4 + (ch >> 3), d = (ch & 7) * 8;
                const u32x4 w = *(const u32x4*)(proj + (size_t)(b * SEQ + 16 * n + ll) * NP + OFF_BKV + (kv * 2 + g) * 64 + d);
                const f32x4 p0 = *(const f32x4*)(pos + ll * 64 + d), p1 = *(const f32x4*)(pos + ll * 64 + d + 4);
                u32x4 o; o.x = pk2(bf_lo(w.x) + p0.x, bf_hi(w.x) + p0.y); o.y = pk2(bf_lo(w.y) + p0.z, bf_hi(w.y) + p0.w); o.z = pk2(bf_lo(w.z) + p1.x, bf_hi(w.z) + p1.y); o.w = pk2(bf_lo(w.w) + p1.z, bf_hi(w.w) + p1.w);
                *(u32x4*)(Ab + row * 264 + ch * 8) = o; }
            __syncthreads();
#pragma unroll
            for (int kk = 0; kk < 16; ++kk) { const bf16x8 bfr = *(const bf16x8*)(Ab + l32 * 264 + kk * 16 + hi * 8); acc = MFMA32(af[kk], bfr, acc); }
        }
#pragma unroll
        for (int i = 0; i < 16; ++i) { const float v = acc[i]; acc[i] = 0.5f * v * (1.0f + tanhf(0.7978845608028654f * (v + 0.044715f * v * v * v))); }
        f32x16 o2[2];
#pragma unroll
        for (int ds = 0; ds < 2; ++ds)
#pragma unroll
            for (int i = 0; i < 16; ++i) o2[ds][i] = 0.f;
#pragma unroll
        for (int c2 = 0; c2 < 2; ++c2) { u32x4 pw; pw.x = pk2(acc[8 * c2 + 0], acc[8 * c2 + 1]); pw.y = pk2(acc[8 * c2 + 2], acc[8 * c2 + 3]); pw.z = pk2(acc[8 * c2 + 4], acc[8 * c2 + 5]); pw.w = pk2(acc[8 * c2 + 6], acc[8 * c2 + 7]);
            const bf16x8 hb = __builtin_bit_cast(bf16x8, pw);
#pragma unroll
            for (int ds = 0; ds < 2; ++ds) { const bf16* wp = W2t + (size_t)(ds * 32 + l32) * 256 + 32 * wave + 16 * c2 + 4 * hi;
                const u32x2 lo = *(const u32x2*)wp, hi2 = *(const u32x2*)(wp + 8); u32x4 vw; vw.x = lo.x; vw.y = lo.y; vw.z = hi2.x; vw.w = hi2.y;
                o2[ds] = MFMA32(__builtin_bit_cast(bf16x8, vw), hb, o2[ds]); } }
#pragma unroll
        for (int ds = 0; ds < 2; ++ds)
#pragma unroll
            for (int i = 0; i < 16; ++i) RED[(wave * 64 + ds * 32 + (i >> 2) * 8 + 4 * hi + (i & 3)) * 33 + l32] = o2[ds][i];
        __syncthreads();
#pragma unroll
        for (int e = 0; e < 4; ++e) { const int idx = tid + 512 * e, d = idx & 63, row = idx >> 6; float s = 0.f;
#pragma unroll
            for (int w = 0; w < 8; ++w) s += RED[(w * 64 + d) * 33 + row];
            const int r = rg * 32 + row; if (r < 1016) dst[(size_t)r * 64 + d] = s; }
        __syncthreads();
    }
}

#define XB_TMO      128
#define XB_XCNT(j)  (256  + 64 * (j))
#define XB_XSUB(j)  (1280 + 64 * (j))
#define XB_XGEN(j)  (2304 + 64 * (j))
#define XB_TOP      3328
#define XB_TOPGEN   3392
#define XCD_BAR_WORDS 3456
#define XB_SPIN_CAP (1u << 18)

__device__ __forceinline__ unsigned xb_ld(unsigned* p)              { return __hip_atomic_load(p, __ATOMIC_RELAXED, __HIP_MEMORY_SCOPE_AGENT); }
__device__ __forceinline__ unsigned xb_add(unsigned* p, unsigned v) { return __hip_atomic_fetch_add(p, v, __ATOMIC_RELAXED, __HIP_MEMORY_SCOPE_AGENT); }
__device__ __forceinline__ unsigned xb_xcc_id() { return (unsigned)__builtin_amdgcn_s_getreg((3 << 11) | 20) & 0xFu; }
#define XB_SPIN(cond, bar) do { unsigned _sp = 0; while (cond) { __builtin_amdgcn_s_sleep(1); \
    if ((++_sp & 255u) == 0u) { if (xb_ld(&(bar)[XB_TMO])) break; if (_sp > XB_SPIN_CAP) { atomicAdd(&(bar)[XB_TMO], 1u); break; } } } } while (0)

struct XcdBarrier {
    unsigned* bar; unsigned x;
    volatile LAS unsigned* st;
};

__device__ __forceinline__ XcdBarrier xcd_barrier_post(unsigned* bar, volatile LAS unsigned* st) {
    XcdBarrier b; b.bar = bar; b.x = xb_xcc_id(); b.st = st;
    if (threadIdx.x == 0) (void)xb_add(&bar[XB_XCNT(b.x)], 1u);
    return b;
}
__device__ __forceinline__ void xcd_barrier_complete(unsigned* bar, unsigned x, unsigned& nloc, unsigned& nx) {
    const unsigned G = gridDim.x * gridDim.y * gridDim.z;
    unsigned sum, cnt, mine, sp = 0u;
    for (;;) {
        sum = 0u; cnt = 0u; mine = 0u;
#pragma unroll
        for (unsigned j = 0; j < 16; ++j) { const unsigned c = xb_ld(&bar[XB_XCNT(j)]); sum += c; cnt += (c > 0u) ? 1u : 0u; mine = (j == x) ? c : mine; }
        if (sum == G) break;
        __builtin_amdgcn_s_sleep(1);
        if ((++sp & 255u) == 0u) { if (xb_ld(&bar[XB_TMO])) break; if (sp > XB_SPIN_CAP) { atomicAdd(&bar[XB_TMO], 1u); break; } }
    }
    nloc = mine > 0u ? mine : 1u; nx = cnt > 0u ? cnt : 1u;
}

__device__ __forceinline__ void xcd_barrier(const XcdBarrier& b) {
    asm volatile("s_waitcnt vmcnt(0)" ::: "memory");
    __syncthreads();
    if (threadIdx.x == 0) {
        unsigned* bar = b.bar;
        __builtin_amdgcn_s_waitcnt(0);
        unsigned nloc = b.st[0], nx = b.st[1];
        if (nloc == 0u) { xcd_barrier_complete(bar, b.x, nloc, nx); b.st[0] = nloc; b.st[1] = nx; }
        const unsigned old = xb_add(&bar[XB_XSUB(b.x)], 1u);
        const unsigned gen = old / nloc;
        if (old + 1u == (gen + 1u) * nloc) {
            __builtin_amdgcn_fence(__ATOMIC_RELEASE, "agent");
            asm volatile("s_waitcnt vmcnt(0)" ::: "memory");
            const unsigned og = xb_add(&bar[XB_TOP], 1u);
            const unsigned tg = og / nx;
            if (og + 1u == (tg + 1u) * nx) xb_add(&bar[XB_TOPGEN], 1u);
            else XB_SPIN(xb_ld(&bar[XB_TOPGEN]) == tg, bar);
            __builtin_amdgcn_fence(__ATOMIC_ACQUIRE, "agent");
            xb_add(&bar[XB_XGEN(b.x)], 1u);
            asm volatile("s_waitcnt vmcnt(0)" ::: "memory");
        } else {
            XB_SPIN(xb_ld(&bar[XB_XGEN(b.x)]) == gen, bar);
            __builtin_amdgcn_fence(__ATOMIC_ACQUIRE, "agent");
            asm volatile("s_waitcnt vmcnt(0)" ::: "memory");
        }
    }
    __syncthreads();
}

__global__ void __launch_bounds__(512, 2) mega_fwd(Args ka) {
    extern __shared__ __attribute__((aligned(16))) unsigned char lds[];
    LAS unsigned char* ldsl = (LAS unsigned char*)lds;
    const int tid0 = threadIdx.x;
    {
        unsigned long long* pt = (unsigned long long*)(lds + PTAB_OFF);
        if (tid0 < 21) pt[tid0] = (unsigned long long)ka.in[tid0];
        if (tid0 == 21) pt[21] = (unsigned long long)ka.out;
        if (tid0 == 22) pt[22] = (unsigned long long)ka.ws;
        if (tid0 == 23) { pt[32] = 0ull; }
        __syncthreads();
    }
    const int ph_lo = ka.ph_lo, ph_hi = ka.ph_hi;
    cg::grid_group grid = cg::this_grid();
    (void)xcd_barrier_post((unsigned*)(__attribute__((address_space(1))) unsigned*)(ka.ws + WS_BAR), (volatile LAS unsigned*)(ldsl + PTAB_OFF + 256));
    for (int ph = ph_lo; ph < ph_hi; ++ph) {
        unsigned ldso0 = 0; asm volatile("" : "+s"(ldso0));
        const PT a{(const unsigned long long*)(lds + PTAB_OFF + ldso0)};
        if (ph == 0) { int tidp = tid0; asm volatile("" : "+v"(tidp)); const int lanep = tidp & 63, wavep = __builtin_amdgcn_readfirstlane(tidp >> 6);
            phase_prologue(a, (float*)(lds + ldso0), lanep, wavep, (int)blockIdx.x * 8 + wavep, (int)gridDim.x * 8); }
        else {
            const int l = (ph - 1) / PH_PER_LAYER; int k = (ph - 1) % PH_PER_LAYER; if (k >= 2) k += 1;
            unsigned char* ws = a.ws();
            unsigned char* wl = ws + WS_WT + (size_t)l * LAYER_W;
            bf16* H = (bf16*)(ws + WS_H); bf16* proj = (bf16*)(ws + WS_PROJ);
            int njobs = 0, mode0 = 0, N = 0, K = 0; const bf16* A0 = nullptr; const bf16* B0 = nullptr; bf16* ob = nullptr; float* of = nullptr;
            if (k == 0) { njobs = 1; mode0 = 0; A0 = H; B0 = (const bf16*)(wl + WO_IN); N = NP; K = DM; ob = proj; }
            else if (k == 4) { njobs = 1; mode0 = 6; A0 = (const bf16*)(ws + WS_OA); B0 = (const bf16*)(wl + WO_A); N = DM; K = KCAT; ob = (bf16*)(ws + WS_MIXB); }
            else if (k == 5) { njobs = 1; mode0 = 4; A0 = (const bf16*)(ws + WS_MIXB); B0 = (const bf16*)(wl + WO_OUT); N = DM; K = DM; ob = (bf16*)(ws + WS_Y); }
            else if (k == 7) { njobs = 1; mode0 = 5; A0 = H; B0 = (const bf16*)(wl + WO_UP); N = DFF; K = DM; ob = (bf16*)(ws + WS_U); }
            else if (k == 8) { njobs = 1; mode0 = 4; A0 = (const bf16*)(ws + WS_U); B0 = (const bf16*)(wl + WO_DOWN); N = DM; K = DFF; ob = (bf16*)(ws + WS_Y); }
            for (int j = 0; j < njobs; ++j) {
                const bf16* A = A0; const bf16* B = B0; int Kj = K;
                pg8::Gemm g{A, B, M, N, Kj}; pg8::StaticOrder S; S.init(M, N, (int)gridDim.x, (int)blockIdx.x);
                EpiAny E{mode0 + j, ob, of, proj};
                pg8::gemm_phase<EpiAny, pg8::StaticOrder, true, true>(ldsl, g, S, E);
            }
            int tid = tid0; asm volatile("" : "+v"(tid));
            int bid = (int)blockIdx.x, nblk = (int)gridDim.x; asm volatile("" : "+s"(bid), "+s"(nblk));
            unsigned ldso = 0; asm volatile("" : "+s"(ldso));
            float* ldsf = (float*)(lds + ldso);
            const int lane = tid & 63, wave = __builtin_amdgcn_readfirstlane(tid >> 6);
            const int gw = bid * 8 + wave, ngw = nblk * 8;
            if (k == 1) {
                for (int rep = 0; rep < ((PROBE_SUB & 1) ? 2 : 1); ++rep) { asm volatile("" : "+v"(tid), "+s"(bid)); phase_compress_mfma(a, l, (unsigned char*)ldsf, tid, tid & 63, __builtin_amdgcn_readfirstlane(tid >> 6), bid, nblk); }
                for (int rep = 0; rep < ((PROBE_SUB & 2) ? 2 : 1); ++rep) { asm volatile("" : "+v"(tid), "+s"(bid)); phase_dilated_mfma(a, (unsigned char*)ldsf, tid, tid & 63, __builtin_amdgcn_readfirstlane(tid >> 6), bid, nblk); }
                for (int rep = 0; rep < ((PROBE_SUB & 4) ? 2 : 1); ++rep) { asm volatile("" : "+v"(tid), "+s"(bid)); phase_diff_mfma(a, l, (unsigned char*)ldsf, tid, tid & 63, __builtin_amdgcn_readfirstlane(tid >> 6), bid, nblk); } }
            else if (k == 3) { phase_dil_combine(a, lane, gw, ngw); phase_nsa_mfma(a, (unsigned char*)ldsf, tid, lane, wave, bid, nblk); }
            else if (k == 6) { float* xo = a.out(); const float* xi = (l == 0) ? a.in(0) : xo;
                for (int m = gw; m < M; m += ngw) rowpass_row(xi + (size_t)m * DM, (const bf16*)(ws + WS_Y) + (size_t)m * DM, a.in(16) + (size_t)l * DM, a.in(17) + (size_t)l * DM, xo + (size_t)m * DM, H + (size_t)m * DM, lane); }
            else if (k == 9) { float* xo = a.out(); const float* gn = (l + 1 < DEPTH) ? a.in(15) + (size_t)(l + 1) * DM : nullptr;
                for (int m = gw; m < M; m += ngw) rowpass_row(xo + (size_t)m * DM, (const bf16*)(ws + WS_Y) + (size_t)m * DM, a.in(18) + (size_t)l * DM, gn, xo + (size_t)m * DM, H + (size_t)m * DM, lane); }
        }
        if (ph + 1 < ph_hi) { XcdBarrier xbar; xbar.bar = (unsigned*)(a.ws() + WS_BAR); xbar.x = xb_xcc_id(); xbar.st = (volatile LAS unsigned*)(ldsl + PTAB_OFF + 256); xcd_barrier(xbar); }
        if (ph_hi > 100000) grid.sync();
    }
}

#ifndef N_LAUNCH_SPLIT
#define N_LAUNCH_SPLIT 0
#endif
extern "C" void kernel_launch(void* const* d_in, const int* in_sizes, int n_in, void* d_out, int out_size, void* d_ws, size_t ws_size, hipStream_t stream) {
    static int grid = 0;
    if (grid == 0) {
        if (n_in != 21 || out_size != M * DM || ws_size < WS_END) { fprintf(stderr, "kernel_launch: unexpected shapes (n_in %d out %d ws %zu)\n", n_in, out_size, ws_size); grid = -1; return; }
        int dev = 0, cus = 0, per_cu = 0;
        (void)hipGetDevice(&dev); (void)hipDeviceGetAttribute(&cus, hipDeviceAttributeMultiprocessorCount, dev);
        if (hipFuncSetAttribute((const void*)mega_fwd, hipFuncAttributeMaxDynamicSharedMemorySize, LDS_BYTES) != hipSuccess) { fprintf(stderr, "hipFuncSetAttribute failed\n"); grid = -1; return; }
        if (hipOccupancyMaxActiveBlocksPerMultiprocessor(&per_cu, (const void*)mega_fwd, 512, LDS_BYTES) != hipSuccess || per_cu < 1) { fprintf(stderr, "occupancy query: %d\n", per_cu); per_cu = 1; }
        (void)hipGetLastError();
        grid = cus > 0 ? cus : 256;
    }
    if (grid < 0) return;
    if (hipMemsetAsync((char*)d_ws + WS_BAR, 0, 16384, stream) != hipSuccess) { fprintf(stderr, "kernel_launch: memset of the barrier words failed\n"); return; }
    Args a{};
    for (int i = 0; i < 21; ++i) a.in[i] = (const float*)d_in[i];
    a.out = (float*)d_out; a.ws = (unsigned char*)d_ws;
#if N_LAUNCH_SPLIT
    for (int ph = 0; ph < NPH; ++ph) { a.ph_lo = ph; a.ph_hi = ph + 1; hipLaunchKernelGGL(mega_fwd, dim3(grid), dim3(512), LDS_BYTES, stream, a); }
#else
    a.ph_lo = 0; a.ph_hi = NPH;
    void* args[] = {&a};
    hipError_t e = hipLaunchCooperativeKernel((const void*)mega_fwd, dim3(grid), dim3(512), args, LDS_BYTES, stream);
    if (e != hipSuccess) fprintf(stderr, "cooperative launch failed: %s (grid %d)\n", hipGetErrorString(e), grid);
#endif
}
```

```cpp
#include <hip/hip_runtime.h>
#include <hip/hip_cooperative_groups.h>
#include <cstdio>
#include <cstdint>
namespace cg = cooperative_groups;
namespace pg8 {
#define PG8_LAS __attribute__((address_space(3)))
typedef unsigned short bf16_t;
typedef short bf16x8 __attribute__((ext_vector_type(8)));
typedef float f32x4 __attribute__((ext_vector_type(4)));
typedef unsigned u32x4 __attribute__((ext_vector_type(4)));
constexpr int BM = 256, BK = 64, HALF = 128, HTB = HALF * BK * 2  , STAGE_BYTES = 8 * HTB, NXCD = 8, WGM = 8;

__host__ __device__ __forceinline__ int lds_byte(int r, int c) { const int st = (r >> 4) * 2 + (c >> 5), rr = r & 15, cc = c & 31, ob = rr * 64 + cc * 2; return st * 1024 + (ob ^ (((ob >> 9) & 1) << 5)); }
__host__ __device__ __forceinline__ void stage_rc(int b, int& R, int& C) { const int st = b / 1024, sb = b % 1024, swz = sb ^ (((sb >> 9) & 1) << 5); R = (st >> 1) * 16 + swz / 64; C = (st & 1) * 32 + (swz % 64) / 2; }
__host__ __device__ __forceinline__ int perm32(int rho) { const int n = rho >> 4, i = rho & 15; return 8 * (i >> 2) + 4 * n + (i & 3); }

struct Unit { int pm, pn; };
struct Gemm { const bf16_t* A; const bf16_t* Bt; int M, N, K; };

struct StaticOrder {
    int nM, nN, nwg, G, c;
    __host__ __device__ void init(int M, int N, int G_, int c_) { nM = M / BM; nN = N / BM; nwg = nM * nN; G = G_; c = c_; }
    __host__ __device__ bool next(int i, Unit& u) const {
        const long L = (long)i * G + c; if (L >= nwg) return false;
        int wgid = (int)L; { const int q = nwg / NXCD, r = nwg % NXCD, xcd = wgid % NXCD, off = wgid / NXCD; wgid = (xcd < r ? xcd * (q + 1) : r * (q + 1) + (xcd - r) * q) + off; }
        const int nig = WGM * nN, gid = wgid / nig, fm = gid * WGM, gsz = (nM - fm) < WGM ? (nM - fm) : WGM;
        u.pm = fm + ((wgid % nig) % gsz); u.pn = (wgid % nig) / gsz; return true;
    }
    __device__ __forceinline__ void a_ready(const Unit&) const {}
    __device__ __forceinline__ void done(const Unit&) const {}
};

__device__ __forceinline__ unsigned cvt_pk_bf16(float lo, float hi) { unsigned r; asm volatile("v_cvt_pk_bf16_f32 %0, %1, %2" : "=v"(r) : "v"(lo), "v"(hi)); return r; }
typedef float f32x2 __attribute__((ext_vector_type(2)));
template <class Epi, class Sched, bool ALIGN_EPI = false, bool SP2 = false>
__device__ __forceinline__ void gemm_phase(PG8_LAS unsigned char* lds, const Gemm g, const Sched& S, const Epi& E) {
    const int tid = threadIdx.x, wid = __builtin_amdgcn_readfirstlane(tid >> 6), lane = tid & 63, wr = wid >> 2, wc = wid & 3, fr = lane & 15, fq = lane >> 4;
    const int K = g.K, nt = K / BK;
    unsigned voffA[2], voffB[2];
#pragma unroll
    for (int i = 0; i < 2; ++i) { int R, C; stage_rc(tid * 16 + i * 8192, R, C); const int Rb = Epi::PERM ? ((R & ~31) + perm32(R & 31)) : R;
        voffA[i] = (unsigned)(R * K + C) * 2u; voffB[i] = (unsigned)(Rb * K + C) * 2u; }
    const size_t kstep = (size_t)(BK * 2);
    const size_t hstep = (size_t)HALF * K * 2;
    const size_t tstep = 2 * hstep;
    const unsigned ldsw = (unsigned)wid * 1024u;
    const int aoff = lds_byte(wr * 64 + fr, fq * 8), boff = lds_byte(wc * 32 + fr, fq * 8);
#define PG8_SA(b, h) (((b) * 2 + (h)) * HTB)
#define PG8_SB(b, h) ((4 + (b) * 2 + (h)) * HTB)
#define PG8_STAGE(bufoff, gbase, voff) do { _Pragma("unroll") for (int _i = 0; _i < 2; ++_i) \
        __builtin_amdgcn_global_load_lds((const unsigned*)((const char*)(gbase) + (voff)[_i]), (PG8_LAS unsigned*)(lds + (bufoff) + ldsw + _i * 8192), 16, 0, 0); } while (0)
#define PG8_LDA(dst, b, h) do { _Pragma("unroll") for (int m = 0; m < 4; ++m) _Pragma("unroll") for (int k = 0; k < 2; ++k) dst[m][k] = *(const PG8_LAS bf16x8*)(lds + PG8_SA(b, h) + aoff + m * 2048 + k * 1024); } while (0)
#define PG8_LDB(dst, b, h) do { _Pragma("unroll") for (int n = 0; n < 2; ++n) _Pragma("unroll") for (int k = 0; k < 2; ++k) dst[n][k] = *(const PG8_LAS bf16x8*)(lds + PG8_SB(b, h) + boff + n * 2048 + k * 1024); } while (0)
#define PG8_MMA(ai, bj, At, Bt) do { __builtin_amdgcn_s_setprio(1); _Pragma("unroll") for (int m = 0; m < 4; ++m) _Pragma("unroll") for (int n = 0; n < 2; ++n) _Pragma("unroll") for (int k = 0; k < 2; ++k) \
        acc[ai][bj][m][n] = __builtin_amdgcn_mfma_f32_16x16x32_bf16(Bt[n][k], At[m][k], acc[ai][bj][m][n], 0, 0, 0); __builtin_amdgcn_s_setprio(0); } while (0)
#define PG8_WAIT_V(n) asm volatile("s_waitcnt vmcnt(" #n ")" ::: "memory")
#define PG8_WAIT_L(n) asm volatile("s_waitcnt lgkmcnt(" #n ")" ::: "memory")
#define PG8_BAR __builtin_amdgcn_s_barrier()
#define PG8_SCHED __builtin_amdgcn_sched_barrier(0)
    Unit cur, nxt; int ui = 0;
    if (!S.next(0, cur)) return;
    f32x4 acc[2][2][4][2];
#pragma unroll
    for (int a = 0; a < 2; ++a)
#pragma unroll
        for (int b = 0; b < 2; ++b)
#pragma unroll
            for (int m = 0; m < 4; ++m)
#pragma unroll
                for (int n = 0; n < 2; ++n) acc[a][b][m][n] = (f32x4){0.f, 0.f, 0.f, 0.f};
    bf16x8 At[4][2], B0[2][2], B1[2][2];
    const char* cA = (const char*)g.A + (size_t)cur.pm * tstep; const char* cB = (const char*)g.Bt + (size_t)cur.pn * tstep;
    S.a_ready(cur);
    if constexpr (SP2) {
        PG8_STAGE(PG8_SB(0, 0), cB, voffB); PG8_STAGE(PG8_SB(0, 1), cB + hstep, voffB); PG8_STAGE(PG8_SA(0, 0), cA, voffA); PG8_STAGE(PG8_SA(0, 1), cA + hstep, voffA);
        if (wr == 1) PG8_BAR;
        PG8_WAIT_V(2); PG8_BAR;
        PG8_STAGE(PG8_SB(1, 0), cB + kstep, voffB); PG8_STAGE(PG8_SA(1, 0), cA + kstep, voffA); PG8_STAGE(PG8_SB(1, 1), cB + hstep + kstep, voffB);
        PG8_WAIT_V(6); PG8_BAR;
    } else {
        PG8_STAGE(PG8_SB(0, 0), cB, voffB); PG8_STAGE(PG8_SA(0, 0), cA, voffA); PG8_STAGE(PG8_SB(0, 1), cB + hstep, voffB); PG8_STAGE(PG8_SA(0, 1), cA + hstep, voffA);
        if (wr == 1) PG8_BAR;
        PG8_WAIT_V(4); PG8_BAR;
        PG8_STAGE(PG8_SB(1, 0), cB + kstep, voffB); PG8_STAGE(PG8_SA(1, 0), cA + kstep, voffA); PG8_STAGE(PG8_SB(1, 1), cB + hstep + kstep, voffB);
        PG8_WAIT_V(6); PG8_BAR;
    }
    for (;;) {
        const bool has_next = S.next(ui + 1, nxt);
        const char* nA = has_next ? (const char*)g.A + (size_t)nxt.pm * tstep : cA; const char* nB = has_next ? (const char*)g.Bt + (size_t)nxt.pn * tstep : cB;
        for (int t = 0; t < nt; t += 2) {
            if constexpr (Epi::KHOOK) { if (E.khook_at(t)) E.khook(acc, cur, t, wr, wc, fr, fq); }
            const bool last = (t == nt - 2);
            const char* a1 = cA + (size_t)(t + 1) * kstep;
            const char* a2 = last ? nA : cA + (size_t)(t + 2) * kstep; const char* b2 = last ? nB : cB + (size_t)(t + 2) * kstep;
            const char* a3 = a2 + kstep; const char* b3 = b2 + kstep;
            if (last && has_next) S.a_ready(nxt);
            if constexpr (SP2) {
            PG8_LDB(B0, 0, 0); PG8_LDB(B1, 0, 1); PG8_SCHED; PG8_LDA(At, 0, 0); PG8_STAGE(PG8_SA(1, 1), a1 + hstep, voffA);
            PG8_WAIT_V(8); PG8_WAIT_L(0); PG8_BAR; PG8_MMA(0, 0, At, B0); PG8_MMA(0, 1, At, B1); PG8_BAR; PG8_SCHED;
            PG8_LDA(At, 0, 1); PG8_STAGE(PG8_SB(0, 0), b2, voffB); PG8_STAGE(PG8_SB(0, 1), b2 + hstep, voffB); PG8_STAGE(PG8_SA(0, 0), a2, voffA);
            PG8_WAIT_V(8); PG8_WAIT_L(0); PG8_BAR; PG8_MMA(1, 0, At, B0); PG8_MMA(1, 1, At, B1); PG8_BAR; PG8_SCHED;
            PG8_LDB(B0, 1, 0); PG8_LDB(B1, 1, 1); PG8_SCHED; PG8_LDA(At, 1, 0); PG8_STAGE(PG8_SA(0, 1), a2 + hstep, voffA);
            PG8_WAIT_V(8); PG8_WAIT_L(0); PG8_BAR; PG8_MMA(0, 0, At, B0); PG8_MMA(0, 1, At, B1); PG8_BAR; PG8_SCHED;
            PG8_LDA(At, 1, 1); PG8_STAGE(PG8_SB(1, 0), b3, voffB); PG8_STAGE(PG8_SB(1, 1), b3 + hstep, voffB); PG8_STAGE(PG8_SA(1, 0), a3, voffA);
            PG8_WAIT_V(8); PG8_WAIT_L(0); PG8_BAR; PG8_MMA(1, 0, At, B0); PG8_MMA(1, 1, At, B1); PG8_BAR; PG8_SCHED;
            } else {
            PG8_LDB(B0, 0, 0); PG8_SCHED; PG8_LDA(At, 0, 0); PG8_STAGE(PG8_SA(1, 1), a1 + hstep, voffA);
            PG8_WAIT_L(8); PG8_BAR; PG8_WAIT_L(0); PG8_MMA(0, 0, At, B0); PG8_BAR; PG8_SCHED;
            PG8_LDB(B1, 0, 1); PG8_STAGE(PG8_SB(0, 0), b2, voffB);
            PG8_BAR; PG8_WAIT_L(0); PG8_MMA(0, 1, At, B1); PG8_BAR;
            PG8_LDA(At, 0, 1); PG8_STAGE(PG8_SA(0, 0), a2, voffA);
            PG8_BAR; PG8_WAIT_L(0); PG8_MMA(1, 0, At, B0); PG8_BAR; PG8_SCHED;
            PG8_STAGE(PG8_SB(0, 1), b2 + hstep, voffB);
            PG8_WAIT_V(6); PG8_BAR; PG8_MMA(1, 1, At, B1); PG8_BAR;
            PG8_LDB(B0, 1, 0); PG8_SCHED; PG8_LDA(At, 1, 0); PG8_STAGE(PG8_SA(0, 1), a2 + hstep, voffA);
            PG8_WAIT_L(8); PG8_BAR; PG8_WAIT_L(0); PG8_MMA(0, 0, At, B0); PG8_BAR; PG8_SCHED;
            PG8_LDB(B1, 1, 1); PG8_STAGE(PG8_SB(1, 0), b3, voffB);
            PG8_BAR; PG8_WAIT_L(0); PG8_MMA(0, 1, At, B1); PG8_BAR;
            PG8_LDA(At, 1, 1); PG8_STAGE(PG8_SA(1, 0), a3, voffA);
            PG8_BAR; PG8_WAIT_L(0); PG8_MMA(1, 0, At, B0); PG8_BAR; PG8_SCHED;
            PG8_STAGE(PG8_SB(1, 1), b3 + hstep, voffB);
            PG8_WAIT_V(6); PG8_BAR; PG8_MMA(1, 1, At, B1); PG8_BAR;
            }
        }
        if constexpr (ALIGN_EPI) { if (wr == 0) PG8_BAR; }
        if constexpr (!Epi::AFTER_DRAIN) { E(acc, cur, wr, wc, fr, fq); S.done(cur); }
        if (!has_next) break;
#pragma unroll
        for (int a = 0; a < 2; ++a)
#pragma unroll
            for (int b = 0; b < 2; ++b)
#pragma unroll
                for (int m = 0; m < 4; ++m)
#pragma unroll
                    for (int n = 0; n < 2; ++n) acc[a][b][m][n] = (f32x4){0.f, 0.f, 0.f, 0.f};
        cur = nxt; cA = nA; cB = nB; ++ui;
        if constexpr (ALIGN_EPI) { if (wr == 1) PG8_BAR; }
    }
    PG8_WAIT_V(0);
    if constexpr (!ALIGN_EPI) { if (wr == 0) PG8_BAR; }
    PG8_BAR;
    if constexpr (Epi::AFTER_DRAIN) { E.fused(acc, cur, wr, wc, fr, fq, lds, wid, lane); S.done(cur); }
#undef PG8_SA
#undef PG8_SB
#undef PG8_STAGE
#undef PG8_LDA
#undef PG8_LDB
#undef PG8_MMA
#undef PG8_WAIT_V
#undef PG8_WAIT_L
#undef PG8_BAR
#undef PG8_SCHED
}
}
#ifndef PROBE_SUB
#define PROBE_SUB 0
#endif
#ifndef PROBE_DUP
#define PROBE_DUP 0
#endif
#ifndef PROBE_DUPK
#define PROBE_DUPK -1
#endif
#ifndef PROBE_PRO
#define PROBE_PRO 0
#endif
#define LAS __attribute__((address_space(3)))
typedef unsigned short bf16;
typedef float f32x4 __attribute__((ext_vector_type(4)));
typedef unsigned u32x4 __attribute__((ext_vector_type(4)));
typedef unsigned u32x2 __attribute__((ext_vector_type(2)));

constexpr int BATCH = 4, SEQ = 2048, DM = 2048, M = BATCH * SEQ, DEPTH = 2;
constexpr int NIN = 15664, NP = 15872, DFF = 8192;
constexpr int OFF_BQ = 4608, OFF_BKV = 5632, OFF_BG = 6400, OFF_CQ = 6448, OFF_CK = 7472, OFF_CV = 8496, OFF_MG = 9520;
constexpr int BT = 2112;
constexpr int NCMP = 127;
constexpr size_t MiB = 1u << 20;
constexpr size_t WS_WT = 0, LAYER_W = 144 * MiB;
constexpr size_t WO_IN = 0, WO_A = 62 * MiB, WO_B = 64 * MiB, WO_C = 68 * MiB, WO_OUT = 72 * MiB, WO_UP = 80 * MiB, WO_DOWN = 112 * MiB;
constexpr size_t WS_H = 288 * MiB, WS_PROJ = 320 * MiB, WS_U = WS_PROJ;
constexpr size_t WS_OA = 568 * MiB, WS_OB = 576 * MiB, WS_OC = 592 * MiB, WS_OCMP = 608 * MiB;
constexpr size_t WS_MIXF = 640 * MiB, WS_MIXB = 704 * MiB, WS_Y = 736 * MiB;
constexpr size_t WS_KC = 800 * MiB, WS_VC = 801 * MiB, WS_SELM = 802 * MiB, WS_BIAST = 803 * MiB, WS_CW = 804 * MiB, WS_BAR = 812 * MiB, WS_END = 813 * MiB;
constexpr int LDS_BYTES = 147456;
constexpr int PH_PER_LAYER = 9;
constexpr int NPH = 1 + DEPTH * PH_PER_LAYER;

struct Args { const float* in[21]; float* out; unsigned char* ws; int ph_lo, ph_hi; };
constexpr int PTAB_OFF = 131072 + 1024;
struct PT { const unsigned long long* t;
    __device__ __forceinline__ unsigned long long get(int i) const { const unsigned long long v = t[i]; const unsigned lo = __builtin_amdgcn_readfirstlane((unsigned)v), hi = __builtin_amdgcn_readfirstlane((unsigned)(v >> 32)); return ((unsigned long long)hi << 32) | lo; }
    __device__ __forceinline__ const float* in(int i) const { return (const float*)(const __attribute__((address_space(1))) float*)get(i); }
    __device__ __forceinline__ float* out() const { return (float*)(__attribute__((address_space(1))) float*)get(21); }
    __device__ __forceinline__ unsigned char* ws() const { return (unsigned char*)(__attribute__((address_space(1))) unsigned char*)get(22); } };

#define LDS_FENCE() asm volatile("s_waitcnt vmcnt(0) lgkmcnt(0)" ::: "memory")

__device__ __forceinline__ unsigned f2bf(float f) { unsigned u = __builtin_bit_cast(unsigned, f); return (u + 0x7fffu + ((u >> 16) & 1u)) >> 16; }
__device__ __forceinline__ unsigned pk2(float lo, float hi) { return f2bf(lo) | (f2bf(hi) << 16); }
typedef __bf16 bf16v2_t __attribute__((ext_vector_type(2)));
typedef float f32v2_t __attribute__((ext_vector_type(2)));
__device__ __forceinline__ unsigned pkh(float lo, float hi) { f32v2_t v; v.x = lo; v.y = hi; return __builtin_bit_cast(unsigned, __builtin_convertvector(v, bf16v2_t)); }
__device__ __forceinline__ float bf_lo(unsigned w) { return __uint_as_float(w << 16); }
__device__ __forceinline__ float bf_hi(unsigned w) { return __uint_as_float(w & 0xffff0000u); }
__device__ __forceinline__ float bf2f(bf16 h) { return __uint_as_float(((unsigned)h) << 16); }
__device__ __forceinline__ float wave_sum(float v) {
#pragma unroll
    for (int o = 32; o >= 1; o >>= 1) v += __shfl_xor(v, o);
    return v;
}
__device__ __forceinline__ float wave_max(float v) {
#pragma unroll
    for (int o = 32; o >= 1; o >>= 1) v = fmaxf(v, __shfl_xor(v, o));
    return v;
}
__device__ __forceinline__ float sigmoidf_(float x) { return 1.0f / (1.0f + __expf(-x)); }

__device__ __forceinline__ void load64(const bf16* p, float (&q)[64]) {
    const u32x4* p4 = (const u32x4*)p;
#pragma unroll
    for (int i = 0; i < 8; ++i) { const u32x4 w = p4[i];
        q[8 * i + 0] = bf_lo(w.x); q[8 * i + 1] = bf_hi(w.x); q[8 * i + 2] = bf_lo(w.y); q[8 * i + 3] = bf_hi(w.y);
        q[8 * i + 4] = bf_lo(w.z); q[8 * i + 5] = bf_hi(w.z); q[8 * i + 6] = bf_lo(w.w); q[8 * i + 7] = bf_hi(w.w); }
}
__device__ __forceinline__ float dot64(const float (&q)[64], const bf16* k) {
    const u32x4* k4 = (const u32x4*)k; float a0 = 0.f, a1 = 0.f;
#pragma unroll
    for (int i = 0; i < 8; ++i) { const u32x4 w = k4[i];
        a0 += q[8 * i + 0] * bf_lo(w.x); a1 += q[8 * i + 1] * bf_hi(w.x); a0 += q[8 * i + 2] * bf_lo(w.y); a1 += q[8 * i + 3] * bf_hi(w.y);
        a0 += q[8 * i + 4] * bf_lo(w.z); a1 += q[8 * i + 5] * bf_hi(w.z); a0 += q[8 * i + 6] * bf_lo(w.w); a1 += q[8 * i + 7] * bf_hi(w.w); }
    return a0 + a1;
}
__device__ __forceinline__ float wave_softmax(float* S, int n, int lane, float& mout) {
    float m = -3.0e38f;
    for (int i = lane; i < n; i += 64) m = fmaxf(m, S[i]);
    m = wave_max(m);
    float s = 0.f;
    for (int i = lane; i < n; i += 64) { const float e = __expf(S[i] - m); S[i] = e; s += e; }
    s = wave_sum(s); mout = m; return s;
}

struct TItem { const float* W; bf16* WT; int K, N, item, pitch; };
struct TRegs { f32x4 v0[8], v1[8]; };
__device__ __forceinline__ void titem_load(const TItem& t, TRegs& R, int lane) {
    const int nblk = (t.N + 63) / 64, kb = t.item / nblk, nb = t.item % nblk, k0 = 64 * kb, n0 = 64 * nb;
    const int rg = lane >> 4, c4 = lane & 15, nn = n0 + 4 * c4; const bool ok = nn < t.N;
#pragma unroll
    for (int i = 0; i < 8; ++i) { const float* p = t.W + (size_t)(k0 + 8 * i + 2 * rg) * t.N + nn;
        R.v0[i] = ok ? *(const f32x4*)p : (f32x4){0.f, 0.f, 0.f, 0.f}; R.v1[i] = ok ? *(const f32x4*)(p + t.N) : (f32x4){0.f, 0.f, 0.f, 0.f}; }
}
__device__ __forceinline__ void titem_store(const TItem& t, const TRegs& R, float* scrf, int lane) {
    unsigned* scr = (unsigned*)scrf;
    const int nblk = (t.N + 63) / 64, kb = t.item / nblk, nb = t.item % nblk, k0 = 64 * kb, n0 = 64 * nb;
    const int rg = lane >> 4, c4 = lane & 15;
#pragma unroll
    for (int i = 0; i < 8; ++i) { unsigned* q = scr + (4 * i + rg) * 66 + 4 * c4;
        q[0] = pkh(R.v0[i].x, R.v1[i].x); q[1] = pkh(R.v0[i].y, R.v1[i].y); q[2] = pkh(R.v0[i].z, R.v1[i].z); q[3] = pkh(R.v0[i].w, R.v1[i].w); }
    LDS_FENCE();
    const int c = lane & 7;
#pragma unroll
    for (int j = 0; j < 8; ++j) { const int n = (lane >> 3) + 8 * j; const unsigned* s = scr + (4 * c) * 66 + n;
        u32x4 o; o.x = s[0]; o.y = s[66]; o.z = s[132]; o.w = s[198];
        *(u32x4*)(t.WT + (size_t)(n0 + n) * t.pitch + k0 + 8 * c) = o; }
    LDS_FENCE();
}
__device__ __forceinline__ int t5_bucket(int d) {
    if (d < 16) return d;
    const float logd = logf((float)d / 16.0f);
    int far = 16 + (int)(logd / 4.852030263919617f * 16.0f);
    return far < 31 ? far : 31;
}
__device__ __forceinline__ void rms_row_to_bf16(const float* xrow, const float* gain, bf16* orow, int lane) {
    const f32x4* xr = (const f32x4*)xrow + lane; const f32x4* gr = (const f32x4*)gain + lane;
    f32x4 v[8]; float s = 0.f;
#pragma unroll
    for (int j = 0; j < 8; ++j) { v[j] = xr[64 * j]; s += (v[j].x * v[j].x + v[j].y * v[j].y) + (v[j].z * v[j].z + v[j].w * v[j].w); }
    const float r = 1.0f / sqrtf(wave_sum(s) * (1.0f / DM) + 1e-6f);
    u32x2* o8 = (u32x2*)orow + lane;
#pragma unroll
    for (int j = 0; j < 8; ++j) { const f32x4 g = gr[64 * j]; u32x2 w; w.x = pk2(v[j].x * r * g.x, v[j].y * r * g.y); w.y = pk2(v[j].z * r * g.z, v[j].w * r * g.w); o8[64 * j] = w; }
}
__device__ __forceinline__ void rowpass_row(const float* xi, const bf16* y, const float* gp, const float* gn, float* xo, bf16* h, int lane) {
    const u32x2* yr = (const u32x2*)y + lane; const f32x4* xr = (const f32x4*)xi + lane; const f32x4* gpr = (const f32x4*)gp + lane;
    f32x4 v[8]; float s = 0.f;
#pragma unroll
    for (int j = 0; j < 8; ++j) { const u32x2 w = yr[64 * j]; v[j].x = bf_lo(w.x); v[j].y = bf_hi(w.x); v[j].z = bf_lo(w.y); v[j].w = bf_hi(w.y); s += (v[j].x * v[j].x + v[j].y * v[j].y) + (v[j].z * v[j].z + v[j].w * v[j].w); }
    const float r = 1.0f / sqrtf(wave_sum(s) * (1.0f / DM) + 1e-6f);
    float s2 = 0.f;
#pragma unroll
    for (int j = 0; j < 8; ++j) { const f32x4 g = gpr[64 * j]; const f32x4 x = xr[64 * j]; v[j] = x + v[j] * r * g; s2 += (v[j].x * v[j].x + v[j].y * v[j].y) + (v[j].z * v[j].z + v[j].w * v[j].w); }
    f32x4* xw = (f32x4*)xo + lane;
#pragma unroll
    for (int j = 0; j < 8; ++j) xw[64 * j] = v[j];
    if (gn) {
        const float r2 = 1.0f / sqrtf(wave_sum(s2) * (1.0f / DM) + 1e-6f);
        const f32x4* gnr = (const f32x4*)gn + lane; u32x2* o8 = (u32x2*)h + lane;
#pragma unroll
        for (int j = 0; j < 8; ++j) { const f32x4 g = gnr[64 * j]; u32x2 w; w.x = pk2(v[j].x * r2 * g.x, v[j].y * r2 * g.y); w.y = pk2(v[j].z * r2 * g.z, v[j].w * r2 * g.w); o8[64 * j] = w; }
    }
}

constexpr int IT_IN = 32 * 245, IT_A = 8 * 32, IT_B = 16 * 32, IT_C = 16 * 32, IT_OUT = 32 * 32, IT_UP = 32 * 128, IT_DOWN = 128 * 32;
constexpr int IT_W1 = 32 * 4, IT_W2 = 4 * 1;
constexpr int IT_LAYER = IT_IN + IT_A + IT_B + IT_C + IT_OUT + IT_UP + IT_DOWN + 2 * IT_W1 + 2 * IT_W2;

__device__ __forceinline__ TItem decode_item(const PT a, unsigned char* ws, int it) {
    const int l = it / IT_LAYER; int r = it % IT_LAYER;
    unsigned char* wl = ws + WS_WT + (size_t)l * LAYER_W; unsigned char* cw = ws + WS_CW + (size_t)l * 4 * MiB;
    TItem t;
    if (r < IT_IN) { t.W = a.in(2) + (size_t)l * DM * NIN; t.K = DM; t.N = NIN; t.WT = (bf16*)(wl + WO_IN); t.item = r; t.pitch = t.K; return t; } r -= IT_IN;
    if (r < IT_A) { t.W = a.in(11) + (size_t)l * 512 * DM; t.K = 512; t.N = DM; t.WT = (bf16*)(wl + WO_A); t.item = r; t.pitch = 2560; return t; } r -= IT_A;
    if (r < IT_B) { t.W = a.in(12) + (size_t)l * 1024 * DM; t.K = 1024; t.N = DM; t.WT = (bf16*)(wl + WO_A) + 512; t.item = r; t.pitch = 2560; return t; } r -= IT_B;
    if (r < IT_C) { t.W = a.in(13) + (size_t)l * 1024 * DM; t.K = 1024; t.N = DM; t.WT = (bf16*)(wl + WO_A) + 1536; t.item = r; t.pitch = 2560; return t; } r -= IT_C;
    if (r < IT_OUT) { t.W = a.in(14) + (size_t)l * DM * DM; t.K = DM; t.N = DM; t.WT = (bf16*)(wl + WO_OUT); t.item = r; t.pitch = t.K; return t; } r -= IT_OUT;
    if (r < IT_UP) { t.W = a.in(19) + (size_t)l * DM * DFF; t.K = DM; t.N = DFF; t.WT = (bf16*)(wl + WO_UP); t.item = r; t.pitch = t.K; return t; } r -= IT_UP;
    if (r < IT_DOWN) { t.W = a.in(20) + (size_t)l * DFF * DM; t.K = DFF; t.N = DM; t.WT = (bf16*)(wl + WO_DOWN); t.item = r; t.pitch = t.K; return t; } r -= IT_DOWN;
    if (r < IT_W1) { t.W = a.in(5) + (size_t)l * 2048 * 256; t.K = 2048; t.N = 256; t.WT = (bf16*)cw; t.item = r; t.pitch = t.K; return t; } r -= IT_W1;
    if (r < IT_W1) { t.W = a.in(7) + (size_t)l * 2048 * 256; t.K = 2048; t.N = 256; t.WT = (bf16*)(cw + MiB); t.item = r; t.pitch = t.K; return t; } r -= IT_W1;
    if (r < IT_W2) { t.W = a.in(6) + (size_t)l * 256 * 64; t.K = 256; t.N = 64; t.WT = (bf16*)(cw + 2 * MiB); t.item = r; t.pitch = t.K; return t; } r -= IT_W2;
    t.W = a.in(8) + (size_t)l * 256 * 64; t.K = 256; t.N = 64; t.WT = (bf16*)(cw + 2 * MiB + 65536); t.item = r; t.pitch = t.K; return t;
}
__device__ __forceinline__ void phase_prologue(const PT a, float* ldsf, int lane, int wave, int gw, int ngw) {
    float* scr = ldsf + wave * 4096;
    unsigned char* ws = a.ws();
    constexpr int NIT = DEPTH * IT_LAYER;
    if (gw < NIT) {
        int it = gw; TItem cur = decode_item(a, ws, it); TRegs R; titem_load(cur, R, lane);
        for (;;) {
            const int nx = it + ngw; const bool more = nx < NIT;
            TItem nxt = cur; TRegs R2 = R;
            if (more) { nxt = decode_item(a, ws, nx); titem_load(nxt, R2, lane); }
            titem_store(cur, R, scr, lane);
            if (!more) break;
            cur = nxt; R = R2; it = nx;
        }
    }
    float* biasT = (float*)(ws + WS_BIAST);
    for (int i = gw * 64 + lane; i < 48 * BT; i += ngw * 64) { const int col = i / BT, d = i % BT; biasT[i] = a.in(1)[t5_bucket(d) * 48 + col]; }
    for (int m = gw; m < M; m += ngw) rms_row_to_bf16(a.in(0) + (size_t)m * DM, a.in(15), (bf16*)(ws + WS_H) + (size_t)m * DM, lane);
}

struct EpiAny { static constexpr bool PERM = true, AFTER_DRAIN = false, KHOOK = true;
    int mode; bf16* ob; float* of; const bf16* proj;
    __device__ __forceinline__ bool khook_at(int t) const { return mode == 6 && (t == 8 || t == 24); }
    __device__ __forceinline__ void khook(pg8::f32x4 (&acc)[2][2][4][2], const pg8::Unit& u, int t, int wr, int wc, int fr, int fq) const {
        const int step = (t == 8) ? 0 : 1;
        { int tl = (int)threadIdx.x; asm volatile("" : "+v"(tl)); fr = tl & 15; fq = (tl >> 4) & 3; }
#pragma unroll
        for (int ai = 0; ai < 2; ++ai) {
                u32x2 zc[16], zn[16];
#pragma unroll
                for (int q = 0; q < 16; ++q) { const int m = q >> 2, bj = (q >> 1) & 1, n = q & 1;
                    const int row = u.pm * 256 + ai * 128 + wr * 64 + m * 16 + fr, col = u.pn * 256 + bj * 128 + wc * 32 + 8 * fq + 4 * n;
                    const bf16* gp = proj + (size_t)row * NP + OFF_MG + step * DM + col; zc[q] = *(const u32x2*)gp; zn[q] = *(const u32x2*)(gp + DM); }
#pragma unroll
                for (int q = 0; q < 16; ++q) { const int m = q >> 2, bj = (q >> 1) & 1, n = q & 1;
                    pg8::f32x4 t0 = acc[ai][bj][m][n];
                    t0[0] *= (1.f + __expf(-bf_lo(zn[q].x))) * __builtin_amdgcn_rcpf(1.f + __expf(-bf_lo(zc[q].x))); t0[1] *= (1.f + __expf(-bf_hi(zn[q].x))) * __builtin_amdgcn_rcpf(1.f + __expf(-bf_hi(zc[q].x)));
                    t0[2] *= (1.f + __expf(-bf_lo(zn[q].y))) * __builtin_amdgcn_rcpf(1.f + __expf(-bf_lo(zc[q].y))); t0[3] *= (1.f + __expf(-bf_hi(zn[q].y))) * __builtin_amdgcn_rcpf(1.f + __expf(-bf_hi(zc[q].y)));
                    acc[ai][bj][m][n] = t0; }
                asm volatile("" ::: "memory"); }
    }
    template <int MODE> __device__ __forceinline__ void run(const pg8::f32x4 (&acc)[2][2][4][2], const pg8::Unit& u, int wr, int wc, int fr, int fq) const {
        constexpr int LDC = (MODE == 0) ? NP : (MODE == 5 ? DFF : DM);
        { int tl = (int)threadIdx.x; asm volatile("" : "+v"(tl)); fr = tl & 15; fq = (tl >> 4) & 3; }
#pragma unroll
        for (int ai = 0; ai < 2; ++ai)
#pragma unroll
            for (int mp = 0; mp < 2; ++mp) {
                u32x4 gpre[4];
                if constexpr (MODE == 6) {
#pragma unroll
                    for (int q = 0; q < 4; ++q) { const int m = 2 * mp + (q >> 1), bj = q & 1; const int row = u.pm * 256 + ai * 128 + wr * 64 + m * 16 + fr, col = u.pn * 256 + bj * 128 + wc * 32 + 8 * fq;
                        gpre[q] = *(const u32x4*)(proj + (size_t)row * NP + OFF_MG + 2 * DM + col); }
                }
#pragma unroll
                for (int q = 0; q < 4; ++q) { const int m = 2 * mp + (q >> 1), bj = q & 1; const int row = u.pm * 256 + ai * 128 + wr * 64 + m * 16 + fr, col = u.pn * 256 + bj * 128 + wc * 32 + 8 * fq;
                    const pg8::f32x4 t0 = acc[ai][bj][m][0], t1 = acc[ai][bj][m][1];
                    float v[8] = {t0[0], t0[1], t0[2], t0[3], t1[0], t1[1], t1[2], t1[3]};
                    if constexpr (MODE == 5) {
#pragma unroll
                        for (int e = 0; e < 8; ++e) { const float r = fmaxf(v[e], 0.f); v[e] = r * r; }
                    }
                    if constexpr (MODE == 6) { const u32x4 g = gpre[q];
                        v[0] *= sigmoidf_(bf_lo(g.x)); v[1] *= sigmoidf_(bf_hi(g.x)); v[2] *= sigmoidf_(bf_lo(g.y)); v[3] *= sigmoidf_(bf_hi(g.y));
                        v[4] *= sigmoidf_(bf_lo(g.z)); v[5] *= sigmoidf_(bf_hi(g.z)); v[6] *= sigmoidf_(bf_lo(g.w)); v[7] *= sigmoidf_(bf_hi(g.w)); }
                    u32x4 w; w.x = pkh(v[0], v[1]); w.y = pkh(v[2], v[3]); w.z = pkh(v[4], v[5]); w.w = pkh(v[6], v[7]);
                    *(u32x4*)(ob + (size_t)row * LDC + col) = w; }
                asm volatile("" ::: "memory"); }
    }
    __device__ __forceinline__ void operator()(const pg8::f32x4 (&acc)[2][2][4][2], const pg8::Unit& u, int wr, int wc, int fr, int fq) const {
        if (mode == 0) run<0>(acc, u, wr, wc, fr, fq);
        else if (mode == 4) run<4>(acc, u, wr, wc, fr, fq);
        else if (mode == 5) run<5>(acc, u, wr, wc, fr, fq);
        else run<6>(acc, u, wr, wc, fr, fq);
    } };


constexpr int KCAT = 2560;
typedef short bf16x8 __attribute__((ext_vector_type(8)));
typedef short bf16x4 __attribute__((ext_vector_type(4)));
typedef float f32x16 __attribute__((ext_vector_type(16)));
#define MFMA32(a, b, c) __builtin_amdgcn_mfma_f32_32x32x16_bf16(a, b, c, 0, 0, 0)

template <int KW, int NDS> struct KVRegs { u32x4 k[KW / 64]; u32x4 v[NDS / 2]; };

template <int KW, int NDS> __device__ __forceinline__ void load_tile(KVRegs<KW, NDS>& R, const bf16* base_b, int tok0, int tstride, int kcol, int vcol, int tid) {
#pragma unroll
    for (int r = 0; r < KW / 64; ++r) { const int idx = tid + 512 * r, key = idx / (KW / 8), ch = idx % (KW / 8);
        R.k[r] = *(const u32x4*)(base_b + (size_t)(tok0 + key * tstride) * NP + kcol + ch * 8); }
#pragma unroll
    for (int r = 0; r < NDS / 2; ++r) { const int idx = tid + 512 * r, key = idx & 63, ch = idx >> 6;
        R.v[r] = *(const u32x4*)(base_b + (size_t)(tok0 + key * tstride) * NP + vcol + ch * 8); }
}
template <int KW, int NDS> __device__ __forceinline__ void store_tile(const KVRegs<KW, NDS>& R, bf16* Ks, bf16* Vt, int tid) {
#pragma unroll
    for (int r = 0; r < KW / 64; ++r) { const int idx = tid + 512 * r, key = idx / (KW / 8), ch = idx % (KW / 8);
        *(u32x4*)(Ks + key * (KW + 8) + ch * 8) = R.k[r]; }
#pragma unroll
    for (int r = 0; r < NDS / 2; ++r) { const int idx = tid + 512 * r, key = idx & 63, ch = idx >> 6; const u32x4 w = R.v[r]; bf16* p = Vt + (ch * 8) * 68 + key;
        p[0 * 68] = (bf16)(w.x & 0xffffu); p[1 * 68] = (bf16)(w.x >> 16); p[2 * 68] = (bf16)(w.y & 0xffffu); p[3 * 68] = (bf16)(w.y >> 16);
        p[4 * 68] = (bf16)(w.z & 0xffffu); p[5 * 68] = (bf16)(w.z >> 16); p[6 * 68] = (bf16)(w.w & 0xffffu); p[7 * 68] = (bf16)(w.w >> 16); }
}
constexpr float LOG2E = 1.4426950408889634f;
constexpr float QSCALE2 = 0.125f * LOG2E;
__device__ __forceinline__ void load_qfrag(const bf16* qrow, int hi, bf16x8 (&qf)[4], float sc) {
    u32x4 w0 = *(const u32x4*)(qrow + 0 * 16 + hi * 8), w1 = *(const u32x4*)(qrow + 1 * 16 + hi * 8), w2 = *(const u32x4*)(qrow + 2 * 16 + hi * 8), w3 = *(const u32x4*)(qrow + 3 * 16 + hi * 8);
    asm volatile("" : "+v"(w0), "+v"(w1), "+v"(w2), "+v"(w3));
    const u32x4 wv[4] = {w0, w1, w2, w3};
#pragma unroll
    for (int c = 0; c < 4; ++c) { const u32x4 w = wv[c]; u32x4 o;
        o.x = pkh(bf_lo(w.x) * sc, bf_hi(w.x) * sc); o.y = pkh(bf_lo(w.y) * sc, bf_hi(w.y) * sc);
        o.z = pkh(bf_lo(w.z) * sc, bf_hi(w.z) * sc); o.w = pkh(bf_lo(w.w) * sc, bf_hi(w.w) * sc);
        qf[c] = __builtin_bit_cast(bf16x8, o); }
}
template <int KP, int NDS> __device__ __forceinline__ void attn_tile(const bf16x8 (&qf)[4], const bf16* Ks, const bf16* Vt, float& m, float& l, f32x16 (&O)[NDS],
                                                                       const float* tab, int dq, int maxd, bool tile_ok, int pmode, float cb, int l32, int hi) {
    f32x16 s0, s1;
#pragma unroll
    for (int i = 0; i < 16; ++i) { s0[i] = 0.f; s1[i] = 0.f; }
#pragma unroll
    for (int c = 0; c < 4; ++c) { const bf16x8 a0 = *(const bf16x8*)(Ks + l32 * KP + c * 16 + hi * 8); const bf16x8 a1 = *(const bf16x8*)(Ks + (32 + l32) * KP + c * 16 + hi * 8);
        s0 = MFMA32(a0, qf[c], s0); s1 = MFMA32(a1, qf[c], s1); }
    float mx = -1e30f, sub;
    if (pmode == 2) {
#pragma unroll
        for (int i = 0; i < 16; ++i) mx = fmaxf(mx, fmaxf(s0[i], s1[i]));
        mx = fmaxf(mx, __shfl_xor(mx, 32)) + cb;
    } else if (pmode == 1) {
        const float* tp = tab + (dq - 4 * hi);
#pragma unroll
        for (int h4 = 0; h4 < 4; ++h4) { float bb[4];
#pragma unroll
            for (int j = 0; j < 4; ++j) bb[j] = tp[-(h4 * 8 + j)];
#pragma unroll
            for (int j = 0; j < 4; ++j) { const int i = 4 * h4 + j; s0[i] = tile_ok ? s0[i] + bb[j] : -INFINITY; mx = fmaxf(mx, s0[i]); } }
#pragma unroll
        for (int h4 = 0; h4 < 4; ++h4) { float bb[4];
#pragma unroll
            for (int j = 0; j < 4; ++j) bb[j] = tp[-(32 + h4 * 8 + j)];
#pragma unroll
            for (int j = 0; j < 4; ++j) { const int i = 4 * h4 + j; s1[i] = tile_ok ? s1[i] + bb[j] : -INFINITY; mx = fmaxf(mx, s1[i]); } }
        mx = fmaxf(mx, __shfl_xor(mx, 32));
    } else {
        const int dq4 = dq - 4 * hi, cl = maxd < 2047 ? maxd : 2047;
#pragma unroll
        for (int h4 = 0; h4 < 4; ++h4) { float bb[4];
#pragma unroll
            for (int j = 0; j < 4; ++j) { const int d0 = dq4 - (h4 * 8 + j); bb[j] = tab[d0 < 0 ? 0 : (d0 > cl ? cl : d0)]; }
#pragma unroll
            for (int j = 0; j < 4; ++j) { const int i = 4 * h4 + j; const int d0 = dq4 - (h4 * 8 + j); const bool v0 = tile_ok && (unsigned)d0 <= (unsigned)maxd;
                s0[i] = v0 ? s0[i] + bb[j] : -INFINITY; mx = fmaxf(mx, s0[i]); } }
#pragma unroll
        for (int h4 = 0; h4 < 4; ++h4) { float bb[4];
#pragma unroll
            for (int j = 0; j < 4; ++j) { const int d1 = dq4 - 32 - (h4 * 8 + j); bb[j] = tab[d1 < 0 ? 0 : (d1 > cl ? cl : d1)]; }
#pragma unroll
            for (int j = 0; j < 4; ++j) { const int i = 4 * h4 + j; const int d1 = dq4 - 32 - (h4 * 8 + j); const bool v1 = tile_ok && (unsigned)d1 <= (unsigned)maxd;
                s1[i] = v1 ? s1[i] + bb[j] : -INFINITY; mx = fmaxf(mx, s1[i]); } }
        mx = fmaxf(mx, __shfl_xor(mx, 32));
    }
    const float mn = fmaxf(m, mx), alpha = __builtin_amdgcn_exp2f(m - mn);
    const bool resc = __any(mn != m);
    m = mn; sub = (pmode == 2) ? mn - cb : mn;
    s0 = s0 - sub; s1 = s1 - sub;
#pragma unroll
    for (int i = 0; i < 16; ++i) { s0[i] = __builtin_amdgcn_exp2f(s0[i]); s1[i] = __builtin_amdgcn_exp2f(s1[i]); }
    const f32x16 ss = s0 + s1;
    const float rs = ((ss[0] + ss[1]) + (ss[2] + ss[3])) + ((ss[4] + ss[5]) + (ss[6] + ss[7])) + (((ss[8] + ss[9]) + (ss[10] + ss[11])) + ((ss[12] + ss[13]) + (ss[14] + ss[15])));
    l = l * alpha + rs;
    if (resc) {
#pragma unroll
        for (int ds = 0; ds < NDS; ++ds)
#pragma unroll
            for (int i = 0; i < 16; ++i) O[ds][i] *= alpha;
    }
#pragma unroll
    for (int c = 0; c < 4; ++c) {
        u32x4 pw;
        if (c == 0) { pw.x = pkh(s0[0], s0[1]); pw.y = pkh(s0[2], s0[3]); pw.z = pkh(s0[4], s0[5]); pw.w = pkh(s0[6], s0[7]); }
        else if (c == 1) { pw.x = pkh(s0[8], s0[9]); pw.y = pkh(s0[10], s0[11]); pw.z = pkh(s0[12], s0[13]); pw.w = pkh(s0[14], s0[15]); }
        else if (c == 2) { pw.x = pkh(s1[0], s1[1]); pw.y = pkh(s1[2], s1[3]); pw.z = pkh(s1[4], s1[5]); pw.w = pkh(s1[6], s1[7]); }
        else { pw.x = pkh(s1[8], s1[9]); pw.y = pkh(s1[10], s1[11]); pw.z = pkh(s1[12], s1[13]); pw.w = pkh(s1[14], s1[15]); }
        const bf16x8 pb = __builtin_bit_cast(bf16x8, pw);
#pragma unroll
        for (int ds = 0; ds < NDS; ++ds) { const bf16* vp = Vt + (ds * 32 + l32) * 68 + 16 * c + 4 * hi;
            const u32x2 lo = *(const u32x2*)vp, hi2 = *(const u32x2*)(vp + 8); u32x4 vw; vw.x = lo.x; vw.y = lo.y; vw.z = hi2.x; vw.w = hi2.y;
            O[ds] = MFMA32(__builtin_bit_cast(bf16x8, vw), pb, O[ds]); }
    }
}
template <int KW, int NDS, int SLOT, bool TWO> __device__ __forceinline__ void attn_pass(unsigned tmask, const bf16* base_b, int tok_base, int tstride, int kcol, int vcol, bf16* Ks, bf16* Vt, int kofs,
        const bf16x8 (&qf)[4], float& m, float& l, f32x16 (&O)[NDS], const float* tab, const unsigned char* bk, int iq, int maxd, unsigned okbits, int wave_maxq, int wave_lo, int tid, int l32, int hi) {
    if (!tmask) return;
    KVRegs<KW, NDS> Ra, Rb; int ja = __builtin_ctz(tmask), jb = -1; tmask &= tmask - 1;
    if (TWO && tmask) { jb = __builtin_ctz(tmask); tmask &= tmask - 1; }
    load_tile<KW, NDS>(Ra, base_b, tok_base + ja * 64 * tstride, tstride, kcol, vcol, tid);
    if (TWO && jb >= 0) load_tile<KW, NDS>(Rb, base_b, tok_base + jb * 64 * tstride, tstride, kcol, vcol, tid);
    for (;;) {
        __syncthreads(); store_tile<KW, NDS>(Ra, Ks, Vt, tid); if (TWO && jb >= 0) store_tile<KW, NDS>(Rb, Ks + SLOT, Vt + SLOT, tid); __syncthreads();
        const int ca = ja, cb = jb; const bool more = tmask != 0u;
        if (more) { ja = __builtin_ctz(tmask); tmask &= tmask - 1; jb = -1; if (TWO && tmask) { jb = __builtin_ctz(tmask); tmask &= tmask - 1; }
            load_tile<KW, NDS>(Ra, base_b, tok_base + ja * 64 * tstride, tstride, kcol, vcol, tid);
            if (TWO && jb >= 0) load_tile<KW, NDS>(Rb, base_b, tok_base + jb * 64 * tstride, tstride, kcol, vcol, tid); }
#pragma unroll 1
        for (int s = 0; s < (TWO ? 2 : 1); ++s) { const int c = s ? cb : ca;
            if (c >= 0 && c * 64 <= wave_maxq && c * 64 + 63 >= wave_lo) {
                const bool tok = ((okbits >> c) & 1u) != 0u;
                int pmode = 0; float cbias = 0.f;
                if (bk) { const int dmin = wave_maxq - 31 - c * 64 - 63, dmax = wave_maxq - c * 64;
                    if (dmin >= 0 && dmax <= maxd && dmax <= 2047) { pmode = 1; if (__all(tok) && bk[dmin] == bk[dmax]) { pmode = 2; cbias = tab[dmin]; } } }
                attn_tile<KW + 8, NDS>(qf, Ks + s * SLOT + kofs, Vt + s * SLOT, m, l, O, tab, iq - c * 64, maxd, tok, pmode, cbias, l32, hi); } }
        if (!more) break;
    }
}
__device__ __forceinline__ unsigned range_mask(int lo, int hi_incl) { const unsigned up = (hi_incl >= 31) ? 0xffffffffu : ((1u << (hi_incl + 1)) - 1u); return up & ~((1u << lo) - 1u); }

__device__ __forceinline__ void cmp_unit(const PT a, unsigned char* ldsb, unsigned* selL, int b, int g, int qt, int tid, int lane, int wave) {
    unsigned char* ws = a.ws(); const bf16* proj = (const bf16*)(ws + WS_PROJ);
    const float* kc = (const float*)(ws + WS_KC); const float* vc = (const float*)(ws + WS_VC); float* ocmp = (float*)(ws + WS_OCMP);
    bf16* Khi = (bf16*)ldsb; bf16* Klo = (bf16*)(ldsb + 18432); bf16* Vt = (bf16*)(ldsb + 104448); float* SC = (float*)ldsb;
    const int l32 = lane & 31, hi = lane >> 5;
    __syncthreads();
    {
        const int hh = g * 8 + wave, t0 = qt * 32, tq = t0 + l32, tok = b * SEQ + tq;
        {
            const int n = tid >> 2, seg = tid & 3;
            const f32x4* kp = (const f32x4*)(kc + (size_t)((b * NCMP + (n < NCMP ? n : 0)) * 2 + g) * 64 + seg * 16);
            u32x4 h0, h1, l0, l1; f32x4 x[4];
#pragma unroll
            for (int e = 0; e < 4; ++e) { x[e] = kp[e]; if (n >= NCMP) x[e] = (f32x4){0.f, 0.f, 0.f, 0.f}; }
            unsigned hw[8], lw[8];
#pragma unroll
            for (int e = 0; e < 4; ++e) { const unsigned a0 = f2bf(x[e].x), a1 = f2bf(x[e].y), a2 = f2bf(x[e].z), a3 = f2bf(x[e].w);
                hw[2 * e] = a0 | (a1 << 16); hw[2 * e + 1] = a2 | (a3 << 16);
                lw[2 * e] = pk2(x[e].x - __uint_as_float(a0 << 16), x[e].y - __uint_as_float(a1 << 16)); lw[2 * e + 1] = pk2(x[e].z - __uint_as_float(a2 << 16), x[e].w - __uint_as_float(a3 << 16)); }
            h0.x = hw[0]; h0.y = hw[1]; h0.z = hw[2]; h0.w = hw[3]; h1.x = hw[4]; h1.y = hw[5]; h1.z = hw[6]; h1.w = hw[7];
            l0.x = lw[0]; l0.y = lw[1]; l0.z = lw[2]; l0.w = lw[3]; l1.x = lw[4]; l1.y = lw[5]; l1.z = lw[6]; l1.w = lw[7];
            *(u32x4*)(Khi + n * 72 + seg * 16) = h0; *(u32x4*)(Khi + n * 72 + seg * 16 + 8) = h1;
            *(u32x4*)(Klo + n * 72 + seg * 16) = l0; *(u32x4*)(Klo + n * 72 + seg * 16 + 8) = l1;
            const int nv_ = tid & 127, dseg = tid >> 7;
            const f32x4* vp = (const f32x4*)(vc + (size_t)((b * NCMP + (nv_ < NCMP ? nv_ : 0)) * 2 + g) * 64 + dseg * 16);
#pragma unroll
            for (int e = 0; e < 4; ++e) { f32x4 v = vp[e]; if (nv_ >= NCMP) v = (f32x4){0.f, 0.f, 0.f, 0.f}; bf16* p = Vt + (dseg * 16 + e * 4) * 136 + nv_;
                p[0] = (bf16)f2bf(v.x); p[136] = (bf16)f2bf(v.y); p[272] = (bf16)f2bf(v.z); p[408] = (bf16)f2bf(v.w); }
        }
        bf16x8 qf[4]; load_qfrag(proj + (size_t)tok * NP + OFF_BQ + hh * 64, hi, qf, 0.125f);
        __syncthreads();
        f32x16 s[4];
#pragma unroll
        for (int st = 0; st < 4; ++st) {
#pragma unroll
            for (int i = 0; i < 16; ++i) s[st][i] = 0.f;
#pragma unroll
            for (int c = 0; c < 4; ++c) { const bf16x8 ah = *(const bf16x8*)(Khi + (st * 32 + l32) * 72 + c * 16 + hi * 8); const bf16x8 al = *(const bf16x8*)(Klo + (st * 32 + l32) * 72 + c * 16 + hi * 8);
                s[st] = MFMA32(ah, qf[c], s[st]); s[st] = MFMA32(al, qf[c], s[st]); }
        }
        int nvq = tq >= 31 ? (tq - 31) / 16 + 1 : 0; nvq = nvq < NCMP ? nvq : NCMP;
        float mx = -1e30f;
#pragma unroll
        for (int st = 0; st < 4; ++st)
#pragma unroll
            for (int i = 0; i < 16; ++i) { const int n = 32 * st + (i >> 2) * 8 + 4 * hi + (i & 3); if (n < nvq) mx = fmaxf(mx, s[st][i]); }
        mx = fmaxf(mx, __shfl_xor(mx, 32));
        float rs = 0.f;
#pragma unroll
        for (int st = 0; st < 4; ++st)
#pragma unroll
            for (int i = 0; i < 16; ++i) { const int n = 32 * st + (i >> 2) * 8 + 4 * hi + (i & 3); const float e = (n < nvq) ? __expf(s[st][i] - mx) : 0.f; s[st][i] = e; rs += e; }
        rs += __shfl_xor(rs, 32);
        const float inv = nvq > 0 ? 1.0f / rs : 0.f;
#pragma unroll
        for (int st = 0; st < 4; ++st)
#pragma unroll
            for (int i = 0; i < 16; ++i) s[st][i] *= inv;
        f32x16 O[2];
#pragma unroll
        for (int ds = 0; ds < 2; ++ds)
#pragma unroll
            for (int i = 0; i < 16; ++i) O[ds][i] = 0.f;
#pragma unroll
        for (int st = 0; st < 4; ++st)
#pragma unroll
            for (int c2 = 0; c2 < 2; ++c2) { const int c = 2 * st + c2; u32x4 pw;
                pw.x = pk2(s[st][8 * c2 + 0], s[st][8 * c2 + 1]); pw.y = pk2(s[st][8 * c2 + 2], s[st][8 * c2 + 3]); pw.z = pk2(s[st][8 * c2 + 4], s[st][8 * c2 + 5]); pw.w = pk2(s[st][8 * c2 + 6], s[st][8 * c2 + 7]);
                const bf16x8 pb = __builtin_bit_cast(bf16x8, pw);
#pragma unroll
                for (int ds = 0; ds < 2; ++ds) { const bf16* vp = Vt + (ds * 32 + l32) * 136 + 16 * c + 4 * hi;
                    const u32x2 lo = *(const u32x2*)vp, hi2 = *(const u32x2*)(vp + 8); u32x4 vw; vw.x = lo.x; vw.y = lo.y; vw.z = hi2.x; vw.w = hi2.y;
                    O[ds] = MFMA32(__builtin_bit_cast(bf16x8, vw), pb, O[ds]); } }
#pragma unroll
        for (int ds = 0; ds < 2; ++ds)
#pragma unroll
            for (int i4 = 0; i4 < 4; ++i4) { f32x4 v; v.x = O[ds][i4 * 4 + 0]; v.y = O[ds][i4 * 4 + 1]; v.z = O[ds][i4 * 4 + 2]; v.w = O[ds][i4 * 4 + 3];
                *(f32x4*)(ocmp + (size_t)tok * 1024 + hh * 64 + ds * 32 + i4 * 8 + 4 * hi) = v; }
        __syncthreads();
        {
            float prev_other = 0.f;
#pragma unroll
            for (int st = 0; st < 4; ++st)
#pragma unroll
                for (int i4 = 0; i4 < 4; ++i4) {
                    const float gs = (s[st][4 * i4] + s[st][4 * i4 + 1]) + (s[st][4 * i4 + 2] + s[st][4 * i4 + 3]);
                    const float other = __shfl_xor(s[st][4 * i4 + 3], 32);
                    const float c = gs + (hi ? other : prev_other);
                    prev_other = other;
                    SC[(wave * 32 + l32) * 33 + 8 * st + 2 * i4 + hi] = c;
                }
        }
        __syncthreads();
#pragma unroll 1
        for (int ps = 0; ps < 2; ++ps) {
            const int q = 4 * wave + 2 * ps + hi, j = l32, t = t0 + q, cur = t >> 6;
            float sc = 0.f;
#pragma unroll
            for (int w = 0; w < 8; ++w) sc += SC[(w * 32 + q) * 33 + j];
            if (j == 0 || cur - j == 0 || cur - j == 1) sc = 1e6f;
            if (j > cur) sc = -1e30f;
            int rank = 0;
#pragma unroll 1
            for (int i = 0; i < 32; ++i) { const float si = __shfl(sc, (lane & 32) + i); rank += (si > sc || (si == sc && i < j)) ? 1 : 0; }
            const bool sel = (rank < 16) && (j <= cur);
            const unsigned long long bal = __ballot(sel);
            if (l32 == 0) selL[q] = hi ? (unsigned)(bal >> 32) : (unsigned)bal;
        }
        __syncthreads();
    }
}


__device__ __forceinline__ void phase_nsa_mfma(const PT a, unsigned char* ldsb, int tid, int lane, int wave, int bid, int nblk) {
    unsigned char* ws = a.ws(); const bf16* proj = (const bf16*)(ws + WS_PROJ); const float* biasT = (const float*)(ws + WS_BIAST);
    const float* ocmp = (const float*)(ws + WS_OCMP); bf16* ob = (bf16*)(ws + WS_OA);
    bf16* Ks = (bf16*)ldsb; bf16* Vt = (bf16*)(ldsb + 9216); float* tabs = (float*)(ldsb + 36864); unsigned char* bk = ldsb + 102400; unsigned* selL = (unsigned*)(ldsb + 121856);
    int gcur = -1;
    __syncthreads();
    for (int u = bid; u < 512; u += nblk) {
        const int bg = u & 7, b = bg >> 1, g = bg & 1, qt = u < 256 ? 63 - (u >> 3) : ((u - 256) >> 3);
        if (g != gcur) { __syncthreads();
            for (int i = tid; i < 8 * 2048; i += 512) tabs[i] = biasT[(24 + g * 8 + (i >> 11)) * BT + (i & 2047)] * LOG2E; for (int i = tid; i < 2048; i += 512) bk[i] = (unsigned char)t5_bucket(i); gcur = g; }
        const int hh = g * 8 + wave, t0 = qt * 32;
        const bf16* base_b = proj + (size_t)b * SEQ * NP;
        cmp_unit(a, ldsb, selL, b, g, qt, tid, lane, wave);
        asm volatile("" : "+v"(lane), "+v"(tid) :: "memory");
        const int l32 = lane & 31, hi = lane >> 5, tq = t0 + l32, tok = b * SEQ + tq;
        bf16x8 qf[4]; load_qfrag(proj + (size_t)tok * NP + OFF_BQ + hh * 64, hi, qf, QSCALE2);
        const unsigned mq = selL[l32];
        unsigned un = mq;
#pragma unroll
        for (int o = 1; o < 32; o <<= 1) un |= (unsigned)__shfl_xor((int)un, o);
        un = (unsigned)__builtin_amdgcn_readfirstlane((int)un);
        const float* tab = tabs + wave * 2048;
        f32x16 Os[2], Ow[2]; float m = -1e30f, l = 0.f;
#pragma unroll
        for (int ds = 0; ds < 2; ++ds)
#pragma unroll
            for (int i = 0; i < 16; ++i) { Os[ds][i] = 0.f; Ow[ds][i] = 0.f; }
        attn_pass<64, 2, 8960, true>(un, base_b, 0, 1, OFF_BKV + (4 + g) * 64, OFF_BKV + (6 + g) * 64, Ks, Vt, 0, qf, m, l, Os, tab, bk, tq, 1 << 20, mq, t0 + 31, -(1 << 20), tid, l32, hi);
        const float isel = 1.0f / (l + __shfl_xor(l, 32));
        m = -1e30f; l = 0.f;
        const int wlo = (t0 - 511 > 0 ? t0 - 511 : 0) >> 6, whi = (t0 + 31) >> 6;
        attn_pass<64, 2, 8960, true>(range_mask(wlo, whi), base_b, 0, 1, OFF_BKV + (8 + g) * 64, OFF_BKV + (10 + g) * 64, Ks, Vt, 0, qf, m, l, Ow, tab, bk, tq, 511, 0xffffffffu, t0 + 31, -(1 << 20), tid, l32, hi);
        const float iwin = 1.0f / (l + __shfl_xor(l, 32));
        const bf16* gp = proj + (size_t)tok * NP + OFF_BG + hh * 3;
        const float g0 = sigmoidf_(bf2f(gp[0])), g1 = sigmoidf_(bf2f(gp[1])) * isel, g2 = sigmoidf_(bf2f(gp[2])) * iwin;
#pragma unroll
        for (int ds = 0; ds < 2; ++ds)
#pragma unroll
            for (int i4 = 0; i4 < 4; ++i4) { const int d = ds * 32 + i4 * 8 + 4 * hi; const size_t off = (size_t)tok * 1024 + hh * 64 + d;
                const f32x4 oc = *(const f32x4*)(ocmp + off);
                const float r0 = g0 * oc.x + g1 * Os[ds][i4 * 4 + 0] + g2 * Ow[ds][i4 * 4 + 0], r1 = g0 * oc.y + g1 * Os[ds][i4 * 4 + 1] + g2 * Ow[ds][i4 * 4 + 1];
                const float r2 = g0 * oc.z + g1 * Os[ds][i4 * 4 + 2] + g2 * Ow[ds][i4 * 4 + 2], r3 = g0 * oc.w + g1 * Os[ds][i4 * 4 + 3] + g2 * Ow[ds][i4 * 4 + 3];
                u32x2 w; w.x = pk2(r0, r1); w.y = pk2(r2, r3); *(u32x2*)(ob + (size_t)tok * KCAT + 512 + hh * 64 + d) = w; }
    }
    __syncthreads();
}

__device__ __forceinline__ void phase_diff_mfma(const PT a, int lyr, unsigned char* ldsb, int tid, int lane, int wave, int bid, int nblk) {
    unsigned char* ws = a.ws(); const bf16* proj = (const bf16*)(ws + WS_PROJ); const float* biasT = (const float*)(ws + WS_BIAST); bf16* oc = (bf16*)(ws + WS_OA);
    const float* lv = a.in(9) + (size_t)lyr * 256; const float* sg = a.in(10) + (size_t)lyr * 128;
    const float lam_init = 0.8f - 0.6f * expf(-0.3f * (float)lyr);
    const float lam = expf(wave_sum(lv[lane] * lv[64 + lane])) - expf(wave_sum(lv[128 + lane] * lv[192 + lane])) + lam_init;
    bf16* Ks = (bf16*)ldsb; bf16* Vt = (bf16*)(ldsb + 17408); float* tab = (float*)(ldsb + 69632); unsigned char* bk = ldsb + 77824; float* sgl = (float*)(ldsb + 79872); float* O2 = (float*)ldsb;
    const int l32 = lane & 31, hi = lane >> 5, mp = wave >> 2, wq = wave & 3;
    int hcur = -1;
    __syncthreads();
    if (tid < 128) sgl[tid] = sg[tid];
    for (int u = bid; u < 512; u += nblk) {
        const int bh = u & 31, b = bh >> 3, h = bh & 7, qt = u < 256 ? 15 - (u >> 5) : ((u - 256) >> 5);
        if (h != hcur) { __syncthreads(); for (int i = tid; i < 2048; i += 512) { tab[i] = biasT[(40 + h) * BT + i] * LOG2E; bk[i] = (unsigned char)t5_bucket(i); } hcur = h; }
        const int t0 = qt * 128, tq = t0 + wq * 32 + l32, tok = b * SEQ + tq;
        const bf16* base_b = proj + (size_t)b * SEQ * NP;
        bf16x8 qf[4]; load_qfrag(proj + (size_t)tok * NP + OFF_CQ + (h * 2 + mp) * 64, hi, qf, QSCALE2);
        f32x16 O[4]; float m = -1e30f, l = 0.f;
#pragma unroll
        for (int ds = 0; ds < 4; ++ds)
#pragma unroll
            for (int i = 0; i < 16; ++i) O[ds][i] = 0.f;
        attn_pass<128, 4, 17408, false>(range_mask(0, (t0 + 127) >> 6), base_b, 0, 1, OFF_CK + h * 128, OFF_CV + h * 128, Ks, Vt, mp * 64, qf, m, l, O, tab, bk, tq, 1 << 20, 0xffffffffu, t0 + wq * 32 + 31, -(1 << 20), tid, l32, hi);
        const float inv = 1.0f / (l + __shfl_xor(l, 32));
        __syncthreads();
        if (mp == 1) {
#pragma unroll
            for (int ds = 0; ds < 4; ++ds)
#pragma unroll
                for (int i = 0; i < 16; ++i) O2[(ds * 16 + i) * 256 + wq * 64 + lane] = O[ds][i] * inv;
        }
        __syncthreads();
        if (mp == 0) {
            float ss = 0.f;
#pragma unroll
            for (int ds = 0; ds < 4; ++ds)
#pragma unroll
                for (int i = 0; i < 16; ++i) { const float o = O[ds][i] * inv - lam * O2[(ds * 16 + i) * 256 + wq * 64 + lane]; O[ds][i] = o; ss += o * o; }
            ss += __shfl_xor(ss, 32);
            const float r = (1.0f - lam_init) / sqrtf(ss * (1.0f / 128.0f) + 1e-6f);
#pragma unroll
            for (int ds = 0; ds < 4; ++ds)
#pragma unroll
                for (int i4 = 0; i4 < 4; ++i4) { const int d = ds * 32 + i4 * 8 + 4 * hi; const f32x4 gn = *(const f32x4*)(sgl + d);
                    u32x2 w; w.x = pkh(O[ds][i4 * 4 + 0] * r * gn.x, O[ds][i4 * 4 + 1] * r * gn.y); w.y = pkh(O[ds][i4 * 4 + 2] * r * gn.z, O[ds][i4 * 4 + 3] * r * gn.w);
                    *(u32x2*)(oc + (size_t)tok * KCAT + 1536 + h * 128 + d) = w; }
        }
        __syncthreads();
    }
}


constexpr size_t WS_OAG = WS_MIXF, WS_LSE = WS_MIXB;
__device__ __forceinline__ void phase_dilated_mfma(const PT a, unsigned char* ldsb, int tid, int lane, int wave, int bid, int nblk) {
    unsigned char* ws = a.ws(); const bf16* proj = (const bf16*)(ws + WS_PROJ); const float* biasT = (const float*)(ws + WS_BIAST);
    float* oag = (float*)(ws + WS_OAG); float* lseb = (float*)(ws + WS_LSE);
    bf16* Ks = (bf16*)ldsb; bf16* Vt = (bf16*)(ldsb + 9216); float* tab = (float*)(ldsb + 36864);
    const int l32 = lane & 31, hi = lane >> 5;
    const int nh = (nblk > 64) ? nblk - 64 : nblk, hb = (nblk > 64) ? bid - 64 : bid;
    const int n_heavy_mine = (hb >= 0) ? (512 - hb + nh - 1) / nh : 0;
    const int n_light_mine = (512 - bid + nblk - 1) / nblk;
    for (int it = 0; it < n_heavy_mine + n_light_mine; ++it) {
        const int u = it < n_heavy_mine ? hb + it * nh : 512 + bid + (it - n_heavy_mine) * nblk;
        int g, b, h, r, i0, nq;
        if (u < 256) { g = 0; b = u >> 6; h = (u >> 3) & 7; r = 0; i0 = (u & 7) * 256; nq = 256; }
        else if (u < 512) { const int v = u - 256; g = 1; b = v >> 6; h = (v >> 3) & 7; r = (v >> 1) & 3; i0 = (v & 1) * 256; nq = 256; }
        else { const int v = u - 512; g = 2; b = v >> 7; h = (v >> 4) & 7; r = v & 15; i0 = 0; nq = 128; }
        const int dil = 1 << (2 * g);
        __syncthreads();
        if (tid < 129) tab[tid] = biasT[(g * 8 + h) * BT + tid * dil] * LOG2E;
        const bool act = wave * 32 < nq;
        const int iq = i0 + ((wave * 32) % nq) + l32, tok = b * SEQ + r + dil * iq;
        const bf16* base_b = proj + (size_t)b * SEQ * NP;
        bf16x8 qf[4]; load_qfrag(proj + (size_t)tok * NP + (g * 8 + h) * 64, hi, qf, QSCALE2);
        f32x16 O[2]; float m = -1e30f, l = 0.f;
#pragma unroll
        for (int ds = 0; ds < 2; ++ds)
#pragma unroll
            for (int i = 0; i < 16; ++i) O[ds][i] = 0.f;
        const int wq0 = i0 + wave * 32;
        attn_pass<64, 2, 8960, true>(range_mask((i0 - 128 > 0 ? i0 - 128 : 0) >> 6, (i0 + nq - 1) >> 6), base_b, r, dil, ((3 + g) * 8 + h) * 64, ((6 + g) * 8 + h) * 64, Ks, Vt, 0, qf, m, l, O, tab, (const unsigned char*)nullptr, iq, 128, 0xffffffffu,
                         act ? wq0 + 31 : -1, wq0 - 128, tid, l32, hi);
        if (act) {
            const float lt = l + __shfl_xor(l, 32), inv = 1.0f / lt;
            float* op = oag + ((size_t)g * M + tok) * 512 + h * 64;
#pragma unroll
            for (int ds = 0; ds < 2; ++ds)
#pragma unroll
                for (int i4 = 0; i4 < 4; ++i4) { f32x4 v; v.x = O[ds][i4 * 4 + 0] * inv; v.y = O[ds][i4 * 4 + 1] * inv; v.z = O[ds][i4 * 4 + 2] * inv; v.w = O[ds][i4 * 4 + 3] * inv;
                    *(f32x4*)(op + ds * 32 + i4 * 8 + 4 * hi) = v; }
            if (hi == 0) lseb[((size_t)g * M + tok) * 8 + h] = (m + __log2f(lt)) * 0.6931471805599453f;
        }
    }
    __syncthreads();
}
__device__ __forceinline__ void phase_dil_combine(const PT a, int lane, int gw, int ngw) {
    unsigned char* ws = a.ws(); const float* oag = (const float*)(ws + WS_OAG); const float* lseb = (const float*)(ws + WS_LSE); bf16* oa = (bf16*)(ws + WS_OA);
    for (int tok = gw; tok < M; tok += ngw) {
        const int h = lane >> 3;
        const float l0 = lseb[((size_t)0 * M + tok) * 8 + h], l1 = lseb[((size_t)1 * M + tok) * 8 + h], l2 = lseb[((size_t)2 * M + tok) * 8 + h];
        const float mx = fmaxf(l0, fmaxf(l1, l2)); float w0 = __expf(l0 - mx), w1 = __expf(l1 - mx), w2 = __expf(l2 - mx); const float iw = 1.0f / (w0 + w1 + w2); w0 *= iw; w1 *= iw; w2 *= iw;
        const f32x4* p0 = (const f32x4*)(oag + ((size_t)0 * M + tok) * 512 + lane * 8); const f32x4* p1 = (const f32x4*)(oag + ((size_t)1 * M + tok) * 512 + lane * 8); const f32x4* p2 = (const f32x4*)(oag + ((size_t)2 * M + tok) * 512 + lane * 8);
        const f32x4 x0 = w0 * p0[0] + w1 * p1[0] + w2 * p2[0], x1 = w0 * p0[1] + w1 * p1[1] + w2 * p2[1];
        u32x4 o; o.x = pk2(x0.x, x0.y); o.y = pk2(x0.z, x0.w); o.z = pk2(x1.x, x1.y); o.w = pk2(x1.z, x1.w);
        *(u32x4*)(oa + (size_t)tok * KCAT + lane * 8) = o;
    }
}


__device__ __forceinline__ void phase_compress_mfma(const PT a, int lyr, unsigned char* ldsb, int tid, int lane, int wave, int bid, int nblk) {
    unsigned char* ws = a.ws(); const bf16* proj = (const bf16*)(ws + WS_PROJ);
    unsigned char* cw = ws + WS_CW + (size_t)lyr * 4 * MiB;
    bf16* Ab = (bf16*)ldsb; float* RED = (float*)(ldsb + 17408);
    const int l32 = lane & 31, hi = lane >> 5;
    __syncthreads();
    for (int u = bid; u < 64; u += nblk) {
        const int kv = u >> 5, rg = u & 31;
        const bf16* W1t = (const bf16*)(cw + (size_t)kv * MiB); const bf16* W2t = (const bf16*)(cw + 2 * MiB + (size_t)kv * 65536);
        const float* pos = a.in(3 + kv) + (size_t)lyr * 2048; float* dst = (float*)(ws + (kv ? WS_VC : WS_KC));
        f32x16 acc;
#pragma unroll
        for (int i = 0; i < 16; ++i) acc[i] = 0.f;
        const bf16* wrow = W1t + (size_t)(32 * wave + l32) * 2048 + hi * 8;
#pragma unroll 1
        for (int kc = 0; kc < 8; ++kc) {
            bf16x8 af[16];
#pragma unroll
            for (int kk = 0; kk < 16; ++kk) af[kk] = *(const bf16x8*)(wrow + kc * 256 + kk * 16);
            __syncthreads();
#pragma unroll
            for (int r2 = 0; r2 < 2; ++r2) { const int idx = tid + 512 * r2, row = idx >> 5, ch = idx & 31; int r = rg * 32 + row; r = r < 1016 ? r : 1015;
                const int g = r & 1, bn = r >> 1, b = bn / NCMP, n = bn % NCMP, ll = kc * 4 + (ch >> 3), d = (ch & 7) * 8;
                const u32x4 w = *(const u32x4*)(proj + (size_t)(b * SEQ + 16 * n + ll) * NP + OFF_BKV + (kv * 2 + g) * 64 + d);
                const f32x4 p0 = *(const f32x4*)(pos + ll * 64 + d), p1 = *(const f32x4*)(pos + ll * 64 + d + 4);
                u32x4 o; o.x = pk2(bf_lo(w.x) + p0.x, bf_hi(w.x) + p0.y); o.y = pk2(bf_lo(w.y) + p0.z, bf_hi(w.y) + p0.w); o.z = pk2(bf_lo(w.z) + p1.x, bf_hi(w.z) + p1.y); o.w = pk2(bf_lo(w.w) + p1.z, bf_hi(w.w) + p1.w);
                *(u32x4*)(Ab + row * 264 + ch * 8) = o; }
            __syncthreads();
#pragma unroll
            for (int kk = 0; kk < 16; ++kk) { const bf16x8 bfr = *(const bf16x8*)(Ab + l32 * 264 + kk * 16 + hi * 8); acc = MFMA32(af[kk], bfr, acc); }
        }
#pragma unroll
        for (int i = 0; i < 16; ++i) { const float v = acc[i]; acc[i] = 0.5f * v * (1.0f + tanhf(0.7978845608028654f * (v + 0.044715f * v * v * v))); }
        f32x16 o2[2];
#pragma unroll
        for (int ds = 0; ds < 2; ++ds)
#pragma unroll
            for (int i = 0; i < 16; ++i) o2[ds][i] = 0.f;
#pragma unroll
        for (int c2 = 0; c2 < 2; ++c2) { u32x4 pw; pw.x = pk2(acc[8 * c2 + 0], acc[8 * c2 + 1]); pw.y = pk2(acc[8 * c2 + 2], acc[8 * c2 + 3]); pw.z = pk2(acc[8 * c2 + 4], acc[8 * c2 + 5]); pw.w = pk2(acc[8 * c2 + 6], acc[8 * c2 + 7]);
            const bf16x8 hb = __builtin_bit_cast(bf16x8, pw);
#pragma unroll
            for (int ds = 0; ds < 2; ++ds) { const bf16* wp = W2t + (size_t)(ds * 32 + l32) * 256 + 32 * wave + 16 * c2 + 4 * hi;
                const u32x2 lo = *(const u32x2*)wp, hi2 = *(const u32x2*)(wp + 8); u32x4 vw; vw.x = lo.x; vw.y = lo.y; vw.z = hi2.x; vw.w = hi2.y;
                o2[ds] = MFMA32(__builtin_bit_cast(bf16x8, vw), hb, o2[ds]); } }
#pragma unroll
        for (int ds = 0; ds < 2; ++ds)
#pragma unroll
            for (int i = 0; i < 16; ++i) RED[(wave * 64 + ds * 32 + (i >> 2) * 8 + 4 * hi + (i & 3)) * 33 + l32] = o2[ds][i];
        __syncthreads();
#pragma unroll
        for (int e = 0; e < 4; ++e) { const int idx = tid + 512 * e, d = idx & 63, row = idx >> 6; float s = 0.f;
#pragma unroll
            for (int w = 0; w < 8; ++w) s += RED[(w * 64 + d) * 33 + row];
            const int r = rg * 32 + row; if (r < 1016) dst[(size_t)r * 64 + d] = s; }
        __syncthreads();
    }
}

#define XB_TMO      128
#define XB_XCNT(j)  (256  + 64 * (j))
#define XB_XSUB(j)  (1280 + 64 * (j))
#define XB_XGEN(j)  (2304 + 64 * (j))
#define XB_TOP      3328
#define XB_TOPGEN   3392
#define XCD_BAR_WORDS 3456
#define XB_SPIN_CAP (1u << 18)

__device__ __forceinline__ unsigned xb_ld(unsigned* p)              { return __hip_atomic_load(p, __ATOMIC_RELAXED, __HIP_MEMORY_SCOPE_AGENT); }
__device__ __forceinline__ unsigned xb_add(unsigned* p, unsigned v) { return __hip_atomic_fetch_add(p, v, __ATOMIC_RELAXED, __HIP_MEMORY_SCOPE_AGENT); }
__device__ __forceinline__ unsigned xb_xcc_id() { return (unsigned)__builtin_amdgcn_s_getreg((3 << 11) | 20) & 0xFu; }
#define XB_SPIN(cond, bar) do { unsigned _sp = 0; while (cond) { __builtin_amdgcn_s_sleep(1); \
    if ((++_sp & 255u) == 0u) { if (xb_ld(&(bar)[XB_TMO])) break; if (_sp > XB_SPIN_CAP) { atomicAdd(&(bar)[XB_TMO], 1u); break; } } } } while (0)

struct XcdBarrier {
    unsigned* bar; unsigned x;
    volatile LAS unsigned* st;
};

__device__ __forceinline__ XcdBarrier xcd_barrier_post(unsigned* bar, volatile LAS unsigned* st) {
    XcdBarrier b; b.bar = bar; b.x = xb_xcc_id(); b.st = st;
    if (threadIdx.x == 0) (void)xb_add(&bar[XB_XCNT(b.x)], 1u);
    return b;
}
__device__ __forceinline__ void xcd_barrier_complete(unsigned* bar, unsigned x, unsigned& nloc, unsigned& nx) {
    const unsigned G = gridDim.x * gridDim.y * gridDim.z;
    unsigned sum, cnt, mine, sp = 0u;
    for (;;) {
        sum = 0u; cnt = 0u; mine = 0u;
#pragma unroll
        for (unsigned j = 0; j < 16; ++j) { const unsigned c = xb_ld(&bar[XB_XCNT(j)]); sum += c; cnt += (c > 0u) ? 1u : 0u; mine = (j == x) ? c : mine; }
        if (sum == G) break;
        __builtin_amdgcn_s_sleep(1);
        if ((++sp & 255u) == 0u) { if (xb_ld(&bar[XB_TMO])) break; if (sp > XB_SPIN_CAP) { atomicAdd(&bar[XB_TMO], 1u); break; } }
    }
    nloc = mine > 0u ? mine : 1u; nx = cnt > 0u ? cnt : 1u;
}

__device__ __forceinline__ void xcd_barrier(const XcdBarrier& b) {
    asm volatile("s_waitcnt vmcnt(0)" ::: "memory");
    __syncthreads();
    if (threadIdx.x == 0) {
        unsigned* bar = b.bar;
        __builtin_amdgcn_s_waitcnt(0);
        unsigned nloc = b.st[0], nx = b.st[1];
        if (nloc == 0u) { xcd_barrier_complete(bar, b.x, nloc, nx); b.st[0] = nloc; b.st[1] = nx; }
        const unsigned old = xb_add(&bar[XB_XSUB(b.x)], 1u);
        const unsigned gen = old / nloc;
        if (old + 1u == (gen + 1u) * nloc) {
            __builtin_amdgcn_fence(__ATOMIC_RELEASE, "agent");
            asm volatile("s_waitcnt vmcnt(0)" ::: "memory");
            const unsigned og = xb_add(&bar[XB_TOP], 1u);
            const unsigned tg = og / nx;
            if (og + 1u == (tg + 1u) * nx) xb_add(&bar[XB_TOPGEN], 1u);
            else XB_SPIN(xb_ld(&bar[XB_TOPGEN]) == tg, bar);
            __builtin_amdgcn_fence(__ATOMIC_ACQUIRE, "agent");
            xb_add(&bar[XB_XGEN(b.x)], 1u);
            asm volatile("s_waitcnt vmcnt(0)" ::: "memory");
        } else {
            XB_SPIN(xb_ld(&bar[XB_XGEN(b.x)]) == gen, bar);
            __builtin_amdgcn_fence(__ATOMIC_ACQUIRE, "agent");
            asm volatile("s_waitcnt vmcnt(0)" ::: "memory");
        }
    }
    __syncthreads();
}

__global__ void __launch_bounds__(512, 2) mega_fwd(Args ka) {
    extern __shared__ __attribute__((aligned(16))) unsigned char lds[];
    LAS unsigned char* ldsl = (LAS unsigned char*)lds;
    const int tid0 = threadIdx.x;
    {
        unsigned long long* pt = (unsigned long long*)(lds + PTAB_OFF);
        if (tid0 < 21) pt[tid0] = (unsigned long long)ka.in[tid0];
        if (tid0 == 21) pt[21] = (unsigned long long)ka.out;
        if (tid0 == 22) pt[22] = (unsigned long long)ka.ws;
        if (tid0 == 23) { pt[32] = 0ull; }
        __syncthreads();
    }
    const int ph_lo = ka.ph_lo, ph_hi = ka.ph_hi;
    cg::grid_group grid = cg::this_grid();
    (void)xcd_barrier_post((unsigned*)(__attribute__((address_space(1))) unsigned*)(ka.ws + WS_BAR), (volatile LAS unsigned*)(ldsl + PTAB_OFF + 256));
    for (int ph = ph_lo; ph < ph_hi; ++ph) {
        unsigned ldso0 = 0; asm volatile("" : "+s"(ldso0));
        const PT a{(const unsigned long long*)(lds + PTAB_OFF + ldso0)};
        if (ph == 0) { int tidp = tid0; asm volatile("" : "+v"(tidp)); const int lanep = tidp & 63, wavep = __builtin_amdgcn_readfirstlane(tidp >> 6);
            phase_prologue(a, (float*)(lds + ldso0), lanep, wavep, (int)blockIdx.x * 8 + wavep, (int)gridDim.x * 8); }
        else {
            const int l = (ph - 1) / PH_PER_LAYER; int k = (ph - 1) % PH_PER_LAYER; if (k >= 2) k += 1;
            unsigned char* ws = a.ws();
            unsigned char* wl = ws + WS_WT + (size_t)l * LAYER_W;
            bf16* H = (bf16*)(ws + WS_H); bf16* proj = (bf16*)(ws + WS_PROJ);
            int njobs = 0, mode0 = 0, N = 0, K = 0; const bf16* A0 = nullptr; const bf16* B0 = nullptr; bf16* ob = nullptr; float* of = nullptr;
            if (k == 0) { njobs = 1; mode0 = 0; A0 = H; B0 = (const bf16*)(wl + WO_IN); N = NP; K = DM; ob = proj; }
            else if (k == 4) { njobs = 1; mode0 = 6; A0 = (const bf16*)(ws + WS_OA); B0 = (const bf16*)(wl + WO_A); N = DM; K = KCAT; ob = (bf16*)(ws + WS_MIXB); }
            else if (k == 5) { njobs = 1; mode0 = 4; A0 = (const bf16*)(ws + WS_MIXB); B0 = (const bf16*)(wl + WO_OUT); N = DM; K = DM; ob = (bf16*)(ws + WS_Y); }
            else if (k == 7) { njobs = 1; mode0 = 5; A0 = H; B0 = (const bf16*)(wl + WO_UP); N = DFF; K = DM; ob = (bf16*)(ws + WS_U); }
            else if (k == 8) { njobs = 1; mode0 = 4; A0 = (const bf16*)(ws + WS_U); B0 = (const bf16*)(wl + WO_DOWN); N = DM; K = DFF; ob = (bf16*)(ws + WS_Y); }
            for (int j = 0; j < njobs; ++j) {
                const bf16* A = A0; const bf16* B = B0; int Kj = K;
                pg8::Gemm g{A, B, M, N, Kj}; pg8::StaticOrder S; S.init(M, N, (int)gridDim.x, (int)blockIdx.x);
                EpiAny E{mode0 + j, ob, of, proj};
                pg8::gemm_phase<EpiAny, pg8::StaticOrder, true, true>(ldsl, g, S, E);
            }
            int tid = tid0; asm volatile("" : "+v"(tid));
            int bid = (int)blockIdx.x, nblk = (int)gridDim.x; asm volatile("" : "+s"(bid), "+s"(nblk));
            unsigned ldso = 0; asm volatile("" : "+s"(ldso));
            float* ldsf = (float*)(lds + ldso);
            const int lane = tid & 63, wave = __builtin_amdgcn_readfirstlane(tid >> 6);
            const int gw = bid * 8 + wave, ngw = nblk * 8;
            if (k == 1) {
                for (int rep = 0; rep < ((PROBE_SUB & 1) ? 2 : 1); ++rep) { asm volatile("" : "+v"(tid), "+s"(bid)); phase_compress_mfma(a, l, (unsigned char*)ldsf, tid, tid & 63, __builtin_amdgcn_readfirstlane(tid >> 6), bid, nblk); }
                for (int rep = 0; rep < ((PROBE_SUB & 2) ? 2 : 1); ++rep) { asm volatile("" : "+v"(tid), "+s"(bid)); phase_dilated_mfma(a, (unsigned char*)ldsf, tid, tid & 63, __builtin_amdgcn_readfirstlane(tid >> 6), bid, nblk); }
                for (int rep = 0; rep < ((PROBE_SUB & 4) ? 2 : 1); ++rep) { asm volatile("" : "+v"(tid), "+s"(bid)); phase_diff_mfma(a, l, (unsigned char*)ldsf, tid, tid & 63, __builtin_amdgcn_readfirstlane(tid >> 6), bid, nblk); } }
            else if (k == 3) { phase_dil_combine(a, lane, gw, ngw); phase_nsa_mfma(a, (unsigned char*)ldsf, tid, lane, wave, bid, nblk); }
            else if (k == 6) { float* xo = a.out(); const float* xi = (l == 0) ? a.in(0) : xo;
                for (int m = gw; m < M; m += ngw) rowpass_row(xi + (size_t)m * DM, (const bf16*)(ws + WS_Y) + (size_t)m * DM, a.in(16) + (size_t)l * DM, a.in(17) + (size_t)l * DM, xo + (size_t)m * DM, H + (size_t)m * DM, lane); }
            else if (k == 9) { float* xo = a.out(); const float* gn = (l + 1 < DEPTH) ? a.in(15) + (size_t)(l + 1) * DM : nullptr;
                for (int m = gw; m < M; m += ngw) rowpass_row(xo + (size_t)m * DM, (const bf16*)(ws + WS_Y) + (size_t)m * DM, a.in(18) + (size_t)l * DM, gn, xo + (size_t)m * DM, H + (size_t)m * DM, lane); }
        }
        if (ph + 1 < ph_hi) { XcdBarrier xbar; xbar.bar = (unsigned*)(a.ws() + WS_BAR); xbar.x = xb_xcc_id(); xbar.st = (volatile LAS unsigned*)(ldsl + PTAB_OFF + 256); xcd_barrier(xbar); }
        if (ph_hi > 100000) grid.sync();
    }
}

#ifndef N_LAUNCH_SPLIT
#define N_LAUNCH_SPLIT 0
#endif
extern "C" void kernel_launch(void* const* d_in, const int* in_sizes, int n_in, void* d_out, int out_size, void* d_ws, size_t ws_size, hipStream_t stream) {
    static int grid = 0;
    if (grid == 0) {
        if (n_in != 21 || out_size != M * DM || ws_size < WS_END) { fprintf(stderr, "kernel_launch: unexpected shapes (n_in %d out %d ws %zu)\n", n_in, out_size, ws_size); grid = -1; return; }
        int dev = 0, cus = 0, per_cu = 0;
        (void)hipGetDevice(&dev); (void)hipDeviceGetAttribute(&cus, hipDeviceAttributeMultiprocessorCount, dev);
        if (hipFuncSetAttribute((const void*)mega_fwd, hipFuncAttributeMaxDynamicSharedMemorySize, LDS_BYTES) != hipSuccess) { fprintf(stderr, "hipFuncSetAttribute failed\n"); grid = -1; return; }
        if (hipOccupancyMaxActiveBlocksPerMultiprocessor(&per_cu, (const void*)mega_fwd, 512, LDS_BYTES) != hipSuccess || per_cu < 1) { fprintf(stderr, "occupancy query: %d\n", per_cu); per_cu = 1; }
        (void)hipGetLastError();
        grid = cus > 0 ? cus : 256;
    }
    if (grid < 0) return;
    if (hipMemsetAsync((char*)d_ws + WS_BAR, 0, 16384, stream) != hipSuccess) { fprintf(stderr, "kernel_launch: memset of the barrier words failed\n"); return; }
    Args a{};
    for (int i = 0; i < 21; ++i) a.in[i] = (const float*)d_in[i];
    a.out = (float*)d_out; a.ws = (unsigned char*)d_ws;
#if N_LAUNCH_SPLIT
    for (int ph = 0; ph < NPH; ++ph) { a.ph_lo = ph; a.ph_hi = ph + 1; hipLaunchKernelGGL(mega_fwd, dim3(grid), dim3(512), LDS_BYTES, stream, a); }
#else
    a.ph_lo = 0; a.ph_hi = NPH;
    void* args[] = {&a};
    hipError_t e = hipLaunchCooperativeKernel((const void*)mega_fwd, dim3(grid), dim3(512), args, LDS_BYTES, stream);
    if (e != hipSuccess) fprintf(stderr, "cooperative launch failed: %s (grid %d)\n", hipGetErrorString(e), grid);
#endif
}
```

```cpp
#include <hip/hip_runtime.h>
#include <hip/hip_cooperative_groups.h>
#include <cstdio>
#include <cstdint>
namespace cg = cooperative_groups;
namespace pg8 {
#define PG8_LAS __attribute__((address_space(3)))
typedef unsigned short bf16_t;
typedef short bf16x8 __attribute__((ext_vector_type(8)));
typedef float f32x4 __attribute__((ext_vector_type(4)));
typedef unsigned u32x4 __attribute__((ext_vector_type(4)));
constexpr int BM = 256, BK = 64, HALF = 128, HTB = HALF * BK * 2  , STAGE_BYTES = 8 * HTB, NXCD = 8, WGM = 8;

__host__ __device__ __forceinline__ int lds_byte(int r, int c) { const int st = (r >> 4) * 2 + (c >> 5), rr = r & 15, cc = c & 31, ob = rr * 64 + cc * 2; return st * 1024 + (ob ^ (((ob >> 9) & 1) << 5)); }
__host__ __device__ __forceinline__ void stage_rc(int b, int& R, int& C) { const int st = b / 1024, sb = b % 1024, swz = sb ^ (((sb >> 9) & 1) << 5); R = (st >> 1) * 16 + swz / 64; C = (st & 1) * 32 + (swz % 64) / 2; }
__host__ __device__ __forceinline__ int perm32(int rho) { const int n = rho >> 4, i = rho & 15; return 8 * (i >> 2) + 4 * n + (i & 3); }

struct Unit { int pm, pn; };
struct Gemm { const bf16_t* A; const bf16_t* Bt; int M, N, K; };

struct StaticOrder {
    int nM, nN, nwg, G, c;
    __host__ __device__ void init(int M, int N, int G_, int c_) { nM = M / BM; nN = N / BM; nwg = nM * nN; G = G_; c = c_; }
    __host__ __device__ bool next(int i, Unit& u) const {
        const long L = (long)i * G + c; if (L >= nwg) return false;
        int wgid = (int)L; { const int q = nwg / NXCD, r = nwg % NXCD, xcd = wgid % NXCD, off = wgid / NXCD; wgid = (xcd < r ? xcd * (q + 1) : r * (q + 1) + (xcd - r) * q) + off; }
        const int nig = WGM * nN, gid = wgid / nig, fm = gid * WGM, gsz = (nM - fm) < WGM ? (nM - fm) : WGM;
        u.pm = fm + ((wgid % nig) % gsz); u.pn = (wgid % nig) / gsz; return true;
    }
    __device__ __forceinline__ void a_ready(const Unit&) const {}
    __device__ __forceinline__ void done(const Unit&) const {}
};

__device__ __forceinline__ unsigned cvt_pk_bf16(float lo, float hi) { unsigned r; asm volatile("v_cvt_pk_bf16_f32 %0, %1, %2" : "=v"(r) : "v"(lo), "v"(hi)); return r; }
typedef float f32x2 __attribute__((ext_vector_type(2)));
template <class Epi, class Sched, bool ALIGN_EPI = false, bool SP2 = false>
__device__ __forceinline__ void gemm_phase(PG8_LAS unsigned char* lds, const Gemm g, const Sched& S, const Epi& E) {
    const int tid = threadIdx.x, wid = __builtin_amdgcn_readfirstlane(tid >> 6), lane = tid & 63, wr = wid >> 2, wc = wid & 3, fr = lane & 15, fq = lane >> 4;
    const int K = g.K, nt = K / BK;
    unsigned voffA[2], voffB[2];
#pragma unroll
    for (int i = 0; i < 2; ++i) { int R, C; stage_rc(tid * 16 + i * 8192, R, C); const int Rb = Epi::PERM ? ((R & ~31) + perm32(R & 31)) : R;
        voffA[i] = (unsigned)(R * K + C) * 2u; voffB[i] = (unsigned)(Rb * K + C) * 2u; }
    const size_t kstep = (size_t)(BK * 2);
    const size_t hstep = (size_t)HALF * K * 2;
    const size_t tstep = 2 * hstep;
    const unsigned ldsw = (unsigned)wid * 1024u;
    const int aoff = lds_byte(wr * 64 + fr, fq * 8), boff = lds_byte(wc * 32 + fr, fq * 8);
#define PG8_SA(b, h) (((b) * 2 + (h)) * HTB)
#define PG8_SB(b, h) ((4 + (b) * 2 + (h)) * HTB)
#define PG8_STAGE(bufoff, gbase, voff) do { _Pragma("unroll") for (int _i = 0; _i < 2; ++_i) \
        __builtin_amdgcn_global_load_lds((const unsigned*)((const char*)(gbase) + (voff)[_i]), (PG8_LAS unsigned*)(lds + (bufoff) + ldsw + _i * 8192), 16, 0, 0); } while (0)
#define PG8_LDA(dst, b, h) do { _Pragma("unroll") for (int m = 0; m < 4; ++m) _Pragma("unroll") for (int k = 0; k < 2; ++k) dst[m][k] = *(const PG8_LAS bf16x8*)(lds + PG8_SA(b, h) + aoff + m * 2048 + k * 1024); } while (0)
#define PG8_LDB(dst, b, h) do { _Pragma("unroll") for (int n = 0; n < 2; ++n) _Pragma("unroll") for (int k = 0; k < 2; ++k) dst[n][k] = *(const PG8_LAS bf16x8*)(lds + PG8_SB(b, h) + boff + n * 2048 + k * 1024); } while (0)
#define PG8_MMA(ai, bj, At, Bt) do { __builtin_amdgcn_s_setprio(1); _Pragma("unroll") for (int m = 0; m < 4; ++m) _Pragma("unroll") for (int n = 0; n < 2; ++n) _Pragma("unroll") for (int k = 0; k < 2; ++k) \
        acc[ai][bj][m][n] = __builtin_amdgcn_mfma_f32_16x16x32_bf16(Bt[n][k], At[m][k], acc[ai][bj][m][n], 0, 0, 0); __builtin_amdgcn_s_setprio(0); } while (0)
#define PG8_WAIT_V(n) asm volatile("s_waitcnt vmcnt(" #n ")" ::: "memory")
#define PG8_WAIT_L(n) asm volatile("s_waitcnt lgkmcnt(" #n ")" ::: "memory")
#define PG8_BAR __builtin_amdgcn_s_barrier()
#define PG8_SCHED __builtin_amdgcn_sched_barrier(0)
    Unit cur, nxt; int ui = 0;
    if (!S.next(0, cur)) return;
    f32x4 acc[2][2][4][2];
#pragma unroll
    for (int a = 0; a < 2; ++a)
#pragma unroll
        for (int b = 0; b < 2; ++b)
#pragma unroll
            for (int m = 0; m < 4; ++m)
#pragma unroll
                for (int n = 0; n < 2; ++n) acc[a][b][m][n] = (f32x4){0.f, 0.f, 0.f, 0.f};
    bf16x8 At[4][2], B0[2][2], B1[2][2];
    const char* cA = (const char*)g.A + (size_t)cur.pm * tstep; const char* cB = (const char*)g.Bt + (size_t)cur.pn * tstep;
    S.a_ready(cur);
    if constexpr (SP2) {
        PG8_STAGE(PG8_SB(0, 0), cB, voffB); PG8_STAGE(PG8_SB(0, 1), cB + hstep, voffB); PG8_STAGE(PG8_SA(0, 0), cA, voffA); PG8_STAGE(PG8_SA(0, 1), cA + hstep, voffA);
        if (wr == 1) PG8_BAR;
        PG8_WAIT_V(2); PG8_BAR;
        PG8_STAGE(PG8_SB(1, 0), cB + kstep, voffB); PG8_STAGE(PG8_SA(1, 0), cA + kstep, voffA); PG8_STAGE(PG8_SB(1, 1), cB + hstep + kstep, voffB);
        PG8_WAIT_V(6); PG8_BAR;
    } else {
        PG8_STAGE(PG8_SB(0, 0), cB, voffB); PG8_STAGE(PG8_SA(0, 0), cA, voffA); PG8_STAGE(PG8_SB(0, 1), cB + hstep, voffB); PG8_STAGE(PG8_SA(0, 1), cA + hstep, voffA);
        if (wr == 1) PG8_BAR;
        PG8_WAIT_V(4); PG8_BAR;
        PG8_STAGE(PG8_SB(1, 0), cB + kstep, voffB); PG8_STAGE(PG8_SA(1, 0), cA + kstep, voffA); PG8_STAGE(PG8_SB(1, 1), cB + hstep + kstep, voffB);
        PG8_WAIT_V(6); PG8_BAR;
    }
    for (;;) {
        const bool has_next = S.next(ui + 1, nxt);
        const char* nA = has_next ? (const char*)g.A + (size_t)nxt.pm * tstep : cA; const char* nB = has_next ? (const char*)g.Bt + (size_t)nxt.pn * tstep : cB;
        for (int t = 0; t < nt; t += 2) {
            if constexpr (Epi::KHOOK) { if (E.khook_at(t)) E.khook(acc, cur, t, wr, wc, fr, fq); }
            const bool last = (t == nt - 2);
            const char* a1 = cA + (size_t)(t + 1) * kstep;
            const char* a2 = last ? nA : cA + (size_t)(t + 2) * kstep; const char* b2 = last ? nB : cB + (size_t)(t + 2) * kstep;
            const char* a3 = a2 + kstep; const char* b3 = b2 + kstep;
            if (last && has_next) S.a_ready(nxt);
            if constexpr (SP2) {
            PG8_LDB(B0, 0, 0); PG8_LDB(B1, 0, 1); PG8_SCHED; PG8_LDA(At, 0, 0); PG8_STAGE(PG8_SA(1, 1), a1 + hstep, voffA);
            PG8_WAIT_V(8); PG8_WAIT_L(0); PG8_BAR; PG8_MMA(0, 0, At, B0); PG8_MMA(0, 1, At, B1); PG8_BAR; PG8_SCHED;
            PG8_LDA(At, 0, 1); PG8_STAGE(PG8_SB(0, 0), b2, voffB); PG8_STAGE(PG8_SB(0, 1), b2 + hstep, voffB); PG8_STAGE(PG8_SA(0, 0), a2, voffA);
            PG8_WAIT_V(8); PG8_WAIT_L(0); PG8_BAR; PG8_MMA(1, 0, At, B0); PG8_MMA(1, 1, At, B1); PG8_BAR; PG8_SCHED;
            PG8_LDB(B0, 1, 0); PG8_LDB(B1, 1, 1); PG8_SCHED; PG8_LDA(At, 1, 0); PG8_STAGE(PG8_SA(0, 1), a2 + hstep, voffA);
            PG8_WAIT_V(8); PG8_WAIT_L(0); PG8_BAR; PG8_MMA(0, 0, At, B0); PG8_MMA(0, 1, At, B1); PG8_BAR; PG8_SCHED;
            PG8_LDA(At, 1, 1); PG8_STAGE(PG8_SB(1, 0), b3, voffB); PG8_STAGE(PG8_SB(1, 1), b3 + hstep, voffB); PG8_STAGE(PG8_SA(1, 0), a3, voffA);
            PG8_WAIT_V(8); PG8_WAIT_L(0); PG8_BAR; PG8_MMA(1, 0, At, B0); PG8_MMA(1, 1, At, B1); PG8_BAR; PG8_SCHED;
            } else {
            PG8_LDB(B0, 0, 0); PG8_SCHED; PG8_LDA(At, 0, 0); PG8_STAGE(PG8_SA(1, 1), a1 + hstep, voffA);
            PG8_WAIT_L(8); PG8_BAR; PG8_WAIT_L(0); PG8_MMA(0, 0, At, B0); PG8_BAR; PG8_SCHED;
            PG8_LDB(B1, 0, 1); PG8_STAGE(PG8_SB(0, 0), b2, voffB);
            PG8_BAR; PG8_WAIT_L(0); PG8_MMA(0, 1, At, B1); PG8_BAR;
            PG8_LDA(At, 0, 1); PG8_STAGE(PG8_SA(0, 0), a2, voffA);
            PG8_BAR; PG8_WAIT_L(0); PG8_MMA(1, 0, At, B0); PG8_BAR; PG8_SCHED;
            PG8_STAGE(PG8_SB(0, 1), b2 + hstep, voffB);
            PG8_WAIT_V(6); PG8_BAR; PG8_MMA(1, 1, At, B1); PG8_BAR;
            PG8_LDB(B0, 1, 0); PG8_SCHED; PG8_LDA(At, 1, 0); PG8_STAGE(PG8_SA(0, 1), a2 + hstep, voffA);
            PG8_WAIT_L(8); PG8_BAR; PG8_WAIT_L(0); PG8_MMA(0, 0, At, B0); PG8_BAR; PG8_SCHED;
            PG8_LDB(B1, 1, 1); PG8_STAGE(PG8_SB(1, 0), b3, voffB);
            PG8_BAR; PG8_WAIT_L(0); PG8_MMA(0, 1, At, B1); PG8_BAR;
            PG8_LDA(At, 1, 1); PG8_STAGE(PG8_SA(1, 0), a3, voffA);
            PG8_BAR; PG8_WAIT_L(0); PG8_MMA(1, 0, At, B0); PG8_BAR; PG8_SCHED;
            PG8_STAGE(PG8_SB(1, 1), b3 + hstep, voffB);
            PG8_WAIT_V(6); PG8_BAR; PG8_MMA(1, 1, At, B1); PG8_BAR;
            }
        }
        if constexpr (ALIGN_EPI) { if (wr == 0) PG8_BAR; }
        if constexpr (!Epi::AFTER_DRAIN) { E(acc, cur, wr, wc, fr, fq); S.done(cur); }
        if (!has_next) break;
#pragma unroll
        for (int a = 0; a < 2; ++a)
#pragma unroll
            for (int b = 0; b < 2; ++b)
#pragma unroll
                for (int m = 0; m < 4; ++m)
#pragma unroll
                    for (int n = 0; n < 2; ++n) acc[a][b][m][n] = (f32x4){0.f, 0.f, 0.f, 0.f};
        cur = nxt; cA = nA; cB = nB; ++ui;
        if constexpr (ALIGN_EPI) { if (wr == 1) PG8_BAR; }
    }
    PG8_WAIT_V(0);
    if constexpr (!ALIGN_EPI) { if (wr == 0) PG8_BAR; }
    PG8_BAR;
    if constexpr (Epi::AFTER_DRAIN) { E.fused(acc, cur, wr, wc, fr, fq, lds, wid, lane); S.done(cur); }
#undef PG8_SA
#undef PG8_SB
#undef PG8_STAGE
#undef PG8_LDA
#undef PG8_LDB
#undef PG8_MMA
#undef PG8_WAIT_V
#undef PG8_WAIT_L
#undef PG8_BAR
#undef PG8_SCHED
}
}
#ifndef PROBE_SUB
#define PROBE_SUB 0
#endif
#ifndef PROBE_DUP
#define PROBE_DUP 0
#endif
#ifndef PROBE_DUPK
#define PROBE_DUPK -1
#endif
#ifndef PROBE_PRO
#define PROBE_PRO 0
#endif
#define LAS __attribute__((address_space(3)))
typedef unsigned short bf16;
typedef float f32x4 __attribute__((ext_vector_type(4)));
typedef unsigned u32x4 __attribute__((ext_vector_type(4)));
typedef unsigned u32x2 __attribute__((ext_vector_type(2)));

constexpr int BATCH = 4, SEQ = 2048, DM = 2048, M = BATCH * SEQ, DEPTH = 2;
constexpr int NIN = 15664, NP = 15872, DFF = 8192;
constexpr int OFF_BQ = 4608, OFF_BKV = 5632, OFF_BG = 6400, OFF_CQ = 6448, OFF_CK = 7472, OFF_CV = 8496, OFF_MG = 9520;
constexpr int BT = 2112;
constexpr int NCMP = 127;
constexpr size_t MiB = 1u << 20;
constexpr size_t WS_WT = 0, LAYER_W = 144 * MiB;
constexpr size_t WO_IN = 0, WO_A = 62 * MiB, WO_B = 64 * MiB, WO_C = 68 * MiB, WO_OUT = 72 * MiB, WO_UP = 80 * MiB, WO_DOWN = 112 * MiB;
constexpr size_t WS_H = 288 * MiB, WS_PROJ = 320 * MiB, WS_U = WS_PROJ;
constexpr size_t WS_OA = 568 * MiB, WS_OB = 576 * MiB, WS_OC = 592 * MiB, WS_OCMP = 608 * MiB;
constexpr size_t WS_MIXF = 640 * MiB, WS_MIXB = 704 * MiB, WS_Y = 736 * MiB;
constexpr size_t WS_KC = 800 * MiB, WS_VC = 801 * MiB, WS_SELM = 802 * MiB, WS_BIAST = 803 * MiB, WS_CW = 804 * MiB, WS_BAR = 812 * MiB, WS_END = 813 * MiB;
constexpr int LDS_BYTES = 147456;
constexpr int PH_PER_LAYER = 9;
constexpr int NPH = 1 + DEPTH * PH_PER_LAYER;

struct Args { const float* in[21]; float* out; unsigned char* ws; int ph_lo, ph_hi; };
constexpr int PTAB_OFF = 131072 + 1024;
struct PT { const unsigned long long* t;
    __device__ __forceinline__ unsigned long long get(int i) const { const unsigned long long v = t[i]; const unsigned lo = __builtin_amdgcn_readfirstlane((unsigned)v), hi = __builtin_amdgcn_readfirstlane((unsigned)(v >> 32)); return ((unsigned long long)hi << 32) | lo; }
    __device__ __forceinline__ const float* in(int i) const { return (const float*)(const __attribute__((address_space(1))) float*)get(i); }
    __device__ __forceinline__ float* out() const { return (float*)(__attribute__((address_space(1))) float*)get(21); }
    __device__ __forceinline__ unsigned char* ws() const { return (unsigned char*)(__attribute__((address_space(1))) unsigned char*)get(22); } };

#define LDS_FENCE() asm volatile("s_waitcnt vmcnt(0) lgkmcnt(0)" ::: "memory")

__device__ __forceinline__ unsigned f2bf(float f) { unsigned u = __builtin_bit_cast(unsigned, f); return (u + 0x7fffu + ((u >> 16) & 1u)) >> 16; }
__device__ __forceinline__ unsigned pk2(float lo, float hi) { return f2bf(lo) | (f2bf(hi) << 16); }
typedef __bf16 bf16v2_t __attribute__((ext_vector_type(2)));
typedef float f32v2_t __attribute__((ext_vector_type(2)));
__device__ __forceinline__ unsigned pkh(float lo, float hi) { f32v2_t v; v.x = lo; v.y = hi; return __builtin_bit_cast(unsigned, __builtin_convertvector(v, bf16v2_t)); }
__device__ __forceinline__ float bf_lo(unsigned w) { return __uint_as_float(w << 16); }
__device__ __forceinline__ float bf_hi(unsigned w) { return __uint_as_float(w & 0xffff0000u); }
__device__ __forceinline__ float bf2f(bf16 h) { return __uint_as_float(((unsigned)h) << 16); }
__device__ __forceinline__ float wave_sum(float v) {
#pragma unroll
    for (int o = 32; o >= 1; o >>= 1) v += __shfl_xor(v, o);
    return v;
}
__device__ __forceinline__ float wave_max(float v) {
#pragma unroll
    for (int o = 32; o >= 1; o >>= 1) v = fmaxf(v, __shfl_xor(v, o));
    return v;
}
__device__ __forceinline__ float sigmoidf_(float x) { return 1.0f / (1.0f + __expf(-x)); }

__device__ __forceinline__ void load64(const bf16* p, float (&q)[64]) {
    const u32x4* p4 = (const u32x4*)p;
#pragma unroll
    for (int i = 0; i < 8; ++i) { const u32x4 w = p4[i];
        q[8 * i + 0] = bf_lo(w.x); q[8 * i + 1] = bf_hi(w.x); q[8 * i + 2] = bf_lo(w.y); q[8 * i + 3] = bf_hi(w.y);
        q[8 * i + 4] = bf_lo(w.z); q[8 * i + 5] = bf_hi(w.z); q[8 * i + 6] = bf_lo(w.w); q[8 * i + 7] = bf_hi(w.w); }
}
__device__ __forceinline__ float dot64(const float (&q)[64], const bf16* k) {
    const u32x4* k4 = (const u32x4*)k; float a0 = 0.f, a1 = 0.f;
#pragma unroll
    for (int i = 0; i < 8; ++i) { const u32x4 w = k4[i];
        a0 += q[8 * i + 0] * bf_lo(w.x); a1 += q[8 * i + 1] * bf_hi(w.x); a0 += q[8 * i + 2] * bf_lo(w.y); a1 += q[8 * i + 3] * bf_hi(w.y);
        a0 += q[8 * i + 4] * bf_lo(w.z); a1 += q[8 * i + 5] * bf_hi(w.z); a0 += q[8 * i + 6] * bf_lo(w.w); a1 += q[8 * i + 7] * bf_hi(w.w); }
    return a0 + a1;
}
__device__ __forceinline__ float wave_softmax(float* S, int n, int lane, float& mout) {
    float m = -3.0e38f;
    for (int i = lane; i < n; i += 64) m = fmaxf(m, S[i]);
    m = wave_max(m);
    float s = 0.f;
    for (int i = lane; i < n; i += 64) { const float e = __expf(S[i] - m); S[i] = e; s += e; }
    s = wave_sum(s); mout = m; return s;
}

struct TItem { const float* W; bf16* WT; int K, N, item, pitch; };
struct TRegs { f32x4 v0[8], v1[8]; };
__device__ __forceinline__ void titem_load(const TItem& t, TRegs& R, int lane) {
    const int nblk = (t.N + 63) / 64, kb = t.item / nblk, nb = t.item % nblk, k0 = 64 * kb, n0 = 64 * nb;
    const int rg = lane >> 4, c4 = lane & 15, nn = n0 + 4 * c4; const bool ok = nn < t.N;
#pragma unroll
    for (int i = 0; i < 8; ++i) { const float* p = t.W + (size_t)(k0 + 8 * i + 2 * rg) * t.N + nn;
        R.v0[i] = ok ? *(const f32x4*)p : (f32x4){0.f, 0.f, 0.f, 0.f}; R.v1[i] = ok ? *(const f32x4*)(p + t.N) : (f32x4){0.f, 0.f, 0.f, 0.f}; }
}
__device__ __forceinline__ void titem_store(const TItem& t, const TRegs& R, float* scrf, int lane) {
    unsigned* scr = (unsigned*)scrf;
    const int nblk = (t.N + 63) / 64, kb = t.item / nblk, nb = t.item % nblk, k0 = 64 * kb, n0 = 64 * nb;
    const int rg = lane >> 4, c4 = lane & 15;
#pragma unroll
    for (int i = 0; i < 8; ++i) { unsigned* q = scr + (4 * i + rg) * 66 + 4 * c4;
        q[0] = pkh(R.v0[i].x, R.v1[i].x); q[1] = pkh(R.v0[i].y, R.v1[i].y); q[2] = pkh(R.v0[i].z, R.v1[i].z); q[3] = pkh(R.v0[i].w, R.v1[i].w); }
    LDS_FENCE();
    const int c = lane & 7;
#pragma unroll
    for (int j = 0; j < 8; ++j) { const int n = (lane >> 3) + 8 * j; const unsigned* s = scr + (4 * c) * 66 + n;
        u32x4 o; o.x = s[0]; o.y = s[66]; o.z = s[132]; o.w = s[198];
        *(u32x4*)(t.WT + (size_t)(n0 + n) * t.pitch + k0 + 8 * c) = o; }
    LDS_FENCE();
}
__device__ __forceinline__ int t5_bucket(int d) {
    if (d < 16) return d;
    const float logd = logf((float)d / 16.0f);
    int far = 16 + (int)(logd / 4.852030263919617f * 16.0f);
    return far < 31 ? far : 31;
}
__device__ __forceinline__ void rms_row_to_bf16(const float* xrow, const float* gain, bf16* orow, int lane) {
    const f32x4* xr = (const f32x4*)xrow + lane; const f32x4* gr = (const f32x4*)gain + lane;
    f32x4 v[8]; float s = 0.f;
#pragma unroll
    for (int j = 0; j < 8; ++j) { v[j] = xr[64 * j]; s += (v[j].x * v[j].x + v[j].y * v[j].y) + (v[j].z * v[j].z + v[j].w * v[j].w); }
    const float r = 1.0f / sqrtf(wave_sum(s) * (1.0f / DM) + 1e-6f);
    u32x2* o8 = (u32x2*)orow + lane;
#pragma unroll
    for (int j = 0; j < 8; ++j) { const f32x4 g = gr[64 * j]; u32x2 w; w.x = pk2(v[j].x * r * g.x, v[j].y * r * g.y); w.y = pk2(v[j].z * r * g.z, v[j].w * r * g.w); o8[64 * j] = w; }
}
__device__ __forceinline__ void rowpass_row(const float* xi, const bf16* y, const float* gp, const float* gn, float* xo, bf16* h, int lane) {
    const u32x2* yr = (const u32x2*)y + lane; const f32x4* xr = (const f32x4*)xi + lane; const f32x4* gpr = (const f32x4*)gp + lane;
    u32x2 yw[8]; f32x4 xv[8], gv[8];
#pragma unroll
    for (int j = 0; j < 8; ++j) { yw[j] = yr[64 * j]; xv[j] = xr[64 * j]; gv[j] = gpr[64 * j]; }
    asm volatile("" : "+v"(xv[0]), "+v"(xv[1]), "+v"(xv[2]), "+v"(xv[3]), "+v"(xv[4]), "+v"(xv[5]), "+v"(xv[6]), "+v"(xv[7]));
    asm volatile("" : "+v"(gv[0]), "+v"(gv[1]), "+v"(gv[2]), "+v"(gv[3]), "+v"(gv[4]), "+v"(gv[5]), "+v"(gv[6]), "+v"(gv[7]));
    f32x4 v[8]; float s = 0.f;
#pragma unroll
    for (int j = 0; j < 8; ++j) { const u32x2 w = yw[j]; v[j].x = bf_lo(w.x); v[j].y = bf_hi(w.x); v[j].z = bf_lo(w.y); v[j].w = bf_hi(w.y); s += (v[j].x * v[j].x + v[j].y * v[j].y) + (v[j].z * v[j].z + v[j].w * v[j].w); }
    const float r = 1.0f / sqrtf(wave_sum(s) * (1.0f / DM) + 1e-6f);
    float s2 = 0.f;
#pragma unroll
    for (int j = 0; j < 8; ++j) { v[j] = xv[j] + v[j] * r * gv[j]; s2 += (v[j].x * v[j].x + v[j].y * v[j].y) + (v[j].z * v[j].z + v[j].w * v[j].w); }
    f32x4* xw = (f32x4*)xo + lane;
#pragma unroll
    for (int j = 0; j < 8; ++j) xw[64 * j] = v[j];
    if (gn) {
        const f32x4* gnr = (const f32x4*)gn + lane;
#pragma unroll
        for (int j = 0; j < 8; ++j) gv[j] = gnr[64 * j];
        asm volatile("" : "+v"(gv[0]), "+v"(gv[1]), "+v"(gv[2]), "+v"(gv[3]), "+v"(gv[4]), "+v"(gv[5]), "+v"(gv[6]), "+v"(gv[7]));
        const float r2 = 1.0f / sqrtf(wave_sum(s2) * (1.0f / DM) + 1e-6f);
        u32x2* o8 = (u32x2*)h + lane;
#pragma unroll
        for (int j = 0; j < 8; ++j) { const f32x4 g = gv[j]; u32x2 w; w.x = pkh(v[j].x * r2 * g.x, v[j].y * r2 * g.y); w.y = pkh(v[j].z * r2 * g.z, v[j].w * r2 * g.w); o8[64 * j] = w; }
    }
}

constexpr int IT_IN = 32 * 245, IT_A = 8 * 32, IT_B = 16 * 32, IT_C = 16 * 32, IT_OUT = 32 * 32, IT_UP = 32 * 128, IT_DOWN = 128 * 32;
constexpr int IT_W1 = 32 * 4, IT_W2 = 4 * 1;
constexpr int IT_LAYER = IT_IN + IT_A + IT_B + IT_C + IT_OUT + IT_UP + IT_DOWN + 2 * IT_W1 + 2 * IT_W2;

__device__ __forceinline__ TItem decode_item(const PT a, unsigned char* ws, int it) {
    const int l = it / IT_LAYER; int r = it % IT_LAYER;
    unsigned char* wl = ws + WS_WT + (size_t)l * LAYER_W; unsigned char* cw = ws + WS_CW + (size_t)l * 4 * MiB;
    TItem t;
    if (r < IT_IN) { t.W = a.in(2) + (size_t)l * DM * NIN; t.K = DM; t.N = NIN; t.WT = (bf16*)(wl + WO_IN); t.item = r; t.pitch = t.K; return t; } r -= IT_IN;
    if (r < IT_A) { t.W = a.in(11) + (size_t)l * 512 * DM; t.K = 512; t.N = DM; t.WT = (bf16*)(wl + WO_A); t.item = r; t.pitch = 2560; return t; } r -= IT_A;
    if (r < IT_B) { t.W = a.in(12) + (size_t)l * 1024 * DM; t.K = 1024; t.N = DM; t.WT = (bf16*)(wl + WO_A) + 512; t.item = r; t.pitch = 2560; return t; } r -= IT_B;
    if (r < IT_C) { t.W = a.in(13) + (size_t)l * 1024 * DM; t.K = 1024; t.N = DM; t.WT = (bf16*)(wl + WO_A) + 1536; t.item = r; t.pitch = 2560; return t; } r -= IT_C;
    if (r < IT_OUT) { t.W = a.in(14) + (size_t)l * DM * DM; t.K = DM; t.N = DM; t.WT = (bf16*)(wl + WO_OUT); t.item = r; t.pitch = t.K; return t; } r -= IT_OUT;
    if (r < IT_UP) { t.W = a.in(19) + (size_t)l * DM * DFF; t.K = DM; t.N = DFF; t.WT = (bf16*)(wl + WO_UP); t.item = r; t.pitch = t.K; return t; } r -= IT_UP;
    if (r < IT_DOWN) { t.W = a.in(20) + (size_t)l * DFF * DM; t.K = DFF; t.N = DM; t.WT = (bf16*)(wl + WO_DOWN); t.item = r; t.pitch = t.K; return t; } r -= IT_DOWN;
    if (r < IT_W1) { t.W = a.in(5) + (size_t)l * 2048 * 256; t.K = 2048; t.N = 256; t.WT = (bf16*)cw; t.item = r; t.pitch = t.K; return t; } r -= IT_W1;
    if (r < IT_W1) { t.W = a.in(7) + (size_t)l * 2048 * 256; t.K = 2048; t.N = 256; t.WT = (bf16*)(cw + MiB); t.item = r; t.pitch = t.K; return t; } r -= IT_W1;
    if (r < IT_W2) { t.W = a.in(6) + (size_t)l * 256 * 64; t.K = 256; t.N = 64; t.WT = (bf16*)(cw + 2 * MiB); t.item = r; t.pitch = t.K; return t; } r -= IT_W2;
    t.W = a.in(8) + (size_t)l * 256 * 64; t.K = 256; t.N = 64; t.WT = (bf16*)(cw + 2 * MiB + 65536); t.item = r; t.pitch = t.K; return t;
}
__device__ __forceinline__ void phase_prologue(const PT a, float* ldsf, int lane, int wave, int gw, int ngw) {
    float* scr = ldsf + wave * 4096;
    unsigned char* ws = a.ws();
    constexpr int NIT = DEPTH * IT_LAYER;
    if (gw < NIT) {
        int it = gw; TItem cur = decode_item(a, ws, it); TRegs R; titem_load(cur, R, lane);
        for (;;) {
            const int nx = it + ngw; const bool more = nx < NIT;
            TItem nxt = cur; TRegs R2 = R;
            if (more) { nxt = decode_item(a, ws, nx); titem_load(nxt, R2, lane); }
            titem_store(cur, R, scr, lane);
            if (!more) break;
            cur = nxt; R = R2; it = nx;
        }
    }
    float* biasT = (float*)(ws + WS_BIAST);
    for (int i = gw * 64 + lane; i < 48 * BT; i += ngw * 64) { const int col = i / BT, d = i % BT; biasT[i] = a.in(1)[t5_bucket(d) * 48 + col]; }
    for (int m = gw; m < M; m += ngw) rms_row_to_bf16(a.in(0) + (size_t)m * DM, a.in(15), (bf16*)(ws + WS_H) + (size_t)m * DM, lane);
}

struct EpiAny { static constexpr bool PERM = true, AFTER_DRAIN = false, KHOOK = true;
    int mode; bf16* ob; float* of; const bf16* proj;
    __device__ __forceinline__ bool khook_at(int t) const { return mode == 6 && (t == 8 || t == 24); }
    __device__ __forceinline__ void khook(pg8::f32x4 (&acc)[2][2][4][2], const pg8::Unit& u, int t, int wr, int wc, int fr, int fq) const {
        const int step = (t == 8) ? 0 : 1;
        { int tl = (int)threadIdx.x; asm volatile("" : "+v"(tl)); fr = tl & 15; fq = (tl >> 4) & 3; }
#pragma unroll
        for (int ai = 0; ai < 2; ++ai) {
                u32x2 zc[16], zn[16];
#pragma unroll
                for (int q = 0; q < 16; ++q) { const int m = q >> 2, bj = (q >> 1) & 1, n = q & 1;
                    const int row = u.pm * 256 + ai * 128 + wr * 64 + m * 16 + fr, col = u.pn * 256 + bj * 128 + wc * 32 + 8 * fq + 4 * n;
                    const bf16* gp = proj + (size_t)row * NP + OFF_MG + step * DM + col; zc[q] = *(const u32x2*)gp; zn[q] = *(const u32x2*)(gp + DM); }
#pragma unroll
                for (int q = 0; q < 16; ++q) { const int m = q >> 2, bj = (q >> 1) & 1, n = q & 1;
                    pg8::f32x4 t0 = acc[ai][bj][m][n];
                    t0[0] *= (1.f + __expf(-bf_lo(zn[q].x))) * __builtin_amdgcn_rcpf(1.f + __expf(-bf_lo(zc[q].x))); t0[1] *= (1.f + __expf(-bf_hi(zn[q].x))) * __builtin_amdgcn_rcpf(1.f + __expf(-bf_hi(zc[q].x)));
                    t0[2] *= (1.f + __expf(-bf_lo(zn[q].y))) * __builtin_amdgcn_rcpf(1.f + __expf(-bf_lo(zc[q].y))); t0[3] *= (1.f + __expf(-bf_hi(zn[q].y))) * __builtin_amdgcn_rcpf(1.f + __expf(-bf_hi(zc[q].y)));
                    acc[ai][bj][m][n] = t0; }
                asm volatile("" ::: "memory"); }
    }
    template <int MODE> __device__ __forceinline__ void run(const pg8::f32x4 (&acc)[2][2][4][2], const pg8::Unit& u, int wr, int wc, int fr, int fq) const {
        constexpr int LDC = (MODE == 0) ? NP : (MODE == 5 ? DFF : DM);
        { int tl = (int)threadIdx.x; asm volatile("" : "+v"(tl)); fr = tl & 15; fq = (tl >> 4) & 3; }
#pragma unroll
        for (int ai = 0; ai < 2; ++ai)
#pragma unroll
            for (int mp = 0; mp < 2; ++mp) {
                u32x4 gpre[4];
                if constexpr (MODE == 6) {
#pragma unroll
                    for (int q = 0; q < 4; ++q) { const int m = 2 * mp + (q >> 1), bj = q & 1; const int row = u.pm * 256 + ai * 128 + wr * 64 + m * 16 + fr, col = u.pn * 256 + bj * 128 + wc * 32 + 8 * fq;
                        gpre[q] = *(const u32x4*)(proj + (size_t)row * NP + OFF_MG + 2 * DM + col); }
                }
#pragma unroll
                for (int q = 0; q < 4; ++q) { const int m = 2 * mp + (q >> 1), bj = q & 1; const int row = u.pm * 256 + ai * 128 + wr * 64 + m * 16 + fr, col = u.pn * 256 + bj * 128 + wc * 32 + 8 * fq;
                    const pg8::f32x4 t0 = acc[ai][bj][m][0], t1 = acc[ai][bj][m][1];
                    float v[8] = {t0[0], t0[1], t0[2], t0[3], t1[0], t1[1], t1[2], t1[3]};
                    if constexpr (MODE == 5) {
#pragma unroll
                        for (int e = 0; e < 8; ++e) { const float r = fmaxf(v[e], 0.f); v[e] = r * r; }
                    }
                    if constexpr (MODE == 6) { const u32x4 g = gpre[q];
                        v[0] *= sigmoidf_(bf_lo(g.x)); v[1] *= sigmoidf_(bf_hi(g.x)); v[2] *= sigmoidf_(bf_lo(g.y)); v[3] *= sigmoidf_(bf_hi(g.y));
                        v[4] *= sigmoidf_(bf_lo(g.z)); v[5] *= sigmoidf_(bf_hi(g.z)); v[6] *= sigmoidf_(bf_lo(g.w)); v[7] *= sigmoidf_(bf_hi(g.w)); }
                    u32x4 w; w.x = pkh(v[0], v[1]); w.y = pkh(v[2], v[3]); w.z = pkh(v[4], v[5]); w.w = pkh(v[6], v[7]);
                    *(u32x4*)(ob + (size_t)row * LDC + col) = w; }
                asm volatile("" ::: "memory"); }
    }
    __device__ __forceinline__ void operator()(const pg8::f32x4 (&acc)[2][2][4][2], const pg8::Unit& u, int wr, int wc, int fr, int fq) const {
        if (mode == 0) run<0>(acc, u, wr, wc, fr, fq);
        else if (mode == 4) run<4>(acc, u, wr, wc, fr, fq);
        else if (mode == 5) run<5>(acc, u, wr, wc, fr, fq);
        else run<6>(acc, u, wr, wc, fr, fq);
    } };


constexpr int KCAT = 2560;
typedef short bf16x8 __attribute__((ext_vector_type(8)));
typedef short bf16x4 __attribute__((ext_vector_type(4)));
typedef float f32x16 __attribute__((ext_vector_type(16)));
#define MFMA32(a, b, c) __builtin_amdgcn_mfma_f32_32x32x16_bf16(a, b, c, 0, 0, 0)

template <int KW, int NDS> struct KVRegs { u32x4 k[KW / 64]; u32x4 v[NDS / 2]; };

template <int KW, int NDS> __device__ __forceinline__ void load_tile(KVRegs<KW, NDS>& R, const bf16* base_b, int tok0, int tstride, int kcol, int vcol, int tid) {
#pragma unroll
    for (int r = 0; r < KW / 64; ++r) { const int idx = tid + 512 * r, key = idx / (KW / 8), ch = idx % (KW / 8);
        R.k[r] = *(const u32x4*)(base_b + (size_t)(tok0 + key * tstride) * NP + kcol + ch * 8); }
#pragma unroll
    for (int r = 0; r < NDS / 2; ++r) { const int idx = tid + 512 * r, key = idx & 63, ch = idx >> 6;
        R.v[r] = *(const u32x4*)(base_b + (size_t)(tok0 + key * tstride) * NP + vcol + ch * 8); }
}
template <int KW, int NDS> __device__ __forceinline__ void store_tile(const KVRegs<KW, NDS>& R, bf16* Ks, bf16* Vt, int tid) {
#pragma unroll
    for (int r = 0; r < KW / 64; ++r) { const int idx = tid + 512 * r, key = idx / (KW / 8), ch = idx % (KW / 8);
        *(u32x4*)(Ks + key * (KW + 8) + ch * 8) = R.k[r]; }
#pragma unroll
    for (int r = 0; r < NDS / 2; ++r) { const int idx = tid + 512 * r, key = idx & 63, ch = idx >> 6; const u32x4 w = R.v[r]; bf16* p = Vt + (ch * 8) * 68 + key;
        p[0 * 68] = (bf16)(w.x & 0xffffu); p[1 * 68] = (bf16)(w.x >> 16); p[2 * 68] = (bf16)(w.y & 0xffffu); p[3 * 68] = (bf16)(w.y >> 16);
        p[4 * 68] = (bf16)(w.z & 0xffffu); p[5 * 68] = (bf16)(w.z >> 16); p[6 * 68] = (bf16)(w.w & 0xffffu); p[7 * 68] = (bf16)(w.w >> 16); }
}
constexpr float LOG2E = 1.4426950408889634f;
constexpr float QSCALE2 = 0.125f * LOG2E;
__device__ __forceinline__ void load_qfrag(const bf16* qrow, int hi, bf16x8 (&qf)[4], float sc) {
    u32x4 w0 = *(const u32x4*)(qrow + 0 * 16 + hi * 8), w1 = *(const u32x4*)(qrow + 1 * 16 + hi * 8), w2 = *(const u32x4*)(qrow + 2 * 16 + hi * 8), w3 = *(const u32x4*)(qrow + 3 * 16 + hi * 8);
    asm volatile("" : "+v"(w0), "+v"(w1), "+v"(w2), "+v"(w3));
    const u32x4 wv[4] = {w0, w1, w2, w3};
#pragma unroll
    for (int c = 0; c < 4; ++c) { const u32x4 w = wv[c]; u32x4 o;
        o.x = pkh(bf_lo(w.x) * sc, bf_hi(w.x) * sc); o.y = pkh(bf_lo(w.y) * sc, bf_hi(w.y) * sc);
        o.z = pkh(bf_lo(w.z) * sc, bf_hi(w.z) * sc); o.w = pkh(bf_lo(w.w) * sc, bf_hi(w.w) * sc);
        qf[c] = __builtin_bit_cast(bf16x8, o); }
}
template <int KP, int NDS> __device__ __forceinline__ void attn_tile(const bf16x8 (&qf)[4], const bf16* Ks, const bf16* Vt, float& m, float& l, f32x16 (&O)[NDS],
                                                                       const float* tab, int dq, int maxd, bool tile_ok, int pmode, float cb, int l32, int hi) {
    f32x16 s0, s1;
#pragma unroll
    for (int i = 0; i < 16; ++i) { s0[i] = 0.f; s1[i] = 0.f; }
#pragma unroll
    for (int c = 0; c < 4; ++c) { const bf16x8 a0 = *(const bf16x8*)(Ks + l32 * KP + c * 16 + hi * 8); const bf16x8 a1 = *(const bf16x8*)(Ks + (32 + l32) * KP + c * 16 + hi * 8);
        s0 = MFMA32(a0, qf[c], s0); s1 = MFMA32(a1, qf[c], s1); }
    float mx = -1e30f, sub;
    if (pmode == 2) {
#pragma unroll
        for (int i = 0; i < 16; ++i) mx = fmaxf(mx, fmaxf(s0[i], s1[i]));
        mx = fmaxf(mx, __shfl_xor(mx, 32)) + cb;
    } else if (pmode == 1) {
        const float* tp = tab + (dq - 4 * hi);
#pragma unroll
        for (int h4 = 0; h4 < 4; ++h4) { float bb[4];
#pragma unroll
            for (int j = 0; j < 4; ++j) bb[j] = tp[-(h4 * 8 + j)];
#pragma unroll
            for (int j = 0; j < 4; ++j) { const int i = 4 * h4 + j; s0[i] = tile_ok ? s0[i] + bb[j] : -INFINITY; mx = fmaxf(mx, s0[i]); } }
#pragma unroll
        for (int h4 = 0; h4 < 4; ++h4) { float bb[4];
#pragma unroll
            for (int j = 0; j < 4; ++j) bb[j] = tp[-(32 + h4 * 8 + j)];
#pragma unroll
            for (int j = 0; j < 4; ++j) { const int i = 4 * h4 + j; s1[i] = tile_ok ? s1[i] + bb[j] : -INFINITY; mx = fmaxf(mx, s1[i]); } }
        mx = fmaxf(mx, __shfl_xor(mx, 32));
    } else {
        const int dq4 = dq - 4 * hi, cl = maxd < 2047 ? maxd : 2047;
#pragma unroll
        for (int h4 = 0; h4 < 4; ++h4) { float bb[4];
#pragma unroll
            for (int j = 0; j < 4; ++j) { const int d0 = dq4 - (h4 * 8 + j); bb[j] = tab[d0 < 0 ? 0 : (d0 > cl ? cl : d0)]; }
#pragma unroll
            for (int j = 0; j < 4; ++j) { const int i = 4 * h4 + j; const int d0 = dq4 - (h4 * 8 + j); const bool v0 = tile_ok && (unsigned)d0 <= (unsigned)maxd;
                s0[i] = v0 ? s0[i] + bb[j] : -INFINITY; mx = fmaxf(mx, s0[i]); } }
#pragma unroll
        for (int h4 = 0; h4 < 4; ++h4) { float bb[4];
#pragma unroll
            for (int j = 0; j < 4; ++j) { const int d1 = dq4 - 32 - (h4 * 8 + j); bb[j] = tab[d1 < 0 ? 0 : (d1 > cl ? cl : d1)]; }
#pragma unroll
            for (int j = 0; j < 4; ++j) { const int i = 4 * h4 + j; const int d1 = dq4 - 32 - (h4 * 8 + j); const bool v1 = tile_ok && (unsigned)d1 <= (unsigned)maxd;
                s1[i] = v1 ? s1[i] + bb[j] : -INFINITY; mx = fmaxf(mx, s1[i]); } }
        mx = fmaxf(mx, __shfl_xor(mx, 32));
    }
    const float mn = fmaxf(m, mx), alpha = __builtin_amdgcn_exp2f(m - mn);
    const bool resc = __any(mn != m);
    m = mn; sub = (pmode == 2) ? mn - cb : mn;
    s0 = s0 - sub; s1 = s1 - sub;
#pragma unroll
    for (int i = 0; i < 16; ++i) { s0[i] = __builtin_amdgcn_exp2f(s0[i]); s1[i] = __builtin_amdgcn_exp2f(s1[i]); }
    const f32x16 ss = s0 + s1;
    const float rs = ((ss[0] + ss[1]) + (ss[2] + ss[3])) + ((ss[4] + ss[5]) + (ss[6] + ss[7])) + (((ss[8] + ss[9]) + (ss[10] + ss[11])) + ((ss[12] + ss[13]) + (ss[14] + ss[15])));
    l = l * alpha + rs;
    if (resc) {
#pragma unroll
        for (int ds = 0; ds < NDS; ++ds)
#pragma unroll
            for (int i = 0; i < 16; ++i) O[ds][i] *= alpha;
    }
#pragma unroll
    for (int c = 0; c < 4; ++c) {
        u32x4 pw;
        if (c == 0) { pw.x = pkh(s0[0], s0[1]); pw.y = pkh(s0[2], s0[3]); pw.z = pkh(s0[4], s0[5]); pw.w = pkh(s0[6], s0[7]); }
        else if (c == 1) { pw.x = pkh(s0[8], s0[9]); pw.y = pkh(s0[10], s0[11]); pw.z = pkh(s0[12], s0[13]); pw.w = pkh(s0[14], s0[15]); }
        else if (c == 2) { pw.x = pkh(s1[0], s1[1]); pw.y = pkh(s1[2], s1[3]); pw.z = pkh(s1[4], s1[5]); pw.w = pkh(s1[6], s1[7]); }
        else { pw.x = pkh(s1[8], s1[9]); pw.y = pkh(s1[10], s1[11]); pw.z = pkh(s1[12], s1[13]); pw.w = pkh(s1[14], s1[15]); }
        const bf16x8 pb = __builtin_bit_cast(bf16x8, pw);
#pragma unroll
        for (int ds = 0; ds < NDS; ++ds) { const bf16* vp = Vt + (ds * 32 + l32) * 68 + 16 * c + 4 * hi;
            const u32x2 lo = *(const u32x2*)vp, hi2 = *(const u32x2*)(vp + 8); u32x4 vw; vw.x = lo.x; vw.y = lo.y; vw.z = hi2.x; vw.w = hi2.y;
            O[ds] = MFMA32(__builtin_bit_cast(bf16x8, vw), pb, O[ds]); }
    }
}
template <int KW, int NDS, int SLOT, bool TWO> __device__ __forceinline__ void attn_pass(unsigned tmask, const bf16* base_b, int tok_base, int tstride, int kcol, int vcol, bf16* Ks, bf16* Vt, int kofs,
        const bf16x8 (&qf)[4], float& m, float& l, f32x16 (&O)[NDS], const float* tab, const unsigned char* bk, int iq, int maxd, unsigned okbits, int wave_maxq, int wave_lo, int tid, int l32, int hi) {
    if (!tmask) return;
    KVRegs<KW, NDS> Ra, Rb; int ja = __builtin_ctz(tmask), jb = -1; tmask &= tmask - 1;
    if (TWO && tmask) { jb = __builtin_ctz(tmask); tmask &= tmask - 1; }
    load_tile<KW, NDS>(Ra, base_b, tok_base + ja * 64 * tstride, tstride, kcol, vcol, tid);
    if (TWO && jb >= 0) load_tile<KW, NDS>(Rb, base_b, tok_base + jb * 64 * tstride, tstride, kcol, vcol, tid);
    for (;;) {
        __syncthreads(); store_tile<KW, NDS>(Ra, Ks, Vt, tid); if (TWO && jb >= 0) store_tile<KW, NDS>(Rb, Ks + SLOT, Vt + SLOT, tid); __syncthreads();
        const int ca = ja, cb = jb; const bool more = tmask != 0u;
        if (more) { ja = __builtin_ctz(tmask); tmask &= tmask - 1; jb = -1; if (TWO && tmask) { jb = __builtin_ctz(tmask); tmask &= tmask - 1; }
            load_tile<KW, NDS>(Ra, base_b, tok_base + ja * 64 * tstride, tstride, kcol, vcol, tid);
            if (TWO && jb >= 0) load_tile<KW, NDS>(Rb, base_b, tok_base + jb * 64 * tstride, tstride, kcol, vcol, tid); }
#pragma unroll 1
        for (int s = 0; s < (TWO ? 2 : 1); ++s) { const int c = s ? cb : ca;
            if (c >= 0 && c * 64 <= wave_maxq && c * 64 + 63 >= wave_lo) {
                const bool tok = ((okbits >> c) & 1u) != 0u;
                int pmode = 0; float cbias = 0.f;
                if (bk) { const int dmin = wave_maxq - 31 - c * 64 - 63, dmax = wave_maxq - c * 64;
                    if (dmin >= 0 && dmax <= maxd && dmax <= 2047) { pmode = 1; if (__all(tok) && bk[dmin] == bk[dmax]) { pmode = 2; cbias = tab[dmin]; } } }
                attn_tile<KW + 8, NDS>(qf, Ks + s * SLOT + kofs, Vt + s * SLOT, m, l, O, tab, iq - c * 64, maxd, tok, pmode, cbias, l32, hi); } }
        if (!more) break;
    }
}
__device__ __forceinline__ unsigned range_mask(int lo, int hi_incl) { const unsigned up = (hi_incl >= 31) ? 0xffffffffu : ((1u << (hi_incl + 1)) - 1u); return up & ~((1u << lo) - 1u); }

__device__ __forceinline__ void cmp_unit(const PT a, unsigned char* ldsb, unsigned* selL, int b, int g, int qt, int tid, int lane, int wave) {
    unsigned char* ws = a.ws(); const bf16* proj = (const bf16*)(ws + WS_PROJ);
    const float* kc = (const float*)(ws + WS_KC); const float* vc = (const float*)(ws + WS_VC); float* ocmp = (float*)(ws + WS_OCMP);
    bf16* Khi = (bf16*)ldsb; bf16* Klo = (bf16*)(ldsb + 18432); bf16* Vt = (bf16*)(ldsb + 104448); float* SC = (float*)ldsb;
    const int l32 = lane & 31, hi = lane >> 5;
    __syncthreads();
    {
        const int hh = g * 8 + wave, t0 = qt * 32, tq = t0 + l32, tok = b * SEQ + tq;
        {
            const int n = tid >> 2, seg = tid & 3;
            const f32x4* kp = (const f32x4*)(kc + (size_t)((b * NCMP + (n < NCMP ? n : 0)) * 2 + g) * 64 + seg * 16);
            u32x4 h0, h1, l0, l1; f32x4 x[4];
#pragma unroll
            for (int e = 0; e < 4; ++e) { x[e] = kp[e]; if (n >= NCMP) x[e] = (f32x4){0.f, 0.f, 0.f, 0.f}; }
            unsigned hw[8], lw[8];
#pragma unroll
            for (int e = 0; e < 4; ++e) { const unsigned a0 = f2bf(x[e].x), a1 = f2bf(x[e].y), a2 = f2bf(x[e].z), a3 = f2bf(x[e].w);
                hw[2 * e] = a0 | (a1 << 16); hw[2 * e + 1] = a2 | (a3 << 16);
                lw[2 * e] = pk2(x[e].x - __uint_as_float(a0 << 16), x[e].y - __uint_as_float(a1 << 16)); lw[2 * e + 1] = pk2(x[e].z - __uint_as_float(a2 << 16), x[e].w - __uint_as_float(a3 << 16)); }
            h0.x = hw[0]; h0.y = hw[1]; h0.z = hw[2]; h0.w = hw[3]; h1.x = hw[4]; h1.y = hw[5]; h1.z = hw[6]; h1.w = hw[7];
            l0.x = lw[0]; l0.y = lw[1]; l0.z = lw[2]; l0.w = lw[3]; l1.x = lw[4]; l1.y = lw[5]; l1.z = lw[6]; l1.w = lw[7];
            *(u32x4*)(Khi + n * 72 + seg * 16) = h0; *(u32x4*)(Khi + n * 72 + seg * 16 + 8) = h1;
            *(u32x4*)(Klo + n * 72 + seg * 16) = l0; *(u32x4*)(Klo + n * 72 + seg * 16 + 8) = l1;
            const int nv_ = tid & 127, dseg = tid >> 7;
            const f32x4* vp = (const f32x4*)(vc + (size_t)((b * NCMP + (nv_ < NCMP ? nv_ : 0)) * 2 + g) * 64 + dseg * 16);
#pragma unroll
            for (int e = 0; e < 4; ++e) { f32x4 v = vp[e]; if (nv_ >= NCMP) v = (f32x4){0.f, 0.f, 0.f, 0.f}; bf16* p = Vt + (dseg * 16 + e * 4) * 136 + nv_;
                p[0] = (bf16)f2bf(v.x); p[136] = (bf16)f2bf(v.y); p[272] = (bf16)f2bf(v.z); p[408] = (bf16)f2bf(v.w); }
        }
        bf16x8 qf[4]; load_qfrag(proj + (size_t)tok * NP + OFF_BQ + hh * 64, hi, qf, 0.125f);
        __syncthreads();
        f32x16 s[4];
#pragma unroll
        for (int st = 0; st < 4; ++st) {
#pragma unroll
            for (int i = 0; i < 16; ++i) s[st][i] = 0.f;
#pragma unroll
            for (int c = 0; c < 4; ++c) { const bf16x8 ah = *(const bf16x8*)(Khi + (st * 32 + l32) * 72 + c * 16 + hi * 8); const bf16x8 al = *(const bf16x8*)(Klo + (st * 32 + l32) * 72 + c * 16 + hi * 8);
                s[st] = MFMA32(ah, qf[c], s[st]); s[st] = MFMA32(al, qf[c], s[st]); }
        }
        int nvq = tq >= 31 ? (tq - 31) / 16 + 1 : 0; nvq = nvq < NCMP ? nvq : NCMP;
        float mx = -1e30f;
#pragma unroll
        for (int st = 0; st < 4; ++st)
#pragma unroll
            for (int i = 0; i < 16; ++i) { const int n = 32 * st + (i >> 2) * 8 + 4 * hi + (i & 3); if (n < nvq) mx = fmaxf(mx, s[st][i]); }
        mx = fmaxf(mx, __shfl_xor(mx, 32));
        float rs = 0.f;
#pragma unroll
        for (int st = 0; st < 4; ++st)
#pragma unroll
            for (int i = 0; i < 16; ++i) { const int n = 32 * st + (i >> 2) * 8 + 4 * hi + (i & 3); const float e = (n < nvq) ? __expf(s[st][i] - mx) : 0.f; s[st][i] = e; rs += e; }
        rs += __shfl_xor(rs, 32);
        const float inv = nvq > 0 ? 1.0f / rs : 0.f;
#pragma unroll
        for (int st = 0; st < 4; ++st)
#pragma unroll
            for (int i = 0; i < 16; ++i) s[st][i] *= inv;
        f32x16 O[2];
#pragma unroll
        for (int ds = 0; ds < 2; ++ds)
#pragma unroll
            for (int i = 0; i < 16; ++i) O[ds][i] = 0.f;
#pragma unroll
        for (int st = 0; st < 4; ++st)
#pragma unroll
            for (int c2 = 0; c2 < 2; ++c2) { const int c = 2 * st + c2; u32x4 pw;
                pw.x = pk2(s[st][8 * c2 + 0], s[st][8 * c2 + 1]); pw.y = pk2(s[st][8 * c2 + 2], s[st][8 * c2 + 3]); pw.z = pk2(s[st][8 * c2 + 4], s[st][8 * c2 + 5]); pw.w = pk2(s[st][8 * c2 + 6], s[st][8 * c2 + 7]);
                const bf16x8 pb = __builtin_bit_cast(bf16x8, pw);
#pragma unroll
                for (int ds = 0; ds < 2; ++ds) { const bf16* vp = Vt + (ds * 32 + l32) * 136 + 16 * c + 4 * hi;
                    const u32x2 lo = *(const u32x2*)vp, hi2 = *(const u32x2*)(vp + 8); u32x4 vw; vw.x = lo.x; vw.y = lo.y; vw.z = hi2.x; vw.w = hi2.y;
                    O[ds] = MFMA32(__builtin_bit_cast(bf16x8, vw), pb, O[ds]); } }
#pragma unroll
        for (int ds = 0; ds < 2; ++ds)
#pragma unroll
            for (int i4 = 0; i4 < 4; ++i4) { f32x4 v; v.x = O[ds][i4 * 4 + 0]; v.y = O[ds][i4 * 4 + 1]; v.z = O[ds][i4 * 4 + 2]; v.w = O[ds][i4 * 4 + 3];
                *(f32x4*)(ocmp + (size_t)tok * 1024 + hh * 64 + ds * 32 + i4 * 8 + 4 * hi) = v; }
        __syncthreads();
        {
            float prev_other = 0.f;
#pragma unroll
            for (int st = 0; st < 4; ++st)
#pragma unroll
                for (int i4 = 0; i4 < 4; ++i4) {
                    const float gs = (s[st][4 * i4] + s[st][4 * i4 + 1]) + (s[st][4 * i4 + 2] + s[st][4 * i4 + 3]);
                    const float other = __shfl_xor(s[st][4 * i4 + 3], 32);
                    const float c = gs + (hi ? other : prev_other);
                    prev_other = other;
                    SC[(wave * 32 + l32) * 33 + 8 * st + 2 * i4 + hi] = c;
                }
        }
        __syncthreads();
#pragma unroll 1
        for (int ps = 0; ps < 2; ++ps) {
            const int q = 4 * wave + 2 * ps + hi, j = l32, t = t0 + q, cur = t >> 6;
            float sc = 0.f;
#pragma unroll
            for (int w = 0; w < 8; ++w) sc += SC[(w * 32 + q) * 33 + j];
            if (j == 0 || cur - j == 0 || cur - j == 1) sc = 1e6f;
            if (j > cur) sc = -1e30f;
            int rank = 0;
#pragma unroll 1
            for (int i = 0; i < 32; ++i) { const float si = __shfl(sc, (lane & 32) + i); rank += (si > sc || (si == sc && i < j)) ? 1 : 0; }
            const bool sel = (rank < 16) && (j <= cur);
            const unsigned long long bal = __ballot(sel);
            if (l32 == 0) selL[q] = hi ? (unsigned)(bal >> 32) : (unsigned)bal;
        }
        __syncthreads();
    }
}


__device__ __forceinline__ void phase_nsa_mfma(const PT a, unsigned char* ldsb, int tid, int lane, int wave, int bid, int nblk) {
    unsigned char* ws = a.ws(); const bf16* proj = (const bf16*)(ws + WS_PROJ); const float* biasT = (const float*)(ws + WS_BIAST);
    const float* ocmp = (const float*)(ws + WS_OCMP); bf16* ob = (bf16*)(ws + WS_OA);
    bf16* Ks = (bf16*)ldsb; bf16* Vt = (bf16*)(ldsb + 9216); float* tabs = (float*)(ldsb + 36864); unsigned char* bk = ldsb + 102400; unsigned* selL = (unsigned*)(ldsb + 121856);
    int gcur = -1;
    __syncthreads();
    for (int u = bid; u < 512; u += nblk) {
        const int bg = u & 7, b = bg >> 1, g = bg & 1, qt = u < 256 ? 63 - (u >> 3) : ((u - 256) >> 3);
        if (g != gcur) { __syncthreads();
            for (int i = tid; i < 8 * 2048; i += 512) tabs[i] = biasT[(24 + g * 8 + (i >> 11)) * BT + (i & 2047)] * LOG2E; for (int i = tid; i < 2048; i += 512) bk[i] = (unsigned char)t5_bucket(i); gcur = g; }
        const int hh = g * 8 + wave, t0 = qt * 32;
        const bf16* base_b = proj + (size_t)b * SEQ * NP;
        cmp_unit(a, ldsb, selL, b, g, qt, tid, lane, wave);
        asm volatile("" : "+v"(lane), "+v"(tid) :: "memory");
        const int l32 = lane & 31, hi = lane >> 5, tq = t0 + l32, tok = b * SEQ + tq;
        bf16x8 qf[4]; load_qfrag(proj + (size_t)tok * NP + OFF_BQ + hh * 64, hi, qf, QSCALE2);
        const unsigned mq = selL[l32];
        unsigned un = mq;
#pragma unroll
        for (int o = 1; o < 32; o <<= 1) un |= (unsigned)__shfl_xor((int)un, o);
        un = (unsigned)__builtin_amdgcn_readfirstlane((int)un);
        const float* tab = tabs + wave * 2048;
        f32x16 Os[2], Ow[2]; float m = -1e30f, l = 0.f;
#pragma unroll
        for (int ds = 0; ds < 2; ++ds)
#pragma unroll
            for (int i = 0; i < 16; ++i) { Os[ds][i] = 0.f; Ow[ds][i] = 0.f; }
        attn_pass<64, 2, 8960, true>(un, base_b, 0, 1, OFF_BKV + (4 + g) * 64, OFF_BKV + (6 + g) * 64, Ks, Vt, 0, qf, m, l, Os, tab, bk, tq, 1 << 20, mq, t0 + 31, -(1 << 20), tid, l32, hi);
        const float isel = 1.0f / (l + __shfl_xor(l, 32));
        m = -1e30f; l = 0.f;
        const int wlo = (t0 - 511 > 0 ? t0 - 511 : 0) >> 6, whi = (t0 + 31) >> 6;
        attn_pass<64, 2, 8960, true>(range_mask(wlo, whi), base_b, 0, 1, OFF_BKV + (8 + g) * 64, OFF_BKV + (10 + g) * 64, Ks, Vt, 0, qf, m, l, Ow, tab, bk, tq, 511, 0xffffffffu, t0 + 31, -(1 << 20), tid, l32, hi);
        const float iwin = 1.0f / (l + __shfl_xor(l, 32));
        const bf16* gp = proj + (size_t)tok * NP + OFF_BG + hh * 3;
        const float g0 = sigmoidf_(bf2f(gp[0])), g1 = sigmoidf_(bf2f(gp[1])) * isel, g2 = sigmoidf_(bf2f(gp[2])) * iwin;
#pragma unroll
        for (int ds = 0; ds < 2; ++ds)
#pragma unroll
            for (int i4 = 0; i4 < 4; ++i4) { const int d = ds * 32 + i4 * 8 + 4 * hi; const size_t off = (size_t)tok * 1024 + hh * 64 + d;
                const f32x4 oc = *(const f32x4*)(ocmp + off);
                const float r0 = g0 * oc.x + g1 * Os[ds][i4 * 4 + 0] + g2 * Ow[ds][i4 * 4 + 0], r1 = g0 * oc.y + g1 * Os[ds][i4 * 4 + 1] + g2 * Ow[ds][i4 * 4 + 1];
                const float r2 = g0 * oc.z + g1 * Os[ds][i4 * 4 + 2] + g2 * Ow[ds][i4 * 4 + 2], r3 = g0 * oc.w + g1 * Os[ds][i4 * 4 + 3] + g2 * Ow[ds][i4 * 4 + 3];
                u32x2 w; w.x = pk2(r0, r1); w.y = pk2(r2, r3); *(u32x2*)(ob + (size_t)tok * KCAT + 512 + hh * 64 + d) = w; }
    }
    __syncthreads();
}

__device__ __forceinline__ void phase_diff_mfma(const PT a, int lyr, unsigned char* ldsb, int tid, int lane, int wave, int bid, int nblk) {
    unsigned char* ws = a.ws(); const bf16* proj = (const bf16*)(ws + WS_PROJ); const float* biasT = (const float*)(ws + WS_BIAST); bf16* oc = (bf16*)(ws + WS_OA);
    const float* lv = a.in(9) + (size_t)lyr * 256; const float* sg = a.in(10) + (size_t)lyr * 128;
    const float lam_init = 0.8f - 0.6f * expf(-0.3f * (float)lyr);
    const float lam = expf(wave_sum(lv[lane] * lv[64 + lane])) - expf(wave_sum(lv[128 + lane] * lv[192 + lane])) + lam_init;
    bf16* Ks = (bf16*)ldsb; bf16* Vt = (bf16*)(ldsb + 17408); float* tab = (float*)(ldsb + 69632); unsigned char* bk = ldsb + 77824; float* sgl = (float*)(ldsb + 79872); float* O2 = (float*)ldsb;
    const int l32 = lane & 31, hi = lane >> 5, mp = wave >> 2, wq = wave & 3;
    int hcur = -1;
    __syncthreads();
    if (tid < 128) sgl[tid] = sg[tid];
    for (int u = bid; u < 512; u += nblk) {
        const int bh = u & 31, b = bh >> 3, h = bh & 7, qt = u < 256 ? 15 - (u >> 5) : ((u - 256) >> 5);
        if (h != hcur) { __syncthreads(); for (int i = tid; i < 2048; i += 512) { tab[i] = biasT[(40 + h) * BT + i] * LOG2E; bk[i] = (unsigned char)t5_bucket(i); } hcur = h; }
        const int t0 = qt * 128, tq = t0 + wq * 32 + l32, tok = b * SEQ + tq;
        const bf16* base_b = proj + (size_t)b * SEQ * NP;
        bf16x8 qf[4]; load_qfrag(proj + (size_t)tok * NP + OFF_CQ + (h * 2 + mp) * 64, hi, qf, QSCALE2);
        f32x16 O[4]; float m = -1e30f, l = 0.f;
#pragma unroll
        for (int ds = 0; ds < 4; ++ds)
#pragma unroll
            for (int i = 0; i < 16; ++i) O[ds][i] = 0.f;
        attn_pass<128, 4, 17408, false>(range_mask(0, (t0 + 127) >> 6), base_b, 0, 1, OFF_CK + h * 128, OFF_CV + h * 128, Ks, Vt, mp * 64, qf, m, l, O, tab, bk, tq, 1 << 20, 0xffffffffu, t0 + wq * 32 + 31, -(1 << 20), tid, l32, hi);
        const float inv = 1.0f / (l + __shfl_xor(l, 32));
        __syncthreads();
        if (mp == 1) {
#pragma unroll
            for (int ds = 0; ds < 4; ++ds)
#pragma unroll
                for (int i = 0; i < 16; ++i) O2[(ds * 16 + i) * 256 + wq * 64 + lane] = O[ds][i] * inv;
        }
        __syncthreads();
        if (mp == 0) {
            float ss = 0.f;
#pragma unroll
            for (int ds = 0; ds < 4; ++ds)
#pragma unroll
                for (int i = 0; i < 16; ++i) { const float o = O[ds][i] * inv - lam * O2[(ds * 16 + i) * 256 + wq * 64 + lane]; O[ds][i] = o; ss += o * o; }
            ss += __shfl_xor(ss, 32);
            const float r = (1.0f - lam_init) / sqrtf(ss * (1.0f / 128.0f) + 1e-6f);
#pragma unroll
            for (int ds = 0; ds < 4; ++ds)
#pragma unroll
                for (int i4 = 0; i4 < 4; ++i4) { const int d = ds * 32 + i4 * 8 + 4 * hi; const f32x4 gn = *(const f32x4*)(sgl + d);
                    u32x2 w; w.x = pkh(O[ds][i4 * 4 + 0] * r * gn.x, O[ds][i4 * 4 + 1] * r * gn.y); w.y = pkh(O[ds][i4 * 4 + 2] * r * gn.z, O[ds][i4 * 4 + 3] * r * gn.w);
                    *(u32x2*)(oc + (size_t)tok * KCAT + 1536 + h * 128 + d) = w; }
        }
        __syncthreads();
    }
}


constexpr size_t WS_OAG = WS_MIXF, WS_LSE = WS_MIXB;
__device__ __forceinline__ void phase_dilated_mfma(const PT a, unsigned char* ldsb, int tid, int lane, int wave, int bid, int nblk) {
    unsigned char* ws = a.ws(); const bf16* proj = (const bf16*)(ws + WS_PROJ); const float* biasT = (const float*)(ws + WS_BIAST);
    float* oag = (float*)(ws + WS_OAG); float* lseb = (float*)(ws + WS_LSE);
    bf16* Ks = (bf16*)ldsb; bf16* Vt = (bf16*)(ldsb + 9216); float* tab = (float*)(ldsb + 36864);
    const int l32 = lane & 31, hi = lane >> 5;
    const int nh = (nblk > 64) ? nblk - 64 : nblk, hb = (nblk > 64) ? bid - 64 : bid;
    const int n_heavy_mine = (hb >= 0) ? (512 - hb + nh - 1) / nh : 0;
    const int n_light_mine = (512 - bid + nblk - 1) / nblk;
    for (int it = 0; it < n_heavy_mine + n_light_mine; ++it) {
        const int u = it < n_heavy_mine ? hb + it * nh : 512 + bid + (it - n_heavy_mine) * nblk;
        int g, b, h, r, i0, nq;
        if (u < 256) { g = 0; b = u >> 6; h = (u >> 3) & 7; r = 0; i0 = (u & 7) * 256; nq = 256; }
        else if (u < 512) { const int v = u - 256; g = 1; b = v >> 6; h = (v >> 3) & 7; r = (v >> 1) & 3; i0 = (v & 1) * 256; nq = 256; }
        else { const int v = u - 512; g = 2; b = v >> 7; h = (v >> 4) & 7; r = v & 15; i0 = 0; nq = 128; }
        const int dil = 1 << (2 * g);
        __syncthreads();
        if (tid < 129) tab[tid] = biasT[(g * 8 + h) * BT + tid * dil] * LOG2E;
        const bool act = wave * 32 < nq;
        const int iq = i0 + ((wave * 32) % nq) + l32, tok = b * SEQ + r + dil * iq;
        const bf16* base_b = proj + (size_t)b * SEQ * NP;
        bf16x8 qf[4]; load_qfrag(proj + (size_t)tok * NP + (g * 8 + h) * 64, hi, qf, QSCALE2);
        f32x16 O[2]; float m = -1e30f, l = 0.f;
#pragma unroll
        for (int ds = 0; ds < 2; ++ds)
#pragma unroll
            for (int i = 0; i < 16; ++i) O[ds][i] = 0.f;
        const int wq0 = i0 + wave * 32;
        attn_pass<64, 2, 8960, true>(range_mask((i0 - 128 > 0 ? i0 - 128 : 0) >> 6, (i0 + nq - 1) >> 6), base_b, r, dil, ((3 + g) * 8 + h) * 64, ((6 + g) * 8 + h) * 64, Ks, Vt, 0, qf, m, l, O, tab, (const unsigned char*)nullptr, iq, 128, 0xffffffffu,
                         act ? wq0 + 31 : -1, wq0 - 128, tid, l32, hi);
        if (act) {
            const float lt = l + __shfl_xor(l, 32), inv = 1.0f / lt;
            float* op = oag + ((size_t)g * M + tok) * 512 + h * 64;
#pragma unroll
            for (int ds = 0; ds < 2; ++ds)
#pragma unroll
                for (int i4 = 0; i4 < 4; ++i4) { f32x4 v; v.x = O[ds][i4 * 4 + 0] * inv; v.y = O[ds][i4 * 4 + 1] * inv; v.z = O[ds][i4 * 4 + 2] * inv; v.w = O[ds][i4 * 4 + 3] * inv;
                    *(f32x4*)(op + ds * 32 + i4 * 8 + 4 * hi) = v; }
            if (hi == 0) lseb[((size_t)g * M + tok) * 8 + h] = (m + __log2f(lt)) * 0.6931471805599453f;
        }
    }
    __syncthreads();
}
__device__ __forceinline__ void phase_dil_combine(const PT a, int lane, int gw, int ngw) {
    unsigned char* ws = a.ws(); const float* oag = (const float*)(ws + WS_OAG); const float* lseb = (const float*)(ws + WS_LSE); bf16* oa = (bf16*)(ws + WS_OA);
    for (int tok = gw; tok < M; tok += ngw) {
        const int h = lane >> 3;
        const float l0 = lseb[((size_t)0 * M + tok) * 8 + h], l1 = lseb[((size_t)1 * M + tok) * 8 + h], l2 = lseb[((size_t)2 * M + tok) * 8 + h];
        const float mx = fmaxf(l0, fmaxf(l1, l2)); float w0 = __expf(l0 - mx), w1 = __expf(l1 - mx), w2 = __expf(l2 - mx); const float iw = 1.0f / (w0 + w1 + w2); w0 *= iw; w1 *= iw; w2 *= iw;
        const f32x4* p0 = (const f32x4*)(oag + ((size_t)0 * M + tok) * 512 + lane * 8); const f32x4* p1 = (const f32x4*)(oag + ((size_t)1 * M + tok) * 512 + lane * 8); const f32x4* p2 = (const f32x4*)(oag + ((size_t)2 * M + tok) * 512 + lane * 8);
        const f32x4 x0 = w0 * p0[0] + w1 * p1[0] + w2 * p2[0], x1 = w0 * p0[1] + w1 * p1[1] + w2 * p2[1];
        u32x4 o; o.x = pk2(x0.x, x0.y); o.y = pk2(x0.z, x0.w); o.z = pk2(x1.x, x1.y); o.w = pk2(x1.z, x1.w);
        *(u32x4*)(oa + (size_t)tok * KCAT + lane * 8) = o;
    }
}


__device__ __forceinline__ void phase_compress_mfma(const PT a, int lyr, unsigned char* ldsb, int tid, int lane, int wave, int bid, int nblk) {
    unsigned char* ws = a.ws(); const bf16* proj = (const bf16*)(ws + WS_PROJ);
    unsigned char* cw = ws + WS_CW + (size_t)lyr * 4 * MiB;
    bf16* Ab = (bf16*)ldsb; float* RED = (float*)(ldsb + 17408);
    const int l32 = lane & 31, hi = lane >> 5;
    __syncthreads();
    for (int u = bid; u < 64; u += nblk) {
        const int kv = u >> 5, rg = u & 31;
        const bf16* W1t = (const bf16*)(cw + (size_t)kv * MiB); const bf16* W2t = (const bf16*)(cw + 2 * MiB + (size_t)kv * 65536);
        const float* pos = a.in(3 + kv) + (size_t)lyr * 2048; float* dst = (float*)(ws + (kv ? WS_VC : WS_KC));
        f32x16 acc;
#pragma unroll
        for (int i = 0; i < 16; ++i) acc[i] = 0.f;
        const bf16* wrow = W1t + (size_t)(32 * wave + l32) * 2048 + hi * 8;
#pragma unroll 1
        for (int kc = 0; kc < 8; ++kc) {
            bf16x8 af[16];
#pragma unroll
            for (int kk = 0; kk < 16; ++kk) af[kk] = *(const bf16x8*)(wrow + kc * 256 + kk * 16);
            __syncthreads();
#pragma unroll
            for (int r2 = 0; r2 < 2; ++r2) { const int idx = tid + 512 * r2, row = idx >> 5, ch = idx & 31; int r = rg * 32 + row; r = r < 1016 ? r : 1015;
                const int g = r & 1, bn = r >> 1, b = bn / NCMP, n = bn % NCMP, ll = kc * 4 + (ch >> 3), d = (ch & 7) * 8;
                const u32x4 w = *(const u32x4*)(proj + (size_t)(b * SEQ + 16 * n + ll) * NP + OFF_BKV + (kv * 2 + g) * 64 + d);
                const f32x4 p0 = *(const f32x4*)(pos + ll * 64 + d), p1 = *(const f32x4*)(pos + ll * 64 + d + 4);
                u32x4 o; o.x = pk2(bf_lo(w.x) + p0.x, bf_hi(w.x) + p0.y); o.y = pk2(bf_lo(w.y) + p0.z, bf_hi(w.y) + p0.w); o.z = pk2(bf_lo(w.z) + p1.x, bf_hi(w.z) + p1.y); o.w = pk2(bf_lo(w.w) + p1.z, bf_hi(w.w) + p1.w);
                *(u32x4*)(Ab + row * 264 + ch * 8) = o; }
            __syncthreads();
#pragma unroll
            for (int kk = 0; kk < 16; ++kk) { const bf16x8 bfr = *(const bf16x8*)(Ab + l32 * 264 + kk * 16 + hi * 8); acc = MFMA32(af[kk], bfr, acc); }
        }
#pragma unroll
        for (int i = 0; i < 16; ++i) { const float v = acc[i]; acc[i] = 0.5f * v * (1.0f + tanhf(0.7978845608028654f * (v + 0.044715f * v * v * v))); }
        f32x16 o2[2];
#pragma unroll
        for (int ds = 0; ds < 2; ++ds)
#pragma unroll
            for (int i = 0; i < 16; ++i) o2[ds][i] = 0.f;
#pragma unroll
        for (int c2 = 0; c2 < 2; ++c2) { u32x4 pw; pw.x = pk2(acc[8 * c2 + 0], acc[8 * c2 + 1]); pw.y = pk2(acc[8 * c2 + 2], acc[8 * c2 + 3]); pw.z = pk2(acc[8 * c2 + 4], acc[8 * c2 + 5]); pw.w = pk2(acc[8 * c2 + 6], acc[8 * c2 + 7]);
            const bf16x8 hb = __builtin_bit_cast(bf16x8, pw);
#pragma unroll
            for (int ds = 0; ds < 2; ++ds) { const bf16* wp = W2t + (size_t)(ds * 32 + l32) * 256 + 32 * wave + 16 * c2 + 4 * hi;
                const u32x2 lo = *(const u32x2*)wp, hi2 = *(const u32x2*)(wp + 8); u32x4 vw; vw.x = lo.x; vw.y = lo.y; vw.z = hi2.x; vw.w = hi2.y;
                o2[ds] = MFMA32(__builtin_bit_cast(bf16x8, vw), hb, o2[ds]); } }
#pragma unroll
        for (int ds = 0; ds < 2; ++ds)
#pragma unroll
            for (int i = 0; i < 16; ++i) RED[(wave * 64 + ds * 32 + (i >> 2) * 8 + 4 * hi + (i & 3)) * 33 + l32] = o2[ds][i];
        __syncthreads();
#pragma unroll
        for (int e = 0; e < 4; ++e) { const int idx = tid + 512 * e, d = idx & 63, row = idx >> 6; float s = 0.f;
#pragma unroll
            for (int w = 0; w < 8; ++w) s += RED[(w * 64 + d) * 33 + row];
            const int r = rg * 32 + row; if (r < 1016) dst[(size_t)r * 64 + d] = s; }
        __syncthreads();
    }
}

#define XB_TMO      128
#define XB_XCNT(j)  (256  + 64 * (j))
#define XB_XSUB(j)  (1280 + 64 * (j))
#define XB_XGEN(j)  (2304 + 64 * (j))
#define XB_TOP      3328
#define XB_TOPGEN   3392
#define XCD_BAR_WORDS 3456
#define XB_SPIN_CAP (1u << 18)

__device__ __forceinline__ unsigned xb_ld(unsigned* p)              { return __hip_atomic_load(p, __ATOMIC_RELAXED, __HIP_MEMORY_SCOPE_AGENT); }
__device__ __forceinline__ unsigned xb_add(unsigned* p, unsigned v) { return __hip_atomic_fetch_add(p, v, __ATOMIC_RELAXED, __HIP_MEMORY_SCOPE_AGENT); }
__device__ __forceinline__ unsigned xb_xcc_id() { return (unsigned)__builtin_amdgcn_s_getreg((3 << 11) | 20) & 0xFu; }
#define XB_SPIN(cond, bar) do { unsigned _sp = 0; while (cond) { __builtin_amdgcn_s_sleep(1); \
    if ((++_sp & 255u) == 0u) { if (xb_ld(&(bar)[XB_TMO])) break; if (_sp > XB_SPIN_CAP) { atomicAdd(&(bar)[XB_TMO], 1u); break; } } } } while (0)

struct XcdBarrier {
    unsigned* bar; unsigned x;
    volatile LAS unsigned* st;
};

__device__ __forceinline__ XcdBarrier xcd_barrier_post(unsigned* bar, volatile LAS unsigned* st) {
    XcdBarrier b; b.bar = bar; b.x = xb_xcc_id(); b.st = st;
    if (threadIdx.x == 0) (void)xb_add(&bar[XB_XCNT(b.x)], 1u);
    return b;
}
__device__ __forceinline__ void xcd_barrier_complete(unsigned* bar, unsigned x, unsigned& nloc, unsigned& nx) {
    const unsigned G = gridDim.x * gridDim.y * gridDim.z;
    unsigned sum, cnt, mine, sp = 0u;
    for (;;) {
        sum = 0u; cnt = 0u; mine = 0u;
#pragma unroll
        for (unsigned j = 0; j < 16; ++j) { const unsigned c = xb_ld(&bar[XB_XCNT(j)]); sum += c; cnt += (c > 0u) ? 1u : 0u; mine = (j == x) ? c : mine; }
        if (sum == G) break;
        __builtin_amdgcn_s_sleep(1);
        if ((++sp & 255u) == 0u) { if (xb_ld(&bar[XB_TMO])) break; if (sp > XB_SPIN_CAP) { atomicAdd(&bar[XB_TMO], 1u); break; } }
    }
    nloc = mine > 0u ? mine : 1u; nx = cnt > 0u ? cnt : 1u;
}

__device__ __forceinline__ void xcd_barrier(const XcdBarrier& b) {
    asm volatile("s_waitcnt vmcnt(0)" ::: "memory");
    __syncthreads();
    if (threadIdx.x == 0) {
        unsigned* bar = b.bar;
        __builtin_amdgcn_s_waitcnt(0);
        unsigned nloc = b.st[0], nx = b.st[1];
        if (nloc == 0u) { xcd_barrier_complete(bar, b.x, nloc, nx); b.st[0] = nloc; b.st[1] = nx; }
        const unsigned old = xb_add(&bar[XB_XSUB(b.x)], 1u);
        const unsigned gen = old / nloc;
        if (old + 1u == (gen + 1u) * nloc) {
            __builtin_amdgcn_fence(__ATOMIC_RELEASE, "agent");
            asm volatile("s_waitcnt vmcnt(0)" ::: "memory");
            const unsigned og = xb_add(&bar[XB_TOP], 1u);
            const unsigned tg = og / nx;
            if (og + 1u == (tg + 1u) * nx) xb_add(&bar[XB_TOPGEN], 1u);
            else XB_SPIN(xb_ld(&bar[XB_TOPGEN]) == tg, bar);
            __builtin_amdgcn_fence(__ATOMIC_ACQUIRE, "agent");
            xb_add(&bar[XB_XGEN(b.x)], 1u);
            asm volatile("s_waitcnt vmcnt(0)" ::: "memory");
        } else {
            XB_SPIN(xb_ld(&bar[XB_XGEN(b.x)]) == gen, bar);
            __builtin_amdgcn_fence(__ATOMIC_ACQUIRE, "agent");
            asm volatile("s_waitcnt vmcnt(0)" ::: "memory");
        }
    }
    __syncthreads();
}

__global__ void __launch_bounds__(512, 2) mega_fwd(Args ka) {
    extern __shared__ __attribute__((aligned(16))) unsigned char lds[];
    LAS unsigned char* ldsl = (LAS unsigned char*)lds;
    const int tid0 = threadIdx.x;
    {
        unsigned long long* pt = (unsigned long long*)(lds + PTAB_OFF);
        if (tid0 < 21) pt[tid0] = (unsigned long long)ka.in[tid0];
        if (tid0 == 21) pt[21] = (unsigned long long)ka.out;
        if (tid0 == 22) pt[22] = (unsigned long long)ka.ws;
        if (tid0 == 23) { pt[32] = 0ull; }
        __syncthreads();
    }
    const int ph_lo = ka.ph_lo, ph_hi = ka.ph_hi;
    cg::grid_group grid = cg::this_grid();
    (void)xcd_barrier_post((unsigned*)(__attribute__((address_space(1))) unsigned*)(ka.ws + WS_BAR), (volatile LAS unsigned*)(ldsl + PTAB_OFF + 256));
    for (int ph = ph_lo; ph < ph_hi; ++ph) {
        unsigned ldso0 = 0; asm volatile("" : "+s"(ldso0));
        const PT a{(const unsigned long long*)(lds + PTAB_OFF + ldso0)};
        if (ph == 0) { int tidp = tid0; asm volatile("" : "+v"(tidp)); const int lanep = tidp & 63, wavep = __builtin_amdgcn_readfirstlane(tidp >> 6);
            phase_prologue(a, (float*)(lds + ldso0), lanep, wavep, (int)blockIdx.x * 8 + wavep, (int)gridDim.x * 8); }
        else {
            const int l = (ph - 1) / PH_PER_LAYER; int k = (ph - 1) % PH_PER_LAYER; if (k >= 2) k += 1;
            unsigned char* ws = a.ws();
            unsigned char* wl = ws + WS_WT + (size_t)l * LAYER_W;
            bf16* H = (bf16*)(ws + WS_H); bf16* proj = (bf16*)(ws + WS_PROJ);
            int njobs = 0, mode0 = 0, N = 0, K = 0; const bf16* A0 = nullptr; const bf16* B0 = nullptr; bf16* ob = nullptr; float* of = nullptr;
            if (k == 0) { njobs = 1; mode0 = 0; A0 = H; B0 = (const bf16*)(wl + WO_IN); N = NP; K = DM; ob = proj; }
            else if (k == 4) { njobs = 1; mode0 = 6; A0 = (const bf16*)(ws + WS_OA); B0 = (const bf16*)(wl + WO_A); N = DM; K = KCAT; ob = (bf16*)(ws + WS_MIXB); }
            else if (k == 5) { njobs = 1; mode0 = 4; A0 = (const bf16*)(ws + WS_MIXB); B0 = (const bf16*)(wl + WO_OUT); N = DM; K = DM; ob = (bf16*)(ws + WS_Y); }
            else if (k == 7) { njobs = 1; mode0 = 5; A0 = H; B0 = (const bf16*)(wl + WO_UP); N = DFF; K = DM; ob = (bf16*)(ws + WS_U); }
            else if (k == 8) { njobs = 1; mode0 = 4; A0 = (const bf16*)(ws + WS_U); B0 = (const bf16*)(wl + WO_DOWN); N = DM; K = DFF; ob = (bf16*)(ws + WS_Y); }
            for (int j = 0; j < njobs; ++j) {
                const bf16* A = A0; const bf16* B = B0; int Kj = K;
                pg8::Gemm g{A, B, M, N, Kj}; pg8::StaticOrder S; S.init(M, N, (int)gridDim.x, (int)blockIdx.x);
                EpiAny E{mode0 + j, ob, of, proj};
                pg8::gemm_phase<EpiAny, pg8::StaticOrder, true, true>(ldsl, g, S, E);
            }
            int tid = tid0; asm volatile("" : "+v"(tid));
            int bid = (int)blockIdx.x, nblk = (int)gridDim.x; asm volatile("" : "+s"(bid), "+s"(nblk));
            unsigned ldso = 0; asm volatile("" : "+s"(ldso));
            float* ldsf = (float*)(lds + ldso);
            const int lane = tid & 63, wave = __builtin_amdgcn_readfirstlane(tid >> 6);
            const int gw = bid * 8 + wave, ngw = nblk * 8;
            if (k == 1) {
                for (int rep = 0; rep < ((PROBE_SUB & 1) ? 2 : 1); ++rep) { asm volatile("" : "+v"(tid), "+s"(bid)); phase_compress_mfma(a, l, (unsigned char*)ldsf, tid, tid & 63, __builtin_amdgcn_readfirstlane(tid >> 6), bid, nblk); }
                for (int rep = 0; rep < ((PROBE_SUB & 2) ? 2 : 1); ++rep) { asm volatile("" : "+v"(tid), "+s"(bid)); phase_dilated_mfma(a, (unsigned char*)ldsf, tid, tid & 63, __builtin_amdgcn_readfirstlane(tid >> 6), bid, nblk); }
                for (int rep = 0; rep < ((PROBE_SUB & 4) ? 2 : 1); ++rep) { asm volatile("" : "+v"(tid), "+s"(bid)); phase_diff_mfma(a, l, (unsigned char*)ldsf, tid, tid & 63, __builtin_amdgcn_readfirstlane(tid >> 6), bid, nblk); } }
            else if (k == 3) { phase_dil_combine(a, lane, gw, ngw); phase_nsa_mfma(a, (unsigned char*)ldsf, tid, lane, wave, bid, nblk); }
            else if (k == 6) { float* xo = a.out(); const float* xi = (l == 0) ? a.in(0) : xo;
                for (int m = gw; m < M; m += ngw) rowpass_row(xi + (size_t)m * DM, (const bf16*)(ws + WS_Y) + (size_t)m * DM, a.in(16) + (size_t)l * DM, a.in(17) + (size_t)l * DM, xo + (size_t)m * DM, H + (size_t)m * DM, lane); }
            else if (k == 9) { float* xo = a.out(); const float* gn = (l + 1 < DEPTH) ? a.in(15) + (size_t)(l + 1) * DM : nullptr;
                for (int m = gw; m < M; m += ngw) rowpass_row(xo + (size_t)m * DM, (const bf16*)(ws + WS_Y) + (size_t)m * DM, a.in(18) + (size_t)l * DM, gn, xo + (size_t)m * DM, H + (size_t)m * DM, lane); }
        }
        if (ph + 1 < ph_hi) { XcdBarrier xbar; xbar.bar = (unsigned*)(a.ws() + WS_BAR); xbar.x = xb_xcc_id(); xbar.st = (volatile LAS unsigned*)(ldsl + PTAB_OFF + 256); xcd_barrier(xbar); }
        if (ph_hi > 100000) grid.sync();
    }
}

#ifndef N_LAUNCH_SPLIT
#define N_LAUNCH_SPLIT 0
#endif
extern "C" void kernel_launch(void* const* d_in, const int* in_sizes, int n_in, void* d_out, int out_size, void* d_ws, size_t ws_size, hipStream_t stream) {
    static int grid = 0;
    if (grid == 0) {
        if (n_in != 21 || out_size != M * DM || ws_size < WS_END) { fprintf(stderr, "kernel_launch: unexpected shapes (n_in %d out %d ws %zu)\n", n_in, out_size, ws_size); grid = -1; return; }
        int dev = 0, cus = 0, per_cu = 0;
        (void)hipGetDevice(&dev); (void)hipDeviceGetAttribute(&cus, hipDeviceAttributeMultiprocessorCount, dev);
        if (hipFuncSetAttribute((const void*)mega_fwd, hipFuncAttributeMaxDynamicSharedMemorySize, LDS_BYTES) != hipSuccess) { fprintf(stderr, "hipFuncSetAttribute failed\n"); grid = -1; return; }
        if (hipOccupancyMaxActiveBlocksPerMultiprocessor(&per_cu, (const void*)mega_fwd, 512, LDS_BYTES) != hipSuccess || per_cu < 1) { fprintf(stderr, "occupancy query: %d\n", per_cu); per_cu = 1; }
        (void)hipGetLastError();
        grid = cus > 0 ? cus : 256;
    }
    if (grid < 0) return;
    if (hipMemsetAsync((char*)d_ws + WS_BAR, 0, 16384, stream) != hipSuccess) { fprintf(stderr, "kernel_launch: memset of the barrier words failed\n"); return; }
    Args a{};
    for (int i = 0; i < 21; ++i) a.in[i] = (const float*)d_in[i];
    a.out = (float*)d_out; a.ws = (unsigned char*)d_ws;
#if N_LAUNCH_SPLIT
    for (int ph = 0; ph < NPH; ++ph) { a.ph_lo = ph; a.ph_hi = ph + 1; hipLaunchKernelGGL(mega_fwd, dim3(grid), dim3(512), LDS_BYTES, stream, a); }
#else
    a.ph_lo = 0; a.ph_hi = NPH;
    void* args[] = {&a};
    hipError_t e = hipLaunchCooperativeKernel((const void*)mega_fwd, dim3(grid), dim3(512), args, LDS_BYTES, stream);
    if (e != hipSuccess) fprintf(stderr, "cooperative launch failed: %s (grid %d)\n", hipGetErrorString(e), grid);
#endif
}
```

```cpp
#include <hip/hip_runtime.h>
#include <hip/hip_cooperative_groups.h>
#include <cstdio>
#include <cstdint>
namespace cg = cooperative_groups;
namespace pg8 {
#define PG8_LAS __attribute__((address_space(3)))
typedef unsigned short bf16_t;
typedef short bf16x8 __attribute__((ext_vector_type(8)));
typedef float f32x4 __attribute__((ext_vector_type(4)));
typedef unsigned u32x4 __attribute__((ext_vector_type(4)));
constexpr int BM = 256, BK = 64, HALF = 128, HTB = HALF * BK * 2  , STAGE_BYTES = 8 * HTB, NXCD = 8, WGM = 8;

__host__ __device__ __forceinline__ int lds_byte(int r, int c) { const int st = (r >> 4) * 2 + (c >> 5), rr = r & 15, cc = c & 31, ob = rr * 64 + cc * 2; return st * 1024 + (ob ^ (((ob >> 9) & 1) << 5)); }
__host__ __device__ __forceinline__ void stage_rc(int b, int& R, int& C) { const int st = b / 1024, sb = b % 1024, swz = sb ^ (((sb >> 9) & 1) << 5); R = (st >> 1) * 16 + swz / 64; C = (st & 1) * 32 + (swz % 64) / 2; }
__host__ __device__ __forceinline__ int perm32(int rho) { const int n = rho >> 4, i = rho & 15; return 8 * (i >> 2) + 4 * n + (i & 3); }

struct Unit { int pm, pn; };
struct Gemm { const bf16_t* A; const bf16_t* Bt; int M, N, K; };

struct StaticOrder {
    int nM, nN, nwg, G, c;
    __host__ __device__ void init(int M, int N, int G_, int c_) { nM = M / BM; nN = N / BM; nwg = nM * nN; G = G_; c = c_; }
    __host__ __device__ bool next(int i, Unit& u) const {
        const long L = (long)i * G + c; if (L >= nwg) return false;
        int wgid = (int)L; { const int q = nwg / NXCD, r = nwg % NXCD, xcd = wgid % NXCD, off = wgid / NXCD; wgid = (xcd < r ? xcd * (q + 1) : r * (q + 1) + (xcd - r) * q) + off; }
        const int nig = WGM * nN, gid = wgid / nig, fm = gid * WGM, gsz = (nM - fm) < WGM ? (nM - fm) : WGM;
        u.pm = fm + ((wgid % nig) % gsz); u.pn = (wgid % nig) / gsz; return true;
    }
    __device__ __forceinline__ void a_ready(const Unit&) const {}
    __device__ __forceinline__ void done(const Unit&) const {}
};

__device__ __forceinline__ unsigned cvt_pk_bf16(float lo, float hi) { unsigned r; asm volatile("v_cvt_pk_bf16_f32 %0, %1, %2" : "=v"(r) : "v"(lo), "v"(hi)); return r; }
typedef float f32x2 __attribute__((ext_vector_type(2)));
template <class Epi, class Sched, bool ALIGN_EPI = false, bool SP2 = false>
__device__ __forceinline__ void gemm_phase(PG8_LAS unsigned char* lds, const Gemm g, const Sched& S, const Epi& E) {
    const int tid = threadIdx.x, wid = __builtin_amdgcn_readfirstlane(tid >> 6), lane = tid & 63, wr = wid >> 2, wc = wid & 3, fr = lane & 15, fq = lane >> 4;
    const int K = g.K, nt = K / BK;
    unsigned voffA[2], voffB[2];
#pragma unroll
    for (int i = 0; i < 2; ++i) { int R, C; stage_rc(tid * 16 + i * 8192, R, C); const int Rb = Epi::PERM ? ((R & ~31) + perm32(R & 31)) : R;
        voffA[i] = (unsigned)(R * K + C) * 2u; voffB[i] = (unsigned)(Rb * K + C) * 2u; }
    const size_t kstep = (size_t)(BK * 2);
    const size_t hstep = (size_t)HALF * K * 2;
    const size_t tstep = 2 * hstep;
    const unsigned ldsw = (unsigned)wid * 1024u;
    const int aoff = lds_byte(wr * 64 + fr, fq * 8), boff = lds_byte(wc * 32 + fr, fq * 8);
#define PG8_SA(b, h) (((b) * 2 + (h)) * HTB)
#define PG8_SB(b, h) ((4 + (b) * 2 + (h)) * HTB)
#define PG8_STAGE(bufoff, gbase, voff) do { _Pragma("unroll") for (int _i = 0; _i < 2; ++_i) \
        __builtin_amdgcn_global_load_lds((const unsigned*)((const char*)(gbase) + (voff)[_i]), (PG8_LAS unsigned*)(lds + (bufoff) + ldsw + _i * 8192), 16, 0, 0); } while (0)
#define PG8_LDA(dst, b, h) do { _Pragma("unroll") for (int m = 0; m < 4; ++m) _Pragma("unroll") for (int k = 0; k < 2; ++k) dst[m][k] = *(const PG8_LAS bf16x8*)(lds + PG8_SA(b, h) + aoff + m * 2048 + k * 1024); } while (0)
#define PG8_LDB(dst, b, h) do { _Pragma("unroll") for (int n = 0; n < 2; ++n) _Pragma("unroll") for (int k = 0; k < 2; ++k) dst[n][k] = *(const PG8_LAS bf16x8*)(lds + PG8_SB(b, h) + boff + n * 2048 + k * 1024); } while (0)
#define PG8_MMA(ai, bj, At, Bt) do { __builtin_amdgcn_s_setprio(1); _Pragma("unroll") for (int m = 0; m < 4; ++m) _Pragma("unroll") for (int n = 0; n < 2; ++n) _Pragma("unroll") for (int k = 0; k < 2; ++k) \
        acc[ai][bj][m][n] = __builtin_amdgcn_mfma_f32_16x16x32_bf16(Bt[n][k], At[m][k], acc[ai][bj][m][n], 0, 0, 0); __builtin_amdgcn_s_setprio(0); } while (0)
#define PG8_WAIT_V(n) asm volatile("s_waitcnt vmcnt(" #n ")" ::: "memory")
#define PG8_WAIT_L(n) asm volatile("s_waitcnt lgkmcnt(" #n ")" ::: "memory")
#define PG8_BAR __builtin_amdgcn_s_barrier()
#define PG8_SCHED __builtin_amdgcn_sched_barrier(0)
    Unit cur, nxt; int ui = 0;
    if (!S.next(0, cur)) return;
    f32x4 acc[2][2][4][2];
#pragma unroll
    for (int a = 0; a < 2; ++a)
#pragma unroll
        for (int b = 0; b < 2; ++b)
#pragma unroll
            for (int m = 0; m < 4; ++m)
#pragma unroll
                for (int n = 0; n < 2; ++n) acc[a][b][m][n] = (f32x4){0.f, 0.f, 0.f, 0.f};
    bf16x8 At[4][2], B0[2][2], B1[2][2];
    const char* cA = (const char*)g.A + (size_t)cur.pm * tstep; const char* cB = (const char*)g.Bt + (size_t)cur.pn * tstep;
    S.a_ready(cur);
    if constexpr (SP2) {
        PG8_STAGE(PG8_SB(0, 0), cB, voffB); PG8_STAGE(PG8_SB(0, 1), cB + hstep, voffB); PG8_STAGE(PG8_SA(0, 0), cA, voffA); PG8_STAGE(PG8_SA(0, 1), cA + hstep, voffA);
        if (wr == 1) PG8_BAR;
        PG8_WAIT_V(2); PG8_BAR;
        PG8_STAGE(PG8_SB(1, 0), cB + kstep, voffB); PG8_STAGE(PG8_SA(1, 0), cA + kstep, voffA); PG8_STAGE(PG8_SB(1, 1), cB + hstep + kstep, voffB);
        PG8_WAIT_V(6); PG8_BAR;
    } else {
        PG8_STAGE(PG8_SB(0, 0), cB, voffB); PG8_STAGE(PG8_SA(0, 0), cA, voffA); PG8_STAGE(PG8_SB(0, 1), cB + hstep, voffB); PG8_STAGE(PG8_SA(0, 1), cA + hstep, voffA);
        if (wr == 1) PG8_BAR;
        PG8_WAIT_V(4); PG8_BAR;
        PG8_STAGE(PG8_SB(1, 0), cB + kstep, voffB); PG8_STAGE(PG8_SA(1, 0), cA + kstep, voffA); PG8_STAGE(PG8_SB(1, 1), cB + hstep + kstep, voffB);
        PG8_WAIT_V(6); PG8_BAR;
    }
    for (;;) {
        const bool has_next = S.next(ui + 1, nxt);
        const char* nA = has_next ? (const char*)g.A + (size_t)nxt.pm * tstep : cA; const char* nB = has_next ? (const char*)g.Bt + (size_t)nxt.pn * tstep : cB;
        for (int t = 0; t < nt; t += 2) {
            if constexpr (Epi::KHOOK) { if (E.khook_at(t)) E.khook(acc, cur, t, wr, wc, fr, fq); }
            const bool last = (t == nt - 2);
            const char* a1 = cA + (size_t)(t + 1) * kstep;
            const char* a2 = last ? nA : cA + (size_t)(t + 2) * kstep; const char* b2 = last ? nB : cB + (size_t)(t + 2) * kstep;
            const char* a3 = a2 + kstep; const char* b3 = b2 + kstep;
            if (last && has_next) S.a_ready(nxt);
            if constexpr (SP2) {
            PG8_LDB(B0, 0, 0); PG8_LDB(B1, 0, 1); PG8_SCHED; PG8_LDA(At, 0, 0); PG8_STAGE(PG8_SA(1, 1), a1 + hstep, voffA);
            PG8_WAIT_V(8); PG8_WAIT_L(0); PG8_BAR; PG8_MMA(0, 0, At, B0); PG8_MMA(0, 1, At, B1); PG8_BAR; PG8_SCHED;
            PG8_LDA(At, 0, 1); PG8_STAGE(PG8_SB(0, 0), b2, voffB); PG8_STAGE(PG8_SB(0, 1), b2 + hstep, voffB); PG8_STAGE(PG8_SA(0, 0), a2, voffA);
            PG8_WAIT_V(8); PG8_WAIT_L(0); PG8_BAR; PG8_MMA(1, 0, At, B0); PG8_MMA(1, 1, At, B1); PG8_BAR; PG8_SCHED;
            PG8_LDB(B0, 1, 0); PG8_LDB(B1, 1, 1); PG8_SCHED; PG8_LDA(At, 1, 0); PG8_STAGE(PG8_SA(0, 1), a2 + hstep, voffA);
            PG8_WAIT_V(8); PG8_WAIT_L(0); PG8_BAR; PG8_MMA(0, 0, At, B0); PG8_MMA(0, 1, At, B1); PG8_BAR; PG8_SCHED;
            PG8_LDA(At, 1, 1); PG8_STAGE(PG8_SB(1, 0), b3, voffB); PG8_STAGE(PG8_SB(1, 1), b3 + hstep, voffB); PG8_STAGE(PG8_SA(1, 0), a3, voffA);
            PG8_WAIT_V(8); PG8_WAIT_L(0); PG8_BAR; PG8_MMA(1, 0, At, B0); PG8_MMA(1, 1, At, B1); PG8_BAR; PG8_SCHED;
            } else {
            PG8_LDB(B0, 0, 0); PG8_SCHED; PG8_LDA(At, 0, 0); PG8_STAGE(PG8_SA(1, 1), a1 + hstep, voffA);
            PG8_WAIT_L(8); PG8_BAR; PG8_WAIT_L(0); PG8_MMA(0, 0, At, B0); PG8_BAR; PG8_SCHED;
            PG8_LDB(B1, 0, 1); PG8_STAGE(PG8_SB(0, 0), b2, voffB);
            PG8_BAR; PG8_WAIT_L(0); PG8_MMA(0, 1, At, B1); PG8_BAR;
            PG8_LDA(At, 0, 1); PG8_STAGE(PG8_SA(0, 0), a2, voffA);
            PG8_BAR; PG8_WAIT_L(0); PG8_MMA(1, 0, At, B0); PG8_BAR; PG8_SCHED;
            PG8_STAGE(PG8_SB(0, 1), b2 + hstep, voffB);
            PG8_WAIT_V(6); PG8_BAR; PG8_MMA(1, 1, At, B1); PG8_BAR;
            PG8_LDB(B0, 1, 0); PG8_SCHED; PG8_LDA(At, 1, 0); PG8_STAGE(PG8_SA(0, 1), a2 + hstep, voffA);
            PG8_WAIT_L(8); PG8_BAR; PG8_WAIT_L(0); PG8_MMA(0, 0, At, B0); PG8_BAR; PG8_SCHED;
            PG8_LDB(B1, 1, 1); PG8_STAGE(PG8_SB(1, 0), b3, voffB);
            PG8_BAR; PG8_WAIT_L(0); PG8_MMA(0, 1, At, B1); PG8_BAR;
            PG8_LDA(At, 1, 1); PG8_STAGE(PG8_SA(1, 0), a3, voffA);
            PG8_BAR; PG8_WAIT_L(0); PG8_MMA(1, 0, At, B0); PG8_BAR; PG8_SCHED;
            PG8_STAGE(PG8_SB(1, 1), b3 + hstep, voffB);
            PG8_WAIT_V(6); PG8_BAR; PG8_MMA(1, 1, At, B1); PG8_BAR;
            }
        }
        if constexpr (ALIGN_EPI) { if (wr == 0) PG8_BAR; }
        if constexpr (!Epi::AFTER_DRAIN) { E(acc, cur, wr, wc, fr, fq); S.done(cur); }
        if (!has_next) break;
#pragma unroll
        for (int a = 0; a < 2; ++a)
#pragma unroll
            for (int b = 0; b < 2; ++b)
#pragma unroll
                for (int m = 0; m < 4; ++m)
#pragma unroll
                    for (int n = 0; n < 2; ++n) acc[a][b][m][n] = (f32x4){0.f, 0.f, 0.f, 0.f};
        cur = nxt; cA = nA; cB = nB; ++ui;
        if constexpr (ALIGN_EPI) { if (wr == 1) PG8_BAR; }
    }
    PG8_WAIT_V(0);
    if constexpr (!ALIGN_EPI) { if (wr == 0) PG8_BAR; }
    PG8_BAR;
    if constexpr (Epi::AFTER_DRAIN) { E.fused(acc, cur, wr, wc, fr, fq, lds, wid, lane); S.done(cur); }
#undef PG8_SA
#undef PG8_SB
#undef PG8_STAGE
#undef PG8_LDA
#undef PG8_LDB
#undef PG8_MMA
#undef PG8_WAIT_V
#undef PG8_WAIT_L
#undef PG8_BAR
#undef PG8_SCHED
}
}
#ifndef PROBE_SUB
#define PROBE_SUB 0
#endif
#ifndef PROBE_DUP
#define PROBE_DUP 0
#endif
#ifndef PROBE_DUPK
#define PROBE_DUPK -1
#endif
#ifndef PROBE_PRO
#define PROBE_PRO 0
#endif
#define LAS __attribute__((address_space(3)))
typedef unsigned short bf16;
typedef float f32x4 __attribute__((ext_vector_type(4)));
typedef unsigned u32x4 __attribute__((ext_vector_type(4)));
typedef unsigned u32x2 __attribute__((ext_vector_type(2)));

constexpr int BATCH = 4, SEQ = 2048, DM = 2048, M = BATCH * SEQ, DEPTH = 2;
constexpr int NIN = 15664, NP = 15872, DFF = 8192;
constexpr int OFF_BQ = 4608, OFF_BKV = 5632, OFF_BG = 6400, OFF_CQ = 6448, OFF_CK = 7472, OFF_CV = 8496, OFF_MG = 9520;
constexpr int BT = 2112;
constexpr int NCMP = 127;
constexpr size_t MiB = 1u << 20;
constexpr size_t WS_WT = 0, LAYER_W = 144 * MiB;
constexpr size_t WO_IN = 0, WO_A = 62 * MiB, WO_B = 64 * MiB, WO_C = 68 * MiB, WO_OUT = 72 * MiB, WO_UP = 80 * MiB, WO_DOWN = 112 * MiB;
constexpr size_t WS_H = 288 * MiB, WS_PROJ = 320 * MiB, WS_U = WS_PROJ;
constexpr size_t WS_OA = 568 * MiB, WS_OB = 576 * MiB, WS_OC = 592 * MiB, WS_OCMP = 608 * MiB;
constexpr size_t WS_MIXF = 640 * MiB, WS_MIXB = 704 * MiB, WS_Y = 736 * MiB;
constexpr size_t WS_KC = 800 * MiB, WS_VC = 801 * MiB, WS_SELM = 802 * MiB, WS_BIAST = 803 * MiB, WS_CW = 804 * MiB, WS_BAR = 812 * MiB, WS_END = 813 * MiB;
constexpr int LDS_BYTES = 147456;
constexpr int PH_PER_LAYER = 9;
constexpr int NPH = 1 + DEPTH * PH_PER_LAYER;

struct Args { const float* in[21]; float* out; unsigned char* ws; int ph_lo, ph_hi; };
constexpr int PTAB_OFF = 131072 + 1024;
struct PT { const unsigned long long* t;
    __device__ __forceinline__ unsigned long long get(int i) const { const unsigned long long v = t[i]; const unsigned lo = __builtin_amdgcn_readfirstlane((unsigned)v), hi = __builtin_amdgcn_readfirstlane((unsigned)(v >> 32)); return ((unsigned long long)hi << 32) | lo; }
    __device__ __forceinline__ const float* in(int i) const { return (const float*)(const __attribute__((address_space(1))) float*)get(i); }
    __device__ __forceinline__ float* out() const { return (float*)(__attribute__((address_space(1))) float*)get(21); }
    __device__ __forceinline__ unsigned char* ws() const { return (unsigned char*)(__attribute__((address_space(1))) unsigned char*)get(22); } };

#define LDS_FENCE() asm volatile("s_waitcnt vmcnt(0) lgkmcnt(0)" ::: "memory")

__device__ __forceinline__ unsigned f2bf(float f) { unsigned u = __builtin_bit_cast(unsigned, f); return (u + 0x7fffu + ((u >> 16) & 1u)) >> 16; }
__device__ __forceinline__ unsigned pk2(float lo, float hi) { return f2bf(lo) | (f2bf(hi) << 16); }
typedef __bf16 bf16v2_t __attribute__((ext_vector_type(2)));
typedef float f32v2_t __attribute__((ext_vector_type(2)));
__device__ __forceinline__ unsigned pkh(float lo, float hi) { f32v2_t v; v.x = lo; v.y = hi; return __builtin_bit_cast(unsigned, __builtin_convertvector(v, bf16v2_t)); }
__device__ __forceinline__ float bf_lo(unsigned w) { return __uint_as_float(w << 16); }
__device__ __forceinline__ float bf_hi(unsigned w) { return __uint_as_float(w & 0xffff0000u); }
__device__ __forceinline__ float bf2f(bf16 h) { return __uint_as_float(((unsigned)h) << 16); }
__device__ __forceinline__ float wave_sum(float v) {
#pragma unroll
    for (int o = 32; o >= 1; o >>= 1) v += __shfl_xor(v, o);
    return v;
}
__device__ __forceinline__ float wave_max(float v) {
#pragma unroll
    for (int o = 32; o >= 1; o >>= 1) v = fmaxf(v, __shfl_xor(v, o));
    return v;
}
__device__ __forceinline__ float sigmoidf_(float x) { return 1.0f / (1.0f + __expf(-x)); }

__device__ __forceinline__ void load64(const bf16* p, float (&q)[64]) {
    const u32x4* p4 = (const u32x4*)p;
#pragma unroll
    for (int i = 0; i < 8; ++i) { const u32x4 w = p4[i];
        q[8 * i + 0] = bf_lo(w.x); q[8 * i + 1] = bf_hi(w.x); q[8 * i + 2] = bf_lo(w.y); q[8 * i + 3] = bf_hi(w.y);
        q[8 * i + 4] = bf_lo(w.z); q[8 * i + 5] = bf_hi(w.z); q[8 * i + 6] = bf_lo(w.w); q[8 * i + 7] = bf_hi(w.w); }
}
__device__ __forceinline__ float dot64(const float (&q)[64], const bf16* k) {
    const u32x4* k4 = (const u32x4*)k; float a0 = 0.f, a1 = 0.f;
#pragma unroll
    for (int i = 0; i < 8; ++i) { const u32x4 w = k4[i];
        a0 += q[8 * i + 0] * bf_lo(w.x); a1 += q[8 * i + 1] * bf_hi(w.x); a0 += q[8 * i + 2] * bf_lo(w.y); a1 += q[8 * i + 3] * bf_hi(w.y);
        a0 += q[8 * i + 4] * bf_lo(w.z); a1 += q[8 * i + 5] * bf_hi(w.z); a0 += q[8 * i + 6] * bf_lo(w.w); a1 += q[8 * i + 7] * bf_hi(w.w); }
    return a0 + a1;
}
__device__ __forceinline__ float wave_softmax(float* S, int n, int lane, float& mout) {
    float m = -3.0e38f;
    for (int i = lane; i < n; i += 64) m = fmaxf(m, S[i]);
    m = wave_max(m);
    float s = 0.f;
    for (int i = lane; i < n; i += 64) { const float e = __expf(S[i] - m); S[i] = e; s += e; }
    s = wave_sum(s); mout = m; return s;
}

struct TItem { const float* W; bf16* WT; int K, N, item, pitch; };
struct TRegs { f32x4 v0[8], v1[8]; };
__device__ __forceinline__ void titem_load(const TItem& t, TRegs& R, int lane) {
    const int nblk = (t.N + 63) / 64, kb = t.item / nblk, nb = t.item % nblk, k0 = 64 * kb, n0 = 64 * nb;
    const int rg = lane >> 4, c4 = lane & 15, nn = n0 + 4 * c4; const bool ok = nn < t.N;
#pragma unroll
    for (int i = 0; i < 8; ++i) { const float* p = t.W + (size_t)(k0 + 8 * i + 2 * rg) * t.N + nn;
        R.v0[i] = ok ? *(const f32x4*)p : (f32x4){0.f, 0.f, 0.f, 0.f}; R.v1[i] = ok ? *(const f32x4*)(p + t.N) : (f32x4){0.f, 0.f, 0.f, 0.f}; }
}
__device__ __forceinline__ void titem_store(const TItem& t, const TRegs& R, float* scrf, int lane) {
    unsigned* scr = (unsigned*)scrf;
    const int nblk = (t.N + 63) / 64, kb = t.item / nblk, nb = t.item % nblk, k0 = 64 * kb, n0 = 64 * nb;
    const int rg = lane >> 4, c4 = lane & 15;
#pragma unroll
    for (int i = 0; i < 8; ++i) { unsigned* q = scr + (4 * i + rg) * 66 + 4 * c4;
        q[0] = pkh(R.v0[i].x, R.v1[i].x); q[1] = pkh(R.v0[i].y, R.v1[i].y); q[2] = pkh(R.v0[i].z, R.v1[i].z); q[3] = pkh(R.v0[i].w, R.v1[i].w); }
    LDS_FENCE();
    const int c = lane & 7;
#pragma unroll
    for (int j = 0; j < 8; ++j) { const int n = (lane >> 3) + 8 * j; const unsigned* s = scr + (4 * c) * 66 + n;
        u32x4 o; o.x = s[0]; o.y = s[66]; o.z = s[132]; o.w = s[198];
        *(u32x4*)(t.WT + (size_t)(n0 + n) * t.pitch + k0 + 8 * c) = o; }
    LDS_FENCE();
}
__device__ __forceinline__ int t5_bucket(int d) {
    if (d < 16) return d;
    const float logd = logf((float)d / 16.0f);
    int far = 16 + (int)(logd / 4.852030263919617f * 16.0f);
    return far < 31 ? far : 31;
}
__device__ __forceinline__ void rms_row_to_bf16(const float* xrow, const float* gain, bf16* orow, int lane) {
    const f32x4* xr = (const f32x4*)xrow + lane; const f32x4* gr = (const f32x4*)gain + lane;
    f32x4 v[8]; float s = 0.f;
#pragma unroll
    for (int j = 0; j < 8; ++j) { v[j] = xr[64 * j]; s += (v[j].x * v[j].x + v[j].y * v[j].y) + (v[j].z * v[j].z + v[j].w * v[j].w); }
    const float r = 1.0f / sqrtf(wave_sum(s) * (1.0f / DM) + 1e-6f);
    u32x2* o8 = (u32x2*)orow + lane;
#pragma unroll
    for (int j = 0; j < 8; ++j) { const f32x4 g = gr[64 * j]; u32x2 w; w.x = pk2(v[j].x * r * g.x, v[j].y * r * g.y); w.y = pk2(v[j].z * r * g.z, v[j].w * r * g.w); o8[64 * j] = w; }
}
__device__ __forceinline__ void rowpass_row(const float* xi, const bf16* y, const float* gp, const float* gn, float* xo, bf16* h, int lane) {
    const u32x2* yr = (const u32x2*)y + lane; const f32x4* xr = (const f32x4*)xi + lane; const f32x4* gpr = (const f32x4*)gp + lane;
    u32x2 yw[8]; f32x4 xv[8], gv[8];
#pragma unroll
    for (int j = 0; j < 8; ++j) { yw[j] = yr[64 * j]; xv[j] = xr[64 * j]; gv[j] = gpr[64 * j]; }
    asm volatile("" : "+v"(xv[0]), "+v"(xv[1]), "+v"(xv[2]), "+v"(xv[3]), "+v"(xv[4]), "+v"(xv[5]), "+v"(xv[6]), "+v"(xv[7]));
    asm volatile("" : "+v"(gv[0]), "+v"(gv[1]), "+v"(gv[2]), "+v"(gv[3]), "+v"(gv[4]), "+v"(gv[5]), "+v"(gv[6]), "+v"(gv[7]));
    f32x4 v[8]; float s = 0.f;
#pragma unroll
    for (int j = 0; j < 8; ++j) { const u32x2 w = yw[j]; v[j].x = bf_lo(w.x); v[j].y = bf_hi(w.x); v[j].z = bf_lo(w.y); v[j].w = bf_hi(w.y); s += (v[j].x * v[j].x + v[j].y * v[j].y) + (v[j].z * v[j].z + v[j].w * v[j].w); }
    const float r = 1.0f / sqrtf(wave_sum(s) * (1.0f / DM) + 1e-6f);
    float s2 = 0.f;
#pragma unroll
    for (int j = 0; j < 8; ++j) { v[j] = xv[j] + v[j] * r * gv[j]; s2 += (v[j].x * v[j].x + v[j].y * v[j].y) + (v[j].z * v[j].z + v[j].w * v[j].w); }
    f32x4* xw = (f32x4*)xo + lane;
#pragma unroll
    for (int j = 0; j < 8; ++j) xw[64 * j] = v[j];
    if (gn) {
        const f32x4* gnr = (const f32x4*)gn + lane;
#pragma unroll
        for (int j = 0; j < 8; ++j) gv[j] = gnr[64 * j];
        asm volatile("" : "+v"(gv[0]), "+v"(gv[1]), "+v"(gv[2]), "+v"(gv[3]), "+v"(gv[4]), "+v"(gv[5]), "+v"(gv[6]), "+v"(gv[7]));
        const float r2 = 1.0f / sqrtf(wave_sum(s2) * (1.0f / DM) + 1e-6f);
        u32x2* o8 = (u32x2*)h + lane;
#pragma unroll
        for (int j = 0; j < 8; ++j) { const f32x4 g = gv[j]; u32x2 w; w.x = pkh(v[j].x * r2 * g.x, v[j].y * r2 * g.y); w.y = pkh(v[j].z * r2 * g.z, v[j].w * r2 * g.w); o8[64 * j] = w; }
    }
}

constexpr int IT_IN = 32 * 245, IT_A = 8 * 32, IT_B = 16 * 32, IT_C = 16 * 32, IT_OUT = 32 * 32, IT_UP = 32 * 128, IT_DOWN = 128 * 32;
constexpr int IT_W1 = 32 * 4, IT_W2 = 4 * 1;
constexpr int IT_LAYER = IT_IN + IT_A + IT_B + IT_C + IT_OUT + IT_UP + IT_DOWN + 2 * IT_W1 + 2 * IT_W2;

__device__ __forceinline__ TItem decode_item(const PT a, unsigned char* ws, int it) {
    const int l = it / IT_LAYER; int r = it % IT_LAYER;
    unsigned char* wl = ws + WS_WT + (size_t)l * LAYER_W; unsigned char* cw = ws + WS_CW + (size_t)l * 4 * MiB;
    TItem t;
    if (r < IT_IN) { t.W = a.in(2) + (size_t)l * DM * NIN; t.K = DM; t.N = NIN; t.WT = (bf16*)(wl + WO_IN); t.item = r; t.pitch = t.K; return t; } r -= IT_IN;
    if (r < IT_A) { t.W = a.in(11) + (size_t)l * 512 * DM; t.K = 512; t.N = DM; t.WT = (bf16*)(wl + WO_A); t.item = r; t.pitch = 2560; return t; } r -= IT_A;
    if (r < IT_B) { t.W = a.in(12) + (size_t)l * 1024 * DM; t.K = 1024; t.N = DM; t.WT = (bf16*)(wl + WO_A) + 512; t.item = r; t.pitch = 2560; return t; } r -= IT_B;
    if (r < IT_C) { t.W = a.in(13) + (size_t)l * 1024 * DM; t.K = 1024; t.N = DM; t.WT = (bf16*)(wl + WO_A) + 1536; t.item = r; t.pitch = 2560; return t; } r -= IT_C;
    if (r < IT_OUT) { t.W = a.in(14) + (size_t)l * DM * DM; t.K = DM; t.N = DM; t.WT = (bf16*)(wl + WO_OUT); t.item = r; t.pitch = t.K; return t; } r -= IT_OUT;
    if (r < IT_UP) { t.W = a.in(19) + (size_t)l * DM * DFF; t.K = DM; t.N = DFF; t.WT = (bf16*)(wl + WO_UP); t.item = r; t.pitch = t.K; return t; } r -= IT_UP;
    if (r < IT_DOWN) { t.W = a.in(20) + (size_t)l * DFF * DM; t.K = DFF; t.N = DM; t.WT = (bf16*)(wl + WO_DOWN); t.item = r; t.pitch = t.K; return t; } r -= IT_DOWN;
    if (r < IT_W1) { t.W = a.in(5) + (size_t)l * 2048 * 256; t.K = 2048; t.N = 256; t.WT = (bf16*)cw; t.item = r; t.pitch = t.K; return t; } r -= IT_W1;
    if (r < IT_W1) { t.W = a.in(7) + (size_t)l * 2048 * 256; t.K = 2048; t.N = 256; t.WT = (bf16*)(cw + MiB); t.item = r; t.pitch = t.K; return t; } r -= IT_W1;
    if (r < IT_W2) { t.W = a.in(6) + (size_t)l * 256 * 64; t.K = 256; t.N = 64; t.WT = (bf16*)(cw + 2 * MiB); t.item = r; t.pitch = t.K; return t; } r -= IT_W2;
    t.W = a.in(8) + (size_t)l * 256 * 64; t.K = 256; t.N = 64; t.WT = (bf16*)(cw + 2 * MiB + 65536); t.item = r; t.pitch = t.K; return t;
}
__device__ __forceinline__ void phase_prologue(const PT a, float* ldsf, int lane, int wave, int gw, int ngw) {
    float* scr = ldsf + wave * 4096;
    unsigned char* ws = a.ws();
    constexpr int NIT = DEPTH * IT_LAYER;
    if (gw < NIT) {
        int it = gw; TItem cur = decode_item(a, ws, it); TRegs R; titem_load(cur, R, lane);
        for (;;) {
            const int nx = it + ngw; const bool more = nx < NIT;
            TItem nxt = cur; TRegs R2 = R;
            if (more) { nxt = decode_item(a, ws, nx); titem_load(nxt, R2, lane); }
            titem_store(cur, R, scr, lane);
            if (!more) break;
            cur = nxt; R = R2; it = nx;
        }
    }
    float* biasT = (float*)(ws + WS_BIAST);
    for (int i = gw * 64 + lane; i < 48 * BT; i += ngw * 64) { const int col = i / BT, d = i % BT; biasT[i] = a.in(1)[t5_bucket(d) * 48 + col]; }
    for (int m = gw; m < M; m += ngw) rms_row_to_bf16(a.in(0) + (size_t)m * DM, a.in(15), (bf16*)(ws + WS_H) + (size_t)m * DM, lane);
}

struct EpiAny { static constexpr bool PERM = true, AFTER_DRAIN = false, KHOOK = true;
    int mode; bf16* ob; float* of; const bf16* proj;
    __device__ __forceinline__ bool khook_at(int t) const { return mode == 6 && (t == 8 || t == 24); }
    __device__ __forceinline__ void khook(pg8::f32x4 (&acc)[2][2][4][2], const pg8::Unit& u, int t, int wr, int wc, int fr, int fq) const {
        const int step = (t == 8) ? 0 : 1;
        { int tl = (int)threadIdx.x; asm volatile("" : "+v"(tl)); fr = tl & 15; fq = (tl >> 4) & 3; }
#pragma unroll
        for (int ai = 0; ai < 2; ++ai) {
                u32x2 zc[16], zn[16];
#pragma unroll
                for (int q = 0; q < 16; ++q) { const int m = q >> 2, bj = (q >> 1) & 1, n = q & 1;
                    const int row = u.pm * 256 + ai * 128 + wr * 64 + m * 16 + fr, col = u.pn * 256 + bj * 128 + wc * 32 + 8 * fq + 4 * n;
                    const bf16* gp = proj + (size_t)row * NP + OFF_MG + step * DM + col; zc[q] = *(const u32x2*)gp; zn[q] = *(const u32x2*)(gp + DM); }
#pragma unroll
                for (int q = 0; q < 16; ++q) { const int m = q >> 2, bj = (q >> 1) & 1, n = q & 1;
                    pg8::f32x4 t0 = acc[ai][bj][m][n];
                    t0[0] *= (1.f + __expf(-bf_lo(zn[q].x))) * __builtin_amdgcn_rcpf(1.f + __expf(-bf_lo(zc[q].x))); t0[1] *= (1.f + __expf(-bf_hi(zn[q].x))) * __builtin_amdgcn_rcpf(1.f + __expf(-bf_hi(zc[q].x)));
                    t0[2] *= (1.f + __expf(-bf_lo(zn[q].y))) * __builtin_amdgcn_rcpf(1.f + __expf(-bf_lo(zc[q].y))); t0[3] *= (1.f + __expf(-bf_hi(zn[q].y))) * __builtin_amdgcn_rcpf(1.f + __expf(-bf_hi(zc[q].y)));
                    acc[ai][bj][m][n] = t0; }
                asm volatile("" ::: "memory"); }
    }
    template <int MODE> __device__ __forceinline__ void run(const pg8::f32x4 (&acc)[2][2][4][2], const pg8::Unit& u, int wr, int wc, int fr, int fq) const {
        constexpr int LDC = (MODE == 0) ? NP : (MODE == 5 ? DFF : DM);
        { int tl = (int)threadIdx.x; asm volatile("" : "+v"(tl)); fr = tl & 15; fq = (tl >> 4) & 3; }
#pragma unroll
        for (int ai = 0; ai < 2; ++ai)
#pragma unroll
            for (int mp = 0; mp < 2; ++mp) {
                u32x4 gpre[4];
                if constexpr (MODE == 6) {
#pragma unroll
                    for (int q = 0; q < 4; ++q) { const int m = 2 * mp + (q >> 1), bj = q & 1; const int row = u.pm * 256 + ai * 128 + wr * 64 + m * 16 + fr, col = u.pn * 256 + bj * 128 + wc * 32 + 8 * fq;
                        gpre[q] = *(const u32x4*)(proj + (size_t)row * NP + OFF_MG + 2 * DM + col); }
                }
#pragma unroll
                for (int q = 0; q < 4; ++q) { const int m = 2 * mp + (q >> 1), bj = q & 1; const int row = u.pm * 256 + ai * 128 + wr * 64 + m * 16 + fr, col = u.pn * 256 + bj * 128 + wc * 32 + 8 * fq;
                    const pg8::f32x4 t0 = acc[ai][bj][m][0], t1 = acc[ai][bj][m][1];
                    float v[8] = {t0[0], t0[1], t0[2], t0[3], t1[0], t1[1], t1[2], t1[3]};
                    if constexpr (MODE == 5) {
#pragma unroll
                        for (int e = 0; e < 8; ++e) { const float r = fmaxf(v[e], 0.f); v[e] = r * r; }
                    }
                    if constexpr (MODE == 6) { const u32x4 g = gpre[q];
                        v[0] *= sigmoidf_(bf_lo(g.x)); v[1] *= sigmoidf_(bf_hi(g.x)); v[2] *= sigmoidf_(bf_lo(g.y)); v[3] *= sigmoidf_(bf_hi(g.y));
                        v[4] *= sigmoidf_(bf_lo(g.z)); v[5] *= sigmoidf_(bf_hi(g.z)); v[6] *= sigmoidf_(bf_lo(g.w)); v[7] *= sigmoidf_(bf_hi(g.w)); }
                    u32x4 w; w.x = pkh(v[0], v[1]); w.y = pkh(v[2], v[3]); w.z = pkh(v[4], v[5]); w.w = pkh(v[6], v[7]);
                    *(u32x4*)(ob + (size_t)row * LDC + col) = w; }
                asm volatile("" ::: "memory"); }
    }
    __device__ __forceinline__ void operator()(const pg8::f32x4 (&acc)[2][2][4][2], const pg8::Unit& u, int wr, int wc, int fr, int fq) const {
        if (mode == 0) run<0>(acc, u, wr, wc, fr, fq);
        else if (mode == 4) run<4>(acc, u, wr, wc, fr, fq);
        else if (mode == 5) run<5>(acc, u, wr, wc, fr, fq);
        else run<6>(acc, u, wr, wc, fr, fq);
    } };


constexpr int KCAT = 2560;
typedef short bf16x8 __attribute__((ext_vector_type(8)));
typedef short bf16x4 __attribute__((ext_vector_type(4)));
typedef float f32x16 __attribute__((ext_vector_type(16)));
#define MFMA32(a, b, c) __builtin_amdgcn_mfma_f32_32x32x16_bf16(a, b, c, 0, 0, 0)

template <int KW, int NDS> struct KVRegs { u32x4 k[KW / 64]; u32x4 v[NDS / 2]; };

template <int KW, int NDS> __device__ __forceinline__ void load_tile(KVRegs<KW, NDS>& R, const bf16* base_b, int tok0, int tstride, int kcol, int vcol, int tid) {
#pragma unroll
    for (int r = 0; r < KW / 64; ++r) { const int idx = tid + 512 * r, key = idx / (KW / 8), ch = idx % (KW / 8);
        R.k[r] = *(const u32x4*)(base_b + (size_t)(tok0 + key * tstride) * NP + kcol + ch * 8); }
#pragma unroll
    for (int r = 0; r < NDS / 2; ++r) { const int idx = tid + 512 * r, key = idx & 63, ch = idx >> 6;
        R.v[r] = *(const u32x4*)(base_b + (size_t)(tok0 + key * tstride) * NP + vcol + ch * 8); }
}
template <int KW, int NDS> __device__ __forceinline__ void store_tile(const KVRegs<KW, NDS>& R, bf16* Ks, bf16* Vt, int tid) {
#pragma unroll
    for (int r = 0; r < KW / 64; ++r) { const int idx = tid + 512 * r, key = idx / (KW / 8), ch = idx % (KW / 8);
        *(u32x4*)(Ks + key * (KW + 8) + ch * 8) = R.k[r]; }
#pragma unroll
    for (int r = 0; r < NDS / 2; ++r) { const int idx = tid + 512 * r, key = idx & 63, ch = idx >> 6; const u32x4 w = R.v[r]; bf16* p = Vt + (ch * 8) * 68 + key;
        p[0 * 68] = (bf16)(w.x & 0xffffu); p[1 * 68] = (bf16)(w.x >> 16); p[2 * 68] = (bf16)(w.y & 0xffffu); p[3 * 68] = (bf16)(w.y >> 16);
        p[4 * 68] = (bf16)(w.z & 0xffffu); p[5 * 68] = (bf16)(w.z >> 16); p[6 * 68] = (bf16)(w.w & 0xffffu); p[7 * 68] = (bf16)(w.w >> 16); }
}
constexpr float LOG2E = 1.4426950408889634f;
constexpr float QSCALE2 = 0.125f * LOG2E;
__device__ __forceinline__ void load_qfrag(const bf16* qrow, int hi, bf16x8 (&qf)[4], float sc) {
    u32x4 w0 = *(const u32x4*)(qrow + 0 * 16 + hi * 8), w1 = *(const u32x4*)(qrow + 1 * 16 + hi * 8), w2 = *(const u32x4*)(qrow + 2 * 16 + hi * 8), w3 = *(const u32x4*)(qrow + 3 * 16 + hi * 8);
    asm volatile("" : "+v"(w0), "+v"(w1), "+v"(w2), "+v"(w3));
    const u32x4 wv[4] = {w0, w1, w2, w3};
#pragma unroll
    for (int c = 0; c < 4; ++c) { const u32x4 w = wv[c]; u32x4 o;
        o.x = pkh(bf_lo(w.x) * sc, bf_hi(w.x) * sc); o.y = pkh(bf_lo(w.y) * sc, bf_hi(w.y) * sc);
        o.z = pkh(bf_lo(w.z) * sc, bf_hi(w.z) * sc); o.w = pkh(bf_lo(w.w) * sc, bf_hi(w.w) * sc);
        qf[c] = __builtin_bit_cast(bf16x8, o); }
}
template <int KP, int NDS> __device__ __forceinline__ void attn_tile(const bf16x8 (&qf)[4], const bf16* Ks, const bf16* Vt, float& m, float& l, f32x16 (&O)[NDS],
                                                                       const float* tab, int dq, int maxd, bool tile_ok, int pmode, float cb, int l32, int hi) {
    f32x16 s0, s1;
#pragma unroll
    for (int i = 0; i < 16; ++i) { s0[i] = 0.f; s1[i] = 0.f; }
#pragma unroll
    for (int c = 0; c < 4; ++c) { const bf16x8 a0 = *(const bf16x8*)(Ks + l32 * KP + c * 16 + hi * 8); const bf16x8 a1 = *(const bf16x8*)(Ks + (32 + l32) * KP + c * 16 + hi * 8);
        s0 = MFMA32(a0, qf[c], s0); s1 = MFMA32(a1, qf[c], s1); }
    float mx = -1e30f, sub;
    if (pmode == 2) {
#pragma unroll
        for (int i = 0; i < 16; ++i) mx = fmaxf(mx, fmaxf(s0[i], s1[i]));
        mx = fmaxf(mx, __shfl_xor(mx, 32)) + cb;
    } else if (pmode == 1) {
        const float* tp = tab + (dq - 4 * hi);
#pragma unroll
        for (int h4 = 0; h4 < 4; ++h4) { float bb[4];
#pragma unroll
            for (int j = 0; j < 4; ++j) bb[j] = tp[-(h4 * 8 + j)];
#pragma unroll
            for (int j = 0; j < 4; ++j) { const int i = 4 * h4 + j; s0[i] = tile_ok ? s0[i] + bb[j] : -INFINITY; mx = fmaxf(mx, s0[i]); } }
#pragma unroll
        for (int h4 = 0; h4 < 4; ++h4) { float bb[4];
#pragma unroll
            for (int j = 0; j < 4; ++j) bb[j] = tp[-(32 + h4 * 8 + j)];
#pragma unroll
            for (int j = 0; j < 4; ++j) { const int i = 4 * h4 + j; s1[i] = tile_ok ? s1[i] + bb[j] : -INFINITY; mx = fmaxf(mx, s1[i]); } }
        mx = fmaxf(mx, __shfl_xor(mx, 32));
    } else {
        const int dq4 = dq - 4 * hi, cl = maxd < 2047 ? maxd : 2047;
#pragma unroll
        for (int h4 = 0; h4 < 4; ++h4) { float bb[4];
#pragma unroll
            for (int j = 0; j < 4; ++j) { const int d0 = dq4 - (h4 * 8 + j); bb[j] = tab[d0 < 0 ? 0 : (d0 > cl ? cl : d0)]; }
#pragma unroll
            for (int j = 0; j < 4; ++j) { const int i = 4 * h4 + j; const int d0 = dq4 - (h4 * 8 + j); const bool v0 = tile_ok && (unsigned)d0 <= (unsigned)maxd;
                s0[i] = v0 ? s0[i] + bb[j] : -INFINITY; mx = fmaxf(mx, s0[i]); } }
#pragma unroll
        for (int h4 = 0; h4 < 4; ++h4) { float bb[4];
#pragma unroll
            for (int j = 0; j < 4; ++j) { const int d1 = dq4 - 32 - (h4 * 8 + j); bb[j] = tab[d1 < 0 ? 0 : (d1 > cl ? cl : d1)]; }
#pragma unroll
            for (int j = 0; j < 4; ++j) { const int i = 4 * h4 + j; const int d1 = dq4 - 32 - (h4 * 8 + j); const bool v1 = tile_ok && (unsigned)d1 <= (unsigned)maxd;
                s1[i] = v1 ? s1[i] + bb[j] : -INFINITY; mx = fmaxf(mx, s1[i]); } }
        mx = fmaxf(mx, __shfl_xor(mx, 32));
    }
    const float mn = fmaxf(m, mx), alpha = __builtin_amdgcn_exp2f(m - mn);
    const bool resc = __any(mn != m);
    m = mn; sub = (pmode == 2) ? mn - cb : mn;
    s0 = s0 - sub; s1 = s1 - sub;
#pragma unroll
    for (int i = 0; i < 16; ++i) { s0[i] = __builtin_amdgcn_exp2f(s0[i]); s1[i] = __builtin_amdgcn_exp2f(s1[i]); }
    const f32x16 ss = s0 + s1;
    const float rs = ((ss[0] + ss[1]) + (ss[2] + ss[3])) + ((ss[4] + ss[5]) + (ss[6] + ss[7])) + (((ss[8] + ss[9]) + (ss[10] + ss[11])) + ((ss[12] + ss[13]) + (ss[14] + ss[15])));
    l = l * alpha + rs;
    if (resc) {
#pragma unroll
        for (int ds = 0; ds < NDS; ++ds)
#pragma unroll
            for (int i = 0; i < 16; ++i) O[ds][i] *= alpha;
    }
#pragma unroll
    for (int c = 0; c < 4; ++c) {
        u32x4 pw;
        if (c == 0) { pw.x = pkh(s0[0], s0[1]); pw.y = pkh(s0[2], s0[3]); pw.z = pkh(s0[4], s0[5]); pw.w = pkh(s0[6], s0[7]); }
        else if (c == 1) { pw.x = pkh(s0[8], s0[9]); pw.y = pkh(s0[10], s0[11]); pw.z = pkh(s0[12], s0[13]); pw.w = pkh(s0[14], s0[15]); }
        else if (c == 2) { pw.x = pkh(s1[0], s1[1]); pw.y = pkh(s1[2], s1[3]); pw.z = pkh(s1[4], s1[5]); pw.w = pkh(s1[6], s1[7]); }
        else { pw.x = pkh(s1[8], s1[9]); pw.y = pkh(s1[10], s1[11]); pw.z = pkh(s1[12], s1[13]); pw.w = pkh(s1[14], s1[15]); }
        const bf16x8 pb = __builtin_bit_cast(bf16x8, pw);
#pragma unroll
        for (int ds = 0; ds < NDS; ++ds) { const bf16* vp = Vt + (ds * 32 + l32) * 68 + 16 * c + 4 * hi;
            const u32x2 lo = *(const u32x2*)vp, hi2 = *(const u32x2*)(vp + 8); u32x4 vw; vw.x = lo.x; vw.y = lo.y; vw.z = hi2.x; vw.w = hi2.y;
            O[ds] = MFMA32(__builtin_bit_cast(bf16x8, vw), pb, O[ds]); }
    }
}
template <int KW, int NDS, int SLOT, bool TWO> __device__ __forceinline__ void attn_pass(unsigned tmask, const bf16* base_b, int tok_base, int tstride, int kcol, int vcol, bf16* Ks, bf16* Vt, int kofs,
        const bf16x8 (&qf)[4], float& m, float& l, f32x16 (&O)[NDS], const float* tab, const unsigned char* bk, int iq, int maxd, unsigned okbits, int wave_maxq, int wave_lo, int tid, int l32, int hi) {
    if (!tmask) return;
    KVRegs<KW, NDS> Ra, Rb; int ja = __builtin_ctz(tmask), jb = -1; tmask &= tmask - 1;
    if (TWO && tmask) { jb = __builtin_ctz(tmask); tmask &= tmask - 1; }
    load_tile<KW, NDS>(Ra, base_b, tok_base + ja * 64 * tstride, tstride, kcol, vcol, tid);
    if (TWO && jb >= 0) load_tile<KW, NDS>(Rb, base_b, tok_base + jb * 64 * tstride, tstride, kcol, vcol, tid);
    for (;;) {
        __syncthreads(); store_tile<KW, NDS>(Ra, Ks, Vt, tid); if (TWO && jb >= 0) store_tile<KW, NDS>(Rb, Ks + SLOT, Vt + SLOT, tid); __syncthreads();
        const int ca = ja, cb = jb; const bool more = tmask != 0u;
        if (more) { ja = __builtin_ctz(tmask); tmask &= tmask - 1; jb = -1; if (TWO && tmask) { jb = __builtin_ctz(tmask); tmask &= tmask - 1; }
            load_tile<KW, NDS>(Ra, base_b, tok_base + ja * 64 * tstride, tstride, kcol, vcol, tid);
            if (TWO && jb >= 0) load_tile<KW, NDS>(Rb, base_b, tok_base + jb * 64 * tstride, tstride, kcol, vcol, tid); }
#pragma unroll 1
        for (int s = 0; s < (TWO ? 2 : 1); ++s) { const int c = s ? cb : ca;
            if (c >= 0 && c * 64 <= wave_maxq && c * 64 + 63 >= wave_lo) {
                const bool tok = ((okbits >> c) & 1u) != 0u;
                int pmode = 0; float cbias = 0.f;
                if (bk) { const int dmin = wave_maxq - 31 - c * 64 - 63, dmax = wave_maxq - c * 64;
                    if (dmin >= 0 && dmax <= maxd && dmax <= 2047) { pmode = 1; if (__all(tok) && bk[dmin] == bk[dmax]) { pmode = 2; cbias = tab[dmin]; } } }
                attn_tile<KW + 8, NDS>(qf, Ks + s * SLOT + kofs, Vt + s * SLOT, m, l, O, tab, iq - c * 64, maxd, tok, pmode, cbias, l32, hi); } }
        if (!more) break;
    }
}
__device__ __forceinline__ unsigned range_mask(int lo, int hi_incl) { const unsigned up = (hi_incl >= 31) ? 0xffffffffu : ((1u << (hi_incl + 1)) - 1u); return up & ~((1u << lo) - 1u); }

__device__ __forceinline__ void cmp_unit(const PT a, unsigned char* ldsb, unsigned* selL, int b, int g, int qt, int tid, int lane, int wave) {
    unsigned char* ws = a.ws(); const bf16* proj = (const bf16*)(ws + WS_PROJ);
    const float* kc = (const float*)(ws + WS_KC); const float* vc = (const float*)(ws + WS_VC); float* ocmp = (float*)(ws + WS_OCMP);
    bf16* Khi = (bf16*)ldsb; bf16* Klo = (bf16*)(ldsb + 18432); bf16* Vt = (bf16*)(ldsb + 104448); float* SC = (float*)ldsb;
    const int l32 = lane & 31, hi = lane >> 5;
    __syncthreads();
    {
        const int hh = g * 8 + wave, t0 = qt * 32, tq = t0 + l32, tok = b * SEQ + tq;
        {
            const int n = tid >> 2, seg = tid & 3;
            const f32x4* kp = (const f32x4*)(kc + (size_t)((b * NCMP + (n < NCMP ? n : 0)) * 2 + g) * 64 + seg * 16);
            u32x4 h0, h1, l0, l1; f32x4 x[4];
#pragma unroll
            for (int e = 0; e < 4; ++e) { x[e] = kp[e]; if (n >= NCMP) x[e] = (f32x4){0.f, 0.f, 0.f, 0.f}; }
            unsigned hw[8], lw[8];
#pragma unroll
            for (int e = 0; e < 4; ++e) { const unsigned a0 = f2bf(x[e].x), a1 = f2bf(x[e].y), a2 = f2bf(x[e].z), a3 = f2bf(x[e].w);
                hw[2 * e] = a0 | (a1 << 16); hw[2 * e + 1] = a2 | (a3 << 16);
                lw[2 * e] = pk2(x[e].x - __uint_as_float(a0 << 16), x[e].y - __uint_as_float(a1 << 16)); lw[2 * e + 1] = pk2(x[e].z - __uint_as_float(a2 << 16), x[e].w - __uint_as_float(a3 << 16)); }
            h0.x = hw[0]; h0.y = hw[1]; h0.z = hw[2]; h0.w = hw[3]; h1.x = hw[4]; h1.y = hw[5]; h1.z = hw[6]; h1.w = hw[7];
            l0.x = lw[0]; l0.y = lw[1]; l0.z = lw[2]; l0.w = lw[3]; l1.x = lw[4]; l1.y = lw[5]; l1.z = lw[6]; l1.w = lw[7];
            *(u32x4*)(Khi + n * 72 + seg * 16) = h0; *(u32x4*)(Khi + n * 72 + seg * 16 + 8) = h1;
            *(u32x4*)(Klo + n * 72 + seg * 16) = l0; *(u32x4*)(Klo + n * 72 + seg * 16 + 8) = l1;
            const int nv_ = tid & 127, dseg = tid >> 7;
            const f32x4* vp = (const f32x4*)(vc + (size_t)((b * NCMP + (nv_ < NCMP ? nv_ : 0)) * 2 + g) * 64 + dseg * 16);
#pragma unroll
            for (int e = 0; e < 4; ++e) { f32x4 v = vp[e]; if (nv_ >= NCMP) v = (f32x4){0.f, 0.f, 0.f, 0.f}; bf16* p = Vt + (dseg * 16 + e * 4) * 136 + nv_;
                p[0] = (bf16)f2bf(v.x); p[136] = (bf16)f2bf(v.y); p[272] = (bf16)f2bf(v.z); p[408] = (bf16)f2bf(v.w); }
        }
        bf16x8 qf[4]; load_qfrag(proj + (size_t)tok * NP + OFF_BQ + hh * 64, hi, qf, 0.125f);
        __syncthreads();
        f32x16 s[4];
#pragma unroll
        for (int st = 0; st < 4; ++st) {
#pragma unroll
            for (int i = 0; i < 16; ++i) s[st][i] = 0.f;
#pragma unroll
            for (int c = 0; c < 4; ++c) { const bf16x8 ah = *(const bf16x8*)(Khi + (st * 32 + l32) * 72 + c * 16 + hi * 8); const bf16x8 al = *(const bf16x8*)(Klo + (st * 32 + l32) * 72 + c * 16 + hi * 8);
                s[st] = MFMA32(ah, qf[c], s[st]); s[st] = MFMA32(al, qf[c], s[st]); }
        }
        int nvq = tq >= 31 ? (tq - 31) / 16 + 1 : 0; nvq = nvq < NCMP ? nvq : NCMP;
        float mx = -1e30f;
#pragma unroll
        for (int st = 0; st < 4; ++st)
#pragma unroll
            for (int i = 0; i < 16; ++i) { const int n = 32 * st + (i >> 2) * 8 + 4 * hi + (i & 3); if (n < nvq) mx = fmaxf(mx, s[st][i]); }
        mx = fmaxf(mx, __shfl_xor(mx, 32));
        float rs = 0.f;
#pragma unroll
        for (int st = 0; st < 4; ++st)
#pragma unroll
            for (int i = 0; i < 16; ++i) { const int n = 32 * st + (i >> 2) * 8 + 4 * hi + (i & 3); const float e = (n < nvq) ? __expf(s[st][i] - mx) : 0.f; s[st][i] = e; rs += e; }
        rs += __shfl_xor(rs, 32);
        const float inv = nvq > 0 ? 1.0f / rs : 0.f;
#pragma unroll
        for (int st = 0; st < 4; ++st)
#pragma unroll
            for (int i = 0; i < 16; ++i) s[st][i] *= inv;
        f32x16 O[2];
#pragma unroll
        for (int ds = 0; ds < 2; ++ds)
#pragma unroll
            for (int i = 0; i < 16; ++i) O[ds][i] = 0.f;
#pragma unroll
        for (int st = 0; st < 4; ++st)
#pragma unroll
            for (int c2 = 0; c2 < 2; ++c2) { const int c = 2 * st + c2; u32x4 pw;
                pw.x = pk2(s[st][8 * c2 + 0], s[st][8 * c2 + 1]); pw.y = pk2(s[st][8 * c2 + 2], s[st][8 * c2 + 3]); pw.z = pk2(s[st][8 * c2 + 4], s[st][8 * c2 + 5]); pw.w = pk2(s[st][8 * c2 + 6], s[st][8 * c2 + 7]);
                const bf16x8 pb = __builtin_bit_cast(bf16x8, pw);
#pragma unroll
                for (int ds = 0; ds < 2; ++ds) { const bf16* vp = Vt + (ds * 32 + l32) * 136 + 16 * c + 4 * hi;
                    const u32x2 lo = *(const u32x2*)vp, hi2 = *(const u32x2*)(vp + 8); u32x4 vw; vw.x = lo.x; vw.y = lo.y; vw.z = hi2.x; vw.w = hi2.y;
                    O[ds] = MFMA32(__builtin_bit_cast(bf16x8, vw), pb, O[ds]); } }
#pragma unroll
        for (int ds = 0; ds < 2; ++ds)
#pragma unroll
            for (int i4 = 0; i4 < 4; ++i4) { f32x4 v; v.x = O[ds][i4 * 4 + 0]; v.y = O[ds][i4 * 4 + 1]; v.z = O[ds][i4 * 4 + 2]; v.w = O[ds][i4 * 4 + 3];
                *(f32x4*)(ocmp + (size_t)tok * 1024 + hh * 64 + ds * 32 + i4 * 8 + 4 * hi) = v; }
        __syncthreads();
        {
            float prev_other = 0.f;
#pragma unroll
            for (int st = 0; st < 4; ++st)
#pragma unroll
                for (int i4 = 0; i4 < 4; ++i4) {
                    const float gs = (s[st][4 * i4] + s[st][4 * i4 + 1]) + (s[st][4 * i4 + 2] + s[st][4 * i4 + 3]);
                    const float other = __shfl_xor(s[st][4 * i4 + 3], 32);
                    const float c = gs + (hi ? other : prev_other);
                    prev_other = other;
                    SC[(wave * 32 + l32) * 33 + 8 * st + 2 * i4 + hi] = c;
                }
        }
        __syncthreads();
#pragma unroll 1
        for (int ps = 0; ps < 2; ++ps) {
            const int q = 4 * wave + 2 * ps + hi, j = l32, t = t0 + q, cur = t >> 6;
            float sc = 0.f;
#pragma unroll
            for (int w = 0; w < 8; ++w) sc += SC[(w * 32 + q) * 33 + j];
            if (j == 0 || cur - j == 0 || cur - j == 1) sc = 1e6f;
            if (j > cur) sc = -1e30f;
            int rank = 0;
#pragma unroll 1
            for (int i = 0; i < 32; ++i) { const float si = __shfl(sc, (lane & 32) + i); rank += (si > sc || (si == sc && i < j)) ? 1 : 0; }
            const bool sel = (rank < 16) && (j <= cur);
            const unsigned long long bal = __ballot(sel);
            if (l32 == 0) selL[q] = hi ? (unsigned)(bal >> 32) : (unsigned)bal;
        }
        __syncthreads();
    }
}


__device__ __forceinline__ void phase_nsa_mfma(const PT a, unsigned char* ldsb, int tid, int lane, int wave, int bid, int nblk) {
    unsigned char* ws = a.ws(); const bf16* proj = (const bf16*)(ws + WS_PROJ); const float* biasT = (const float*)(ws + WS_BIAST);
    const float* ocmp = (const float*)(ws + WS_OCMP); bf16* ob = (bf16*)(ws + WS_OA);
    bf16* Ks = (bf16*)ldsb; bf16* Vt = (bf16*)(ldsb + 9216); float* tabs = (float*)(ldsb + 36864); unsigned char* bk = ldsb + 102400; unsigned* selL = (unsigned*)(ldsb + 121856);
    int gcur = -1;
    __syncthreads();
    for (int u = bid; u < 512; u += nblk) {
        const int bg = u & 7, b = bg >> 1, g = bg & 1, qt = u < 256 ? 63 - (u >> 3) : ((u - 256) >> 3);
        if (g != gcur) { __syncthreads();
            for (int i = tid; i < 8 * 2048; i += 512) tabs[i] = biasT[(24 + g * 8 + (i >> 11)) * BT + (i & 2047)] * LOG2E; for (int i = tid; i < 2048; i += 512) bk[i] = (unsigned char)t5_bucket(i); gcur = g; }
        const int hh = g * 8 + wave, t0 = qt * 32;
        const bf16* base_b = proj + (size_t)b * SEQ * NP;
        cmp_unit(a, ldsb, selL, b, g, qt, tid, lane, wave);
        asm volatile("" : "+v"(lane), "+v"(tid) :: "memory");
        const int l32 = lane & 31, hi = lane >> 5, tq = t0 + l32, tok = b * SEQ + tq;
        bf16x8 qf[4]; load_qfrag(proj + (size_t)tok * NP + OFF_BQ + hh * 64, hi, qf, QSCALE2);
        const unsigned mq = selL[l32];
        unsigned un = mq;
#pragma unroll
        for (int o = 1; o < 32; o <<= 1) un |= (unsigned)__shfl_xor((int)un, o);
        un = (unsigned)__builtin_amdgcn_readfirstlane((int)un);
        const float* tab = tabs + wave * 2048;
        f32x16 Os[2], Ow[2]; float m = -1e30f, l = 0.f;
#pragma unroll
        for (int ds = 0; ds < 2; ++ds)
#pragma unroll
            for (int i = 0; i < 16; ++i) { Os[ds][i] = 0.f; Ow[ds][i] = 0.f; }
        attn_pass<64, 2, 8960, true>(un, base_b, 0, 1, OFF_BKV + (4 + g) * 64, OFF_BKV + (6 + g) * 64, Ks, Vt, 0, qf, m, l, Os, tab, bk, tq, 1 << 20, mq, t0 + 31, -(1 << 20), tid, l32, hi);
        const float isel = 1.0f / (l + __shfl_xor(l, 32));
        m = -1e30f; l = 0.f;
        const int wlo = (t0 - 511 > 0 ? t0 - 511 : 0) >> 6, whi = (t0 + 31) >> 6;
        attn_pass<64, 2, 8960, true>(range_mask(wlo, whi), base_b, 0, 1, OFF_BKV + (8 + g) * 64, OFF_BKV + (10 + g) * 64, Ks, Vt, 0, qf, m, l, Ow, tab, bk, tq, 511, 0xffffffffu, t0 + 31, -(1 << 20), tid, l32, hi);
        const float iwin = 1.0f / (l + __shfl_xor(l, 32));
        const bf16* gp = proj + (size_t)tok * NP + OFF_BG + hh * 3;
        const float g0 = sigmoidf_(bf2f(gp[0])), g1 = sigmoidf_(bf2f(gp[1])) * isel, g2 = sigmoidf_(bf2f(gp[2])) * iwin;
        f32x4 ocv[8];
#pragma unroll
        for (int q = 0; q < 8; ++q) ocv[q] = *(const f32x4*)(ocmp + (size_t)tok * 1024 + hh * 64 + (q >> 2) * 32 + (q & 3) * 8 + 4 * hi);
        asm volatile("" : "+v"(ocv[0]), "+v"(ocv[1]), "+v"(ocv[2]), "+v"(ocv[3]), "+v"(ocv[4]), "+v"(ocv[5]), "+v"(ocv[6]), "+v"(ocv[7]));
#pragma unroll
        for (int ds = 0; ds < 2; ++ds)
#pragma unroll
            for (int i4 = 0; i4 < 4; ++i4) { const int d = ds * 32 + i4 * 8 + 4 * hi;
                const f32x4 oc = ocv[ds * 4 + i4];
                const float r0 = g0 * oc.x + g1 * Os[ds][i4 * 4 + 0] + g2 * Ow[ds][i4 * 4 + 0], r1 = g0 * oc.y + g1 * Os[ds][i4 * 4 + 1] + g2 * Ow[ds][i4 * 4 + 1];
                const float r2 = g0 * oc.z + g1 * Os[ds][i4 * 4 + 2] + g2 * Ow[ds][i4 * 4 + 2], r3 = g0 * oc.w + g1 * Os[ds][i4 * 4 + 3] + g2 * Ow[ds][i4 * 4 + 3];
                u32x2 w; w.x = pk2(r0, r1); w.y = pk2(r2, r3); *(u32x2*)(ob + (size_t)tok * KCAT + 512 + hh * 64 + d) = w; }
    }
    __syncthreads();
}

__device__ __forceinline__ void phase_diff_mfma(const PT a, int lyr, unsigned char* ldsb, int tid, int lane, int wave, int bid, int nblk) {
    unsigned char* ws = a.ws(); const bf16* proj = (const bf16*)(ws + WS_PROJ); const float* biasT = (const float*)(ws + WS_BIAST); bf16* oc = (bf16*)(ws + WS_OA);
    const float* lv = a.in(9) + (size_t)lyr * 256; const float* sg = a.in(10) + (size_t)lyr * 128;
    const float lam_init = 0.8f - 0.6f * expf(-0.3f * (float)lyr);
    const float lam = expf(wave_sum(lv[lane] * lv[64 + lane])) - expf(wave_sum(lv[128 + lane] * lv[192 + lane])) + lam_init;
    bf16* Ks = (bf16*)ldsb; bf16* Vt = (bf16*)(ldsb + 17408); float* tab = (float*)(ldsb + 69632); unsigned char* bk = ldsb + 77824; float* sgl = (float*)(ldsb + 79872); float* O2 = (float*)ldsb;
    const int l32 = lane & 31, hi = lane >> 5, mp = wave >> 2, wq = wave & 3;
    int hcur = -1;
    __syncthreads();
    if (tid < 128) sgl[tid] = sg[tid];
    for (int u = bid; u < 512; u += nblk) {
        const int bh = u & 31, b = bh >> 3, h = bh & 7, qt = u < 256 ? 15 - (u >> 5) : ((u - 256) >> 5);
        if (h != hcur) { __syncthreads(); for (int i = tid; i < 2048; i += 512) { tab[i] = biasT[(40 + h) * BT + i] * LOG2E; bk[i] = (unsigned char)t5_bucket(i); } hcur = h; }
        const int t0 = qt * 128, tq = t0 + wq * 32 + l32, tok = b * SEQ + tq;
        const bf16* base_b = proj + (size_t)b * SEQ * NP;
        bf16x8 qf[4]; load_qfrag(proj + (size_t)tok * NP + OFF_CQ + (h * 2 + mp) * 64, hi, qf, QSCALE2);
        f32x16 O[4]; float m = -1e30f, l = 0.f;
#pragma unroll
        for (int ds = 0; ds < 4; ++ds)
#pragma unroll
            for (int i = 0; i < 16; ++i) O[ds][i] = 0.f;
        attn_pass<128, 4, 17408, false>(range_mask(0, (t0 + 127) >> 6), base_b, 0, 1, OFF_CK + h * 128, OFF_CV + h * 128, Ks, Vt, mp * 64, qf, m, l, O, tab, bk, tq, 1 << 20, 0xffffffffu, t0 + wq * 32 + 31, -(1 << 20), tid, l32, hi);
        const float inv = 1.0f / (l + __shfl_xor(l, 32));
        __syncthreads();
        if (mp == 1) {
#pragma unroll
            for (int ds = 0; ds < 4; ++ds)
#pragma unroll
                for (int i = 0; i < 16; ++i) O2[(ds * 16 + i) * 256 + wq * 64 + lane] = O[ds][i] * inv;
        }
        __syncthreads();
        if (mp == 0) {
            float ss = 0.f;
#pragma unroll
            for (int ds = 0; ds < 4; ++ds)
#pragma unroll
                for (int i = 0; i < 16; ++i) { const float o = O[ds][i] * inv - lam * O2[(ds * 16 + i) * 256 + wq * 64 + lane]; O[ds][i] = o; ss += o * o; }
            ss += __shfl_xor(ss, 32);
            const float r = (1.0f - lam_init) / sqrtf(ss * (1.0f / 128.0f) + 1e-6f);
#pragma unroll
            for (int ds = 0; ds < 4; ++ds)
#pragma unroll
                for (int i4 = 0; i4 < 4; ++i4) { const int d = ds * 32 + i4 * 8 + 4 * hi; const f32x4 gn = *(const f32x4*)(sgl + d);
                    u32x2 w; w.x = pkh(O[ds][i4 * 4 + 0] * r * gn.x, O[ds][i4 * 4 + 1] * r * gn.y); w.y = pkh(O[ds][i4 * 4 + 2] * r * gn.z, O[ds][i4 * 4 + 3] * r * gn.w);
                    *(u32x2*)(oc + (size_t)tok * KCAT + 1536 + h * 128 + d) = w; }
        }
        __syncthreads();
    }
}


constexpr size_t WS_OAG = WS_MIXF, WS_LSE = WS_MIXB;
__device__ __forceinline__ void phase_dilated_mfma(const PT a, unsigned char* ldsb, int tid, int lane, int wave, int bid, int nblk) {
    unsigned char* ws = a.ws(); const bf16* proj = (const bf16*)(ws + WS_PROJ); const float* biasT = (const float*)(ws + WS_BIAST);
    float* oag = (float*)(ws + WS_OAG); float* lseb = (float*)(ws + WS_LSE);
    bf16* Ks = (bf16*)ldsb; bf16* Vt = (bf16*)(ldsb + 9216); float* tab = (float*)(ldsb + 36864);
    const int l32 = lane & 31, hi = lane >> 5;
    const int nh = (nblk > 64) ? nblk - 64 : nblk, hb = (nblk > 64) ? bid - 64 : bid;
    const int n_heavy_mine = (hb >= 0) ? (512 - hb + nh - 1) / nh : 0;
    const int n_light_mine = (512 - bid + nblk - 1) / nblk;
    for (int it = 0; it < n_heavy_mine + n_light_mine; ++it) {
        const int u = it < n_heavy_mine ? hb + it * nh : 512 + bid + (it - n_heavy_mine) * nblk;
        int g, b, h, r, i0, nq;
        if (u < 256) { g = 0; b = u >> 6; h = (u >> 3) & 7; r = 0; i0 = (u & 7) * 256; nq = 256; }
        else if (u < 512) { const int v = u - 256; g = 1; b = v >> 6; h = (v >> 3) & 7; r = (v >> 1) & 3; i0 = (v & 1) * 256; nq = 256; }
        else { const int v = u - 512; g = 2; b = v >> 7; h = (v >> 4) & 7; r = v & 15; i0 = 0; nq = 128; }
        const int dil = 1 << (2 * g);
        __syncthreads();
        if (tid < 129) tab[tid] = biasT[(g * 8 + h) * BT + tid * dil] * LOG2E;
        const bool act = wave * 32 < nq;
        const int iq = i0 + ((wave * 32) % nq) + l32, tok = b * SEQ + r + dil * iq;
        const bf16* base_b = proj + (size_t)b * SEQ * NP;
        bf16x8 qf[4]; load_qfrag(proj + (size_t)tok * NP + (g * 8 + h) * 64, hi, qf, QSCALE2);
        f32x16 O[2]; float m = -1e30f, l = 0.f;
#pragma unroll
        for (int ds = 0; ds < 2; ++ds)
#pragma unroll
            for (int i = 0; i < 16; ++i) O[ds][i] = 0.f;
        const int wq0 = i0 + wave * 32;
        attn_pass<64, 2, 8960, true>(range_mask((i0 - 128 > 0 ? i0 - 128 : 0) >> 6, (i0 + nq - 1) >> 6), base_b, r, dil, ((3 + g) * 8 + h) * 64, ((6 + g) * 8 + h) * 64, Ks, Vt, 0, qf, m, l, O, tab, (const unsigned char*)nullptr, iq, 128, 0xffffffffu,
                         act ? wq0 + 31 : -1, wq0 - 128, tid, l32, hi);
        if (act) {
            const float lt = l + __shfl_xor(l, 32), inv = 1.0f / lt;
            float* op = oag + ((size_t)g * M + tok) * 512 + h * 64;
#pragma unroll
            for (int ds = 0; ds < 2; ++ds)
#pragma unroll
                for (int i4 = 0; i4 < 4; ++i4) { f32x4 v; v.x = O[ds][i4 * 4 + 0] * inv; v.y = O[ds][i4 * 4 + 1] * inv; v.z = O[ds][i4 * 4 + 2] * inv; v.w = O[ds][i4 * 4 + 3] * inv;
                    *(f32x4*)(op + ds * 32 + i4 * 8 + 4 * hi) = v; }
            if (hi == 0) lseb[((size_t)g * M + tok) * 8 + h] = (m + __log2f(lt)) * 0.6931471805599453f;
        }
    }
    __syncthreads();
}
__device__ __forceinline__ void phase_dil_combine(const PT a, int lane, int gw, int ngw) {
    unsigned char* ws = a.ws(); const float* oag = (const float*)(ws + WS_OAG); const float* lseb = (const float*)(ws + WS_LSE); bf16* oa = (bf16*)(ws + WS_OA);
    for (int tok = gw; tok < M; tok += ngw) {
        const int h = lane >> 3;
        const float l0 = lseb[((size_t)0 * M + tok) * 8 + h], l1 = lseb[((size_t)1 * M + tok) * 8 + h], l2 = lseb[((size_t)2 * M + tok) * 8 + h];
        const float mx = fmaxf(l0, fmaxf(l1, l2)); float w0 = __expf(l0 - mx), w1 = __expf(l1 - mx), w2 = __expf(l2 - mx); const float iw = 1.0f / (w0 + w1 + w2); w0 *= iw; w1 *= iw; w2 *= iw;
        const f32x4* p0 = (const f32x4*)(oag + ((size_t)0 * M + tok) * 512 + lane * 8); const f32x4* p1 = (const f32x4*)(oag + ((size_t)1 * M + tok) * 512 + lane * 8); const f32x4* p2 = (const f32x4*)(oag + ((size_t)2 * M + tok) * 512 + lane * 8);
        const f32x4 x0 = w0 * p0[0] + w1 * p1[0] + w2 * p2[0], x1 = w0 * p0[1] + w1 * p1[1] + w2 * p2[1];
        u32x4 o; o.x = pk2(x0.x, x0.y); o.y = pk2(x0.z, x0.w); o.z = pk2(x1.x, x1.y); o.w = pk2(x1.z, x1.w);
        *(u32x4*)(oa + (size_t)tok * KCAT + lane * 8) = o;
    }
}


__device__ __forceinline__ void phase_compress_mfma(const PT a, int lyr, unsigned char* ldsb, int tid, int lane, int wave, int bid, int nblk) {
    unsigned char* ws = a.ws(); const bf16* proj = (const bf16*)(ws + WS_PROJ);
    unsigned char* cw = ws + WS_CW + (size_t)lyr * 4 * MiB;
    bf16* Ab = (bf16*)ldsb; float* RED = (float*)(ldsb + 17408);
    const int l32 = lane & 31, hi = lane >> 5;
    __syncthreads();
    for (int u = bid; u < 64; u += nblk) {
        const int kv = u >> 5, rg = u & 31;
        const bf16* W1t = (const bf16*)(cw + (size_t)kv * MiB); const bf16* W2t = (const bf16*)(cw + 2 * MiB + (size_t)kv * 65536);
        const float* pos = a.in(3 + kv) + (size_t)lyr * 2048; float* dst = (float*)(ws + (kv ? WS_VC : WS_KC));
        f32x16 acc;
#pragma unroll
        for (int i = 0; i < 16; ++i) acc[i] = 0.f;
        const bf16* wrow = W1t + (size_t)(32 * wave + l32) * 2048 + hi * 8;
#pragma unroll 1
        for (int kc = 0; kc < 8; ++kc) {
            bf16x8 af[16];
#pragma unroll
            for (int kk = 0; kk < 16; ++kk) af[kk] = *(const bf16x8*)(wrow + kc * 256 + kk * 16);
            __syncthreads();
#pragma unroll
            for (int r2 = 0; r2 < 2; ++r2) { const int idx = tid + 512 * r2, row = idx >> 5, ch = idx & 31; int r = rg * 32 + row; r = r < 1016 ? r : 1015;
                const int g = r & 1, bn = r >> 1, b = bn / NCMP, n = bn % NCMP, ll = kc * 4 + (ch >> 3), d = (ch & 7) * 8;
                const u32x4 w = *(const u32x4*)(proj + (size_t)(b * SEQ + 16 * n + ll) * NP + OFF_BKV + (kv * 2 + g) * 64 + d);
                const f32x4 p0 = *(const f32x4*)(pos + ll * 64 + d), p1 = *(const f32x4*)(pos + ll * 64 + d + 4);
                u32x4 o; o.x = pk2(bf_lo(w.x) + p0.x, bf_hi(w.x) + p0.y); o.y = pk2(bf_lo(w.y) + p0.z, bf_hi(w.y) + p0.w); o.z = pk2(bf_lo(w.z) + p1.x, bf_hi(w.z) + p1.y); o.w = pk2(bf_lo(w.w) + p1.z, bf_hi(w.w) + p1.w);
                *(u32x4*)(Ab + row * 264 + ch * 8) = o; }
            __syncthreads();
#pragma unroll
            for (int kk = 0; kk < 16; ++kk) { const bf16x8 bfr = *(const bf16x8*)(Ab + l32 * 264 + kk * 16 + hi * 8); acc = MFMA32(af[kk], bfr, acc); }
        }
#pragma unroll
        for (int i = 0; i < 16; ++i) { const float v = acc[i]; acc[i] = 0.5f * v * (1.0f + tanhf(0.7978845608028654f * (v + 0.044715f * v * v * v))); }
        f32x16 o2[2];
#pragma unroll
        for (int ds = 0; ds < 2; ++ds)
#pragma unroll
            for (int i = 0; i < 16; ++i) o2[ds][i] = 0.f;
#pragma unroll
        for (int c2 = 0; c2 < 2; ++c2) { u32x4 pw; pw.x = pk2(acc[8 * c2 + 0], acc[8 * c2 + 1]); pw.y = pk2(acc[8 * c2 + 2], acc[8 * c2 + 3]); pw.z = pk2(acc[8 * c2 + 4], acc[8 * c2 + 5]); pw.w = pk2(acc[8 * c2 + 6], acc[8 * c2 + 7]);
            const bf16x8 hb = __builtin_bit_cast(bf16x8, pw);
#pragma unroll
            for (int ds = 0; ds < 2; ++ds) { const bf16* wp = W2t + (size_t)(ds * 32 + l32) * 256 + 32 * wave + 16 * c2 + 4 * hi;
                const u32x2 lo = *(const u32x2*)wp, hi2 = *(const u32x2*)(wp + 8); u32x4 vw; vw.x = lo.x; vw.y = lo.y; vw.z = hi2.x; vw.w = hi2.y;
                o2[ds] = MFMA32(__builtin_bit_cast(bf16x8, vw), hb, o2[ds]); } }
#pragma unroll
        for (int ds = 0; ds < 2; ++ds)
#pragma unroll
            for (int i = 0; i < 16; ++i) RED[(wave * 64 + ds * 32 + (i >> 2) * 8 + 4 * hi + (i & 3)) * 33 + l32] = o2[ds][i];
        __syncthreads();
#pragma unroll
        for (int e = 0; e < 4; ++e) { const int idx = tid + 512 * e, d = idx & 63, row = idx >> 6; float s = 0.f;
#pragma unroll
            for (int w = 0; w < 8; ++w) s += RED[(w * 64 + d) * 33 + row];
            const int r = rg * 32 + row; if (r < 1016) dst[(size_t)r * 64 + d] = s; }
        __syncthreads();
    }
}

#define XB_TMO      128
#define XB_XCNT(j)  (256  + 64 * (j))
#define XB_XSUB(j)  (1280 + 64 * (j))
#define XB_XGEN(j)  (2304 + 64 * (j))
#define XB_TOP      3328
#define XB_TOPGEN   3392
#define XCD_BAR_WORDS 3456
#define XB_SPIN_CAP (1u << 18)

__device__ __forceinline__ unsigned xb_ld(unsigned* p)              { return __hip_atomic_load(p, __ATOMIC_RELAXED, __HIP_MEMORY_SCOPE_AGENT); }
__device__ __forceinline__ unsigned xb_add(unsigned* p, unsigned v) { return __hip_atomic_fetch_add(p, v, __ATOMIC_RELAXED, __HIP_MEMORY_SCOPE_AGENT); }
__device__ __forceinline__ unsigned xb_xcc_id() { return (unsigned)__builtin_amdgcn_s_getreg((3 << 11) | 20) & 0xFu; }
#define XB_SPIN(cond, bar) do { unsigned _sp = 0; while (cond) { __builtin_amdgcn_s_sleep(1); \
    if ((++_sp & 255u) == 0u) { if (xb_ld(&(bar)[XB_TMO])) break; if (_sp > XB_SPIN_CAP) { atomicAdd(&(bar)[XB_TMO], 1u); break; } } } } while (0)

struct XcdBarrier {
    unsigned* bar; unsigned x;
    volatile LAS unsigned* st;
};

__device__ __forceinline__ XcdBarrier xcd_barrier_post(unsigned* bar, volatile LAS unsigned* st) {
    XcdBarrier b; b.bar = bar; b.x = xb_xcc_id(); b.st = st;
    if (threadIdx.x == 0) (void)xb_add(&bar[XB_XCNT(b.x)], 1u);
    return b;
}
__device__ __forceinline__ void xcd_barrier_complete(unsigned* bar, unsigned x, unsigned& nloc, unsigned& nx) {
    const unsigned G = gridDim.x * gridDim.y * gridDim.z;
    unsigned sum, cnt, mine, sp = 0u;
    for (;;) {
        sum = 0u; cnt = 0u; mine = 0u;
#pragma unroll
        for (unsigned j = 0; j < 16; ++j) { const unsigned c = xb_ld(&bar[XB_XCNT(j)]); sum += c; cnt += (c > 0u) ? 1u : 0u; mine = (j == x) ? c : mine; }
        if (sum == G) break;
        __builtin_amdgcn_s_sleep(1);
        if ((++sp & 255u) == 0u) { if (xb_ld(&bar[XB_TMO])) break; if (sp > XB_SPIN_CAP) { atomicAdd(&bar[XB_TMO], 1u); break; } }
    }
    nloc = mine > 0u ? mine : 1u; nx = cnt > 0u ? cnt : 1u;
}

__device__ __forceinline__ void xcd_barrier(const XcdBarrier& b) {
    asm volatile("s_waitcnt vmcnt(0)" ::: "memory");
    __syncthreads();
    if (threadIdx.x == 0) {
        unsigned* bar = b.bar;
        __builtin_amdgcn_s_waitcnt(0);
        unsigned nloc = b.st[0], nx = b.st[1];
        if (nloc == 0u) { xcd_barrier_complete(bar, b.x, nloc, nx); b.st[0] = nloc; b.st[1] = nx; }
        const unsigned old = xb_add(&bar[XB_XSUB(b.x)], 1u);
        const unsigned gen = old / nloc;
        if (old + 1u == (gen + 1u) * nloc) {
            __builtin_amdgcn_fence(__ATOMIC_RELEASE, "agent");
            asm volatile("s_waitcnt vmcnt(0)" ::: "memory");
            const unsigned og = xb_add(&bar[XB_TOP], 1u);
            const unsigned tg = og / nx;
            if (og + 1u == (tg + 1u) * nx) xb_add(&bar[XB_TOPGEN], 1u);
            else XB_SPIN(xb_ld(&bar[XB_TOPGEN]) == tg, bar);
            __builtin_amdgcn_fence(__ATOMIC_ACQUIRE, "agent");
            xb_add(&bar[XB_XGEN(b.x)], 1u);
            asm volatile("s_waitcnt vmcnt(0)" ::: "memory");
        } else {
            XB_SPIN(xb_ld(&bar[XB_XGEN(b.x)]) == gen, bar);
            __builtin_amdgcn_fence(__ATOMIC_ACQUIRE, "agent");
            asm volatile("s_waitcnt vmcnt(0)" ::: "memory");
        }
    }
    __syncthreads();
}

__global__ void __launch_bounds__(512, 2) mega_fwd(Args ka) {
    extern __shared__ __attribute__((aligned(16))) unsigned char lds[];
    LAS unsigned char* ldsl = (LAS unsigned char*)lds;
    const int tid0 = threadIdx.x;
    {
        unsigned long long* pt = (unsigned long long*)(lds + PTAB_OFF);
        if (tid0 < 21) pt[tid0] = (unsigned long long)ka.in[tid0];
        if (tid0 == 21) pt[21] = (unsigned long long)ka.out;
        if (tid0 == 22) pt[22] = (unsigned long long)ka.ws;
        if (tid0 == 23) { pt[32] = 0ull; }
        __syncthreads();
    }
    const int ph_lo = ka.ph_lo, ph_hi = ka.ph_hi;
    cg::grid_group grid = cg::this_grid();
    (void)xcd_barrier_post((unsigned*)(__attribute__((address_space(1))) unsigned*)(ka.ws + WS_BAR), (volatile LAS unsigned*)(ldsl + PTAB_OFF + 256));
    for (int ph = ph_lo; ph < ph_hi; ++ph) {
        unsigned ldso0 = 0; asm volatile("" : "+s"(ldso0));
        const PT a{(const unsigned long long*)(lds + PTAB_OFF + ldso0)};
        if (ph == 0) { int tidp = tid0; asm volatile("" : "+v"(tidp)); const int lanep = tidp & 63, wavep = __builtin_amdgcn_readfirstlane(tidp >> 6);
            phase_prologue(a, (float*)(lds + ldso0), lanep, wavep, (int)blockIdx.x * 8 + wavep, (int)gridDim.x * 8); }
        else {
            const int l = (ph - 1) / PH_PER_LAYER; int k = (ph - 1) % PH_PER_LAYER; if (k >= 2) k += 1;
            unsigned char* ws = a.ws();
            unsigned char* wl = ws + WS_WT + (size_t)l * LAYER_W;
            bf16* H = (bf16*)(ws + WS_H); bf16* proj = (bf16*)(ws + WS_PROJ);
            int njobs = 0, mode0 = 0, N = 0, K = 0; const bf16* A0 = nullptr; const bf16* B0 = nullptr; bf16* ob = nullptr; float* of = nullptr;
            if (k == 0) { njobs = 1; mode0 = 0; A0 = H; B0 = (const bf16*)(wl + WO_IN); N = NP; K = DM; ob = proj; }
            else if (k == 4) { njobs = 1; mode0 = 6; A0 = (const bf16*)(ws + WS_OA); B0 = (const bf16*)(wl + WO_A); N = DM; K = KCAT; ob = (bf16*)(ws + WS_MIXB); }
            else if (k == 5) { njobs = 1; mode0 = 4; A0 = (const bf16*)(ws + WS_MIXB); B0 = (const bf16*)(wl + WO_OUT); N = DM; K = DM; ob = (bf16*)(ws + WS_Y); }
            else if (k == 7) { njobs = 1; mode0 = 5; A0 = H; B0 = (const bf16*)(wl + WO_UP); N = DFF; K = DM; ob = (bf16*)(ws + WS_U); }
            else if (k == 8) { njobs = 1; mode0 = 4; A0 = (const bf16*)(ws + WS_U); B0 = (const bf16*)(wl + WO_DOWN); N = DM; K = DFF; ob = (bf16*)(ws + WS_Y); }
            for (int j = 0; j < njobs; ++j) {
                const bf16* A = A0; const bf16* B = B0; int Kj = K;
                pg8::Gemm g{A, B, M, N, Kj}; pg8::StaticOrder S; S.init(M, N, (int)gridDim.x, (int)blockIdx.x);
                EpiAny E{mode0 + j, ob, of, proj};
                pg8::gemm_phase<EpiAny, pg8::StaticOrder, true, true>(ldsl, g, S, E);
            }
            int tid = tid0; asm volatile("" : "+v"(tid));
            int bid = (int)blockIdx.x, nblk = (int)gridDim.x; asm volatile("" : "+s"(bid), "+s"(nblk));
            unsigned ldso = 0; asm volatile("" : "+s"(ldso));
            float* ldsf = (float*)(lds + ldso);
            const int lane = tid & 63, wave = __builtin_amdgcn_readfirstlane(tid >> 6);
            const int gw = bid * 8 + wave, ngw = nblk * 8;
            if (k == 1) {
                for (int rep = 0; rep < ((PROBE_SUB & 1) ? 2 : 1); ++rep) { asm volatile("" : "+v"(tid), "+s"(bid)); phase_compress_mfma(a, l, (unsigned char*)ldsf, tid, tid & 63, __builtin_amdgcn_readfirstlane(tid >> 6), bid, nblk); }
                for (int rep = 0; rep < ((PROBE_SUB & 2) ? 2 : 1); ++rep) { asm volatile("" : "+v"(tid), "+s"(bid)); phase_dilated_mfma(a, (unsigned char*)ldsf, tid, tid & 63, __builtin_amdgcn_readfirstlane(tid >> 6), bid, nblk); }
                for (int rep = 0; rep < ((PROBE_SUB & 4) ? 2 : 1); ++rep) { asm volatile("" : "+v"(tid), "+s"(bid)); phase_diff_mfma(a, l, (unsigned char*)ldsf, tid, tid & 63, __builtin_amdgcn_readfirstlane(tid >> 6), bid, nblk); } }
            else if (k == 3) { phase_dil_combine(a, lane, gw, ngw); phase_nsa_mfma(a, (unsigned char*)ldsf, tid, lane, wave, bid, nblk); }
            else if (k == 6) { float* xo = a.out(); const float* xi = (l == 0) ? a.in(0) : xo;
                for (int m = gw; m < M; m += ngw) rowpass_row(xi + (size_t)m * DM, (const bf16*)(ws + WS_Y) + (size_t)m * DM, a.in(16) + (size_t)l * DM, a.in(17) + (size_t)l * DM, xo + (size_t)m * DM, H + (size_t)m * DM, lane); }
            else if (k == 9) { float* xo = a.out(); const float* gn = (l + 1 < DEPTH) ? a.in(15) + (size_t)(l + 1) * DM : nullptr;
                for (int m = gw; m < M; m += ngw) rowpass_row(xo + (size_t)m * DM, (const bf16*)(ws + WS_Y) + (size_t)m * DM, a.in(18) + (size_t)l * DM, gn, xo + (size_t)m * DM, H + (size_t)m * DM, lane); }
        }
        if (ph + 1 < ph_hi) { XcdBarrier xbar; xbar.bar = (unsigned*)(a.ws() + WS_BAR); xbar.x = xb_xcc_id(); xbar.st = (volatile LAS unsigned*)(ldsl + PTAB_OFF + 256); xcd_barrier(xbar); }
        if (ph_hi > 100000) grid.sync();
    }
}

#ifndef N_LAUNCH_SPLIT
#define N_LAUNCH_SPLIT 0
#endif
extern "C" void kernel_launch(void* const* d_in, const int* in_sizes, int n_in, void* d_out, int out_size, void* d_ws, size_t ws_size, hipStream_t stream) {
    static int grid = 0;
    if (grid == 0) {
        if (n_in != 21 || out_size != M * DM || ws_size < WS_END) { fprintf(stderr, "kernel_launch: unexpected shapes (n_in %d out %d ws %zu)\n", n_in, out_size, ws_size); grid = -1; return; }
        int dev = 0, cus = 0, per_cu = 0;
        (void)hipGetDevice(&dev); (void)hipDeviceGetAttribute(&cus, hipDeviceAttributeMultiprocessorCount, dev);
        if (hipFuncSetAttribute((const void*)mega_fwd, hipFuncAttributeMaxDynamicSharedMemorySize, LDS_BYTES) != hipSuccess) { fprintf(stderr, "hipFuncSetAttribute failed\n"); grid = -1; return; }
        if (hipOccupancyMaxActiveBlocksPerMultiprocessor(&per_cu, (const void*)mega_fwd, 512, LDS_BYTES) != hipSuccess || per_cu < 1) { fprintf(stderr, "occupancy query: %d\n", per_cu); per_cu = 1; }
        (void)hipGetLastError();
        grid = cus > 0 ? cus : 256;
    }
    if (grid < 0) return;
    if (hipMemsetAsync((char*)d_ws + WS_BAR, 0, 16384, stream) != hipSuccess) { fprintf(stderr, "kernel_launch: memset of the barrier words failed\n"); return; }
    Args a{};
    for (int i = 0; i < 21; ++i) a.in[i] = (const float*)d_in[i];
    a.out = (float*)d_out; a.ws = (unsigned char*)d_ws;
#if N_LAUNCH_SPLIT
    for (int ph = 0; ph < NPH; ++ph) { a.ph_lo = ph; a.ph_hi = ph + 1; hipLaunchKernelGGL(mega_fwd, dim3(grid), dim3(512), LDS_BYTES, stream, a); }
#else
    a.ph_lo = 0; a.ph_hi = NPH;
    void* args[] = {&a};
    hipError_t e = hipLaunchCooperativeKernel((const void*)mega_fwd, dim3(grid), dim3(512), args, LDS_BYTES, stream);
    if (e != hipSuccess) fprintf(stderr, "cooperative launch failed: %s (grid %d)\n", hipGetErrorString(e), grid);
#endif
}
```
